# Optimizing an MI355X kernel written in HIP

```python
import math
import jax, jax.numpy as jnp
from jax import lax
import numpy as np

D_MODEL = 2048
BATCH = 2
SEQ = 4096
DEPTH = 4
DEC_BATCH = 32
DEC_SEQ = 1
PAST_LEN = 16384
PAGE_SIZE = 128

N_BRANCH = 4
BRANCH_W = D_MODEL // N_BRANCH
ATT_HD = 64
ATT_HQ = BRANCH_W // ATT_HD
ATT_HKV = 2
ATT_G = ATT_HQ // ATT_HKV
WINDOW = 128
ROPE_THETA = 10000.0
SSM_GROUP = 16
SSM_NG = BRANCH_W // SSM_GROUP
SSM_P = 64
CHUNK = 128
SG_GROUPS = 4
SG_GW = BRANCH_W // SG_GROUPS
DN_HD = 128
DN_H = BRANCH_W // DN_HD
DN_CONV = 4
DN_CHUNK = 64
D_FF = 4 * D_MODEL
EPS = 1e-6
NEG_INF = -1e30
IN_SIZES = (ATT_HQ * ATT_HD, ATT_HKV * ATT_HD, ATT_HKV * ATT_HD, BRANCH_W, 2 * BRANCH_W, 3 * BRANCH_W, BRANCH_W, DN_H, DN_H, N_BRANCH * D_MODEL)
N_IN = sum(IN_SIZES)

kernel_name = 'hybrid_gated_parallel_decoder_step'


def _split(z, sizes):
    idx = np.cumsum(np.array(sizes))[:-1].tolist()
    return jnp.split(z, idx, axis=-1)


def _rmsnorm(x, g):
    xf = x.astype(jnp.float32)
    y = xf * lax.rsqrt(jnp.mean(xf * xf, axis=-1, keepdims=True) + EPS)
    return (y * g.astype(jnp.float32)).astype(x.dtype)


def _l2norm(x):
    return x * lax.rsqrt(jnp.sum(x * x, axis=-1, keepdims=True) + EPS)


def _rope(x, pos):
    half = ATT_HD // 2
    inv = ROPE_THETA ** (-jnp.arange(half, dtype=jnp.float32) / half)
    ang = pos.astype(jnp.float32)[:, None] * inv[None, :]
    cos = jnp.cos(ang)[None, :, None, :]
    sin = jnp.sin(ang)[None, :, None, :]
    xf = x.astype(jnp.float32)
    x1, x2 = xf[..., :half], xf[..., half:]
    return jnp.concatenate([x1 * cos - x2 * sin, x2 * cos + x1 * sin], axis=-1).astype(x.dtype)


def _sink_probs(s, sink):
    sk = jnp.broadcast_to(sink.astype(jnp.float32)[:, :, None, None], s.shape[:-1] + (1,))
    return jax.nn.softmax(jnp.concatenate([s, sk], axis=-1), axis=-1)[..., :-1]


def _attn_prompt(q, k, v, sink):
    B, L = q.shape[0], q.shape[1]
    nb = L // WINDOW
    scale = ATT_HD ** -0.5
    qb = q.reshape(B, nb, WINDOW, ATT_HKV, ATT_G, ATT_HD).astype(jnp.float32)
    pad = jnp.zeros((B, WINDOW, ATT_HKV, ATT_HD), k.dtype)
    kp = jnp.concatenate([pad, k], axis=1).reshape(B, nb + 1, WINDOW, ATT_HKV, ATT_HD)
    vp = jnp.concatenate([pad.astype(v.dtype), v], axis=1).reshape(B, nb + 1, WINDOW, ATT_HKV, ATT_HD)
    kb = jnp.concatenate([kp[:, :-1], kp[:, 1:]], axis=2)
    vb = jnp.concatenate([vp[:, :-1], vp[:, 1:]], axis=2)
    s = jnp.einsum('bnqkgd,bnskd->bnkgqs', qb, kb.astype(jnp.float32)) * scale
    blk = jnp.arange(nb)[:, None] * WINDOW
    qpos = blk + jnp.arange(WINDOW)[None, :]
    kpos = blk - WINDOW + jnp.arange(2 * WINDOW)[None, :]
    rel = qpos[:, :, None] - kpos[:, None, :]
    mask = (rel >= 0) & (rel < WINDOW) & (kpos[:, None, :] >= 0)
    s = jnp.where(mask[None, :, None, None], s, NEG_INF)
    p = _sink_probs(s, sink.reshape(ATT_HKV, ATT_G))
    o = jnp.einsum('bnkgqs,bnskd->bnqkgd', p.astype(vb.dtype), vb)
    return o.reshape(B, L, ATT_HQ * ATT_HD)


def _attn_sample(q, k, v, ck, cv, sink, pos0):
    B, L = q.shape[0], q.shape[1]
    lc = ck.shape[1]
    scale = ATT_HD ** -0.5
    K = jnp.concatenate([ck, k.astype(ck.dtype)], axis=1)
    V = jnp.concatenate([cv, v.astype(cv.dtype)], axis=1)
    qpos = pos0 + jnp.arange(L)
    kpos = jnp.concatenate([pos0 - lc + jnp.arange(lc), qpos])
    rel = qpos[:, None] - kpos[None, :]
    mask = (rel >= 0) & (rel < WINDOW)
    qg = q.reshape(B, L, ATT_HKV, ATT_G, ATT_HD).astype(jnp.float32)
    s = jnp.einsum('bqkgd,bskd->bkgqs', qg, K.astype(jnp.float32)) * scale
    s = jnp.where(mask[None, None, None], s, NEG_INF)
    p = _sink_probs(s, sink.reshape(ATT_HKV, ATT_G))
    o = jnp.einsum('bkgqs,bskd->bqkgd', p.astype(V.dtype), V)
    return o.reshape(B, L, ATT_HQ * ATT_HD), K[:, -lc:], V[:, -lc:]


def _attn_branch(zq, zk, zv, qn_g, kn_g, sink, pos0, cache_kv):
    B, L, _ = zq.shape
    pos = pos0 + jnp.arange(L)
    q = _rope(_rmsnorm(zq.reshape(B, L, ATT_HQ, ATT_HD), qn_g), pos)
    k = _rope(_rmsnorm(zk.reshape(B, L, ATT_HKV, ATT_HD), kn_g), pos)
    v = zv.reshape(B, L, ATT_HKV, ATT_HD)
    if cache_kv is None:
        keep = min(WINDOW, L)
        return _attn_prompt(q, k, v, sink), k[:, L - keep:], v[:, L - keep:]
    ck, cv = cache_kv
    return _attn_sample(q, k, v, ck, cv, sink, pos0)


def _lin_combine(e1, e2):
    a1, b1 = e1
    a2, b2 = e2
    return (a2 * a1, a2 * b1 + b2)


def _ssm_branch(zu, s0_re, s0_im, lam_re, lam_im, log_dt, b_re, b_im, c_re, c_im, d_skip, glu_w, glu_b):
    f32 = jnp.float32
    B, L, _ = zu.shape
    u = zu.astype(f32).reshape(B, L, SSM_NG, SSM_GROUP)
    lam = lax.complex(lam_re.astype(f32), lam_im.astype(f32))
    a_bar = jnp.exp(lam * jnp.exp(log_dt.astype(f32))[:, None])
    b_bar = ((a_bar - 1.0) / lam)[..., None] * lax.complex(b_re.astype(f32), b_im.astype(f32))
    c = lax.complex(c_re.astype(f32), c_im.astype(f32))
    bu = jnp.einsum('gpc,blgc->blgp', b_bar, u.astype(jnp.complex64))
    a = jnp.broadcast_to(a_bar, bu.shape)
    a_cum, s_zero = lax.associative_scan(_lin_combine, (a, bu), axis=1)
    s = a_cum * lax.complex(s0_re.astype(f32), s0_im.astype(f32))[:, None] + s_zero
    y = jnp.real(jnp.einsum('gcp,blgp->blgc', c, s)) + d_skip.astype(f32).reshape(SSM_NG, SSM_GROUP) * u
    y = jax.nn.gelu(y.reshape(B, L, BRANCH_W))
    y = y * jax.nn.sigmoid(y @ glu_w.astype(f32) + glu_b.astype(f32))
    s_last = s[:, -1]
    return y, jnp.real(s_last), jnp.imag(s_last)


def _spatial_gate_branch(zc, norm_g, w_s, b_s):
    B, L, _ = zc.shape
    uv = jax.nn.gelu(zc)
    u, v = uv[..., :BRANCH_W], uv[..., BRANCH_W:]
    v = _rmsnorm(v, norm_g)
    n_ch = -(-L // CHUNK)
    vp = jnp.pad(v, ((0, 0), (0, n_ch * CHUNK - L), (0, 0))).reshape(B, n_ch, CHUNK, SG_GROUPS, SG_GW)
    mixed = jnp.einsum('gts,bnsgh->bntgh', jnp.tril(w_s), vp) + jnp.transpose(b_s)[None, None, :, :, None]
    mixed = mixed.reshape(B, n_ch * CHUNK, BRANCH_W)[:, :L]
    start = ((L - 1) // CHUNK) * CHUNK
    return u * mixed, v[:, start:]


def _short_conv(x, buf, w):
    L = x.shape[1]
    xin = jnp.concatenate([buf.astype(x.dtype), x], axis=1)
    y = w[0] * xin[:, :L]
    for i in range(1, DN_CONV):
        y = y + w[i] * xin[:, i:i + L]
    return jax.nn.silu(y), xin[:, L:]


def _gated_delta(q, k, v, g, beta, S0):
    B, L, H, dk = q.shape
    dv = v.shape[-1]
    C = min(DN_CHUNK, L)
    Lp = -(-L // C) * C
    N = Lp // C

    def prep(t):
        t = jnp.pad(t, [(0, 0), (0, Lp - L)] + [(0, 0)] * (t.ndim - 2))
        t = t.reshape((B, N, C) + t.shape[2:])
        return jnp.moveaxis(t, (1, 2), (0, 3))

    q, k, v, g, beta = prep(q), prep(k), prep(v), prep(g), prep(beta)
    gc = jnp.cumsum(g, axis=-1)
    idx = jnp.arange(C)
    tril = idx[:, None] >= idx[None, :]
    stril = idx[:, None] > idx[None, :]
    diff = gc[..., :, None] - gc[..., None, :]
    dec = jnp.where(tril, jnp.exp(jnp.where(tril, diff, 0.0)), 0.0)
    kk = jnp.einsum('nbhtd,nbhsd->nbhts', k, k)
    a_mat = jnp.where(stril, beta[..., :, None] * kk * dec, 0.0) + jnp.eye(C, dtype=jnp.float32)
    eg = jnp.exp(gc)
    rhs = jnp.concatenate([beta[..., None] * v, (beta * eg)[..., None] * k], axis=-1)
    sol = lax.linalg.triangular_solve(a_mat, rhs, left_side=True, lower=True, unit_diagonal=True)
    u_t, w_k = sol[..., :dv], sol[..., dv:]
    qk = jnp.einsum('nbhtd,nbhsd->nbhts', q, k) * dec
    q_g = q * eg[..., None]
    k_end = k * jnp.exp(gc[..., -1:] - gc)[..., None]
    g_end = eg[..., -1]

    def step(S, xs):
        u_c, w_c, qk_c, qg_c, ke_c, ge_c = xs
        U = u_c - jnp.einsum('bhck,bhkv->bhcv', w_c, S)
        O = jnp.einsum('bhck,bhkv->bhcv', qg_c, S) + jnp.einsum('bhts,bhsv->bhtv', qk_c, U)
        S = ge_c[..., None, None] * S + jnp.einsum('bhck,bhcv->bhkv', ke_c, U)
        return S, O

    S, O = lax.scan(step, S0, (u_t, w_k, qk, q_g, k_end, g_end))
    O = jnp.moveaxis(O, (0, 3), (1, 2)).reshape(B, Lp, H, dv)[:, :L]
    return O, S


def _delta_branch(zqkv, zgate, za, zb, S0, conv0, conv_w, a_log, dt_bias, norm_g):
    f32 = jnp.float32
    B, L, _ = zqkv.shape
    qkv, new_conv = _short_conv(zqkv, conv0, conv_w)
    qkv = qkv.astype(f32).reshape(B, L, 3, DN_H, DN_HD)
    q = _l2norm(qkv[:, :, 0]) * (DN_HD ** -0.5)
    k = _l2norm(qkv[:, :, 1])
    v = qkv[:, :, 2]
    g = -jnp.exp(a_log.astype(f32)) * jax.nn.softplus(za.astype(f32) + dt_bias.astype(f32))
    beta = jax.nn.sigmoid(zb.astype(f32))
    o, S = _gated_delta(q, k, v, g, beta, S0.astype(f32))
    o = _rmsnorm(o, norm_g) * jax.nn.silu(zgate.astype(f32).reshape(B, L, DN_H, DN_HD))
    return o.reshape(B, L, BRANCH_W), S, new_conv


def _layer(x, pos0, state, prm, prompt):
    B, L, _ = x.shape
    h = _rmsnorm(x, prm['norm1_g'])
    z = h @ prm['w_in']
    zq, zk, zv, zu, zc, zdqkv, zdg, zda, zdb, zgate = _split(z, IN_SIZES)
    if prompt:
        cache_kv = None
        s_re = jnp.zeros((B, SSM_NG, SSM_P), jnp.float32)
        s_im = jnp.zeros((B, SSM_NG, SSM_P), jnp.float32)
        S0 = jnp.zeros((B, DN_H, DN_HD, DN_HD), jnp.float32)
        conv0 = jnp.zeros((B, DN_CONV - 1, 3 * BRANCH_W), x.dtype)
    else:
        ck, cv, s_re, s_im, S0, conv0 = state
        cache_kv = (ck, cv)
    ya, nk, nv = _attn_branch(zq, zk, zv, prm['att_qn_g'], prm['att_kn_g'], prm['att_sink'], pos0, cache_kv)
    yb, nre, nim = _ssm_branch(zu, s_re, s_im, prm['ssm_lam_re'], prm['ssm_lam_im'], prm['ssm_log_dt'],
                               prm['ssm_b_re'], prm['ssm_b_im'], prm['ssm_c_re'], prm['ssm_c_im'],
                               prm['ssm_d'], prm['ssm_glu_w'], prm['ssm_glu_b'])
    yc, vrows = _spatial_gate_branch(zc, prm['sg_norm_g'], prm['sg_w'], prm['sg_b'])
    yd, nS, nconv = _delta_branch(zdqkv, zdg, zda, zdb, S0, conv0, prm['dn_conv_w'], prm['dn_a_log'],
                                  prm['dn_dt_bias'], prm['dn_norm_g'])
    ys = jnp.stack([ya, yb, yc, yd], axis=2).astype(x.dtype)
    br = jnp.einsum('blnw,nwd->blnd', ys, prm['w_branch'])
    gates = jax.nn.sigmoid(zgate.reshape(B, L, N_BRANCH, D_MODEL))
    x = x + jnp.sum(gates * br, axis=2) @ prm['w_out']
    h2 = _rmsnorm(x, prm['norm2_g'])
    x = x + jnp.square(jax.nn.relu(h2 @ prm['w_ff1'])) @ prm['w_ff2']
    return x, (nk, nv, nre, nim, nS, nconv, vrows)


def setup_inputs(seed: int = 0) -> dict:
    key = jax.random.key(seed)
    ks = jax.random.split(key, 40)
    f32 = jnp.float32

    def nrm(k, shape, scale=1.0):
        return scale * jax.random.normal(k, shape, f32)

    w_cache = min(WINDOW, PAST_LEN)
    dn_dt = jnp.exp(jax.random.uniform(ks[30], (DEPTH, DN_H), f32, math.log(1e-3), math.log(1e-1)))
    return {
        'x_prompt': nrm(ks[0], (BATCH, SEQ, D_MODEL)),
        'x_sample': nrm(ks[1], (DEC_BATCH, DEC_SEQ, D_MODEL)),
        'cache_k': nrm(ks[2], (DEPTH, DEC_BATCH, w_cache, ATT_HKV, ATT_HD)),
        'cache_v': nrm(ks[3], (DEPTH, DEC_BATCH, w_cache, ATT_HKV, ATT_HD)),
        'state_ssm_re': nrm(ks[4], (DEPTH, DEC_BATCH, SSM_NG, SSM_P), 0.1),
        'state_ssm_im': nrm(ks[5], (DEPTH, DEC_BATCH, SSM_NG, SSM_P), 0.1),
        'state_delta': nrm(ks[6], (DEPTH, DEC_BATCH, DN_H, DN_HD, DN_HD), 0.1),
        'state_conv': nrm(ks[7], (DEPTH, DEC_BATCH, DN_CONV - 1, 3 * BRANCH_W)),
        'norm1_g': 1.0 + nrm(ks[8], (DEPTH, D_MODEL), 0.02),
        'w_in': nrm(ks[9], (DEPTH, D_MODEL, N_IN), D_MODEL ** -0.5),
        'att_qn_g': 1.0 + nrm(ks[10], (DEPTH, ATT_HD), 0.02),
        'att_kn_g': 1.0 + nrm(ks[11], (DEPTH, ATT_HD), 0.02),
        'att_sink': nrm(ks[12], (DEPTH, ATT_HQ), 0.5),
        'ssm_lam_re': -0.5 + nrm(ks[13], (DEPTH, SSM_NG, SSM_P), 0.01),
        'ssm_lam_im': jnp.pi * jnp.arange(SSM_P, dtype=f32)[None, None, :] + nrm(ks[14], (DEPTH, SSM_NG, SSM_P), 0.01),
        'ssm_log_dt': jax.random.uniform(ks[15], (DEPTH, SSM_NG), f32, math.log(1e-3), math.log(1e-1)),
        'ssm_b_re': nrm(ks[16], (DEPTH, SSM_NG, SSM_P, SSM_GROUP), (2 * SSM_GROUP) ** -0.5),
        'ssm_b_im': nrm(ks[17], (DEPTH, SSM_NG, SSM_P, SSM_GROUP), (2 * SSM_GROUP) ** -0.5),
        'ssm_c_re': nrm(ks[18], (DEPTH, SSM_NG, SSM_GROUP, SSM_P), SSM_P ** -0.5),
        'ssm_c_im': nrm(ks[19], (DEPTH, SSM_NG, SSM_GROUP, SSM_P), SSM_P ** -0.5),
        'ssm_d': nrm(ks[20], (DEPTH, BRANCH_W)),
        'ssm_glu_w': nrm(ks[21], (DEPTH, BRANCH_W, BRANCH_W), BRANCH_W ** -0.5),
        'ssm_glu_b': nrm(ks[22], (DEPTH, BRANCH_W), 0.01),
        'sg_norm_g': 1.0 + nrm(ks[23], (DEPTH, BRANCH_W), 0.02),
        'sg_w': nrm(ks[24], (DEPTH, SG_GROUPS, CHUNK, CHUNK), CHUNK ** -0.5),
        'sg_b': 1.0 + nrm(ks[25], (DEPTH, SG_GROUPS, CHUNK), 0.02),
        'dn_conv_w': nrm(ks[26], (DEPTH, DN_CONV, 3 * BRANCH_W), DN_CONV ** -0.5),
        'dn_a_log': jnp.log(jax.random.uniform(ks[27], (DEPTH, DN_H), f32, 1.0, 16.0)),
        'dn_dt_bias': dn_dt + jnp.log(-jnp.expm1(-dn_dt)),
        'dn_norm_g': 1.0 + nrm(ks[28], (DEPTH, DN_HD), 0.02),
        'w_branch': nrm(ks[29], (DEPTH, N_BRANCH, BRANCH_W, D_MODEL), BRANCH_W ** -0.5),
        'w_out': nrm(ks[31], (DEPTH, D_MODEL, D_MODEL), D_MODEL ** -0.5),
        'norm2_g': 1.0 + nrm(ks[32], (DEPTH, D_MODEL), 0.02),
        'w_ff1': nrm(ks[33], (DEPTH, D_MODEL, D_FF), D_MODEL ** -0.5),
        'w_ff2': nrm(ks[34], (DEPTH, D_FF, D_MODEL), D_FF ** -0.5),
    }


def reference(x_prompt, x_sample, cache_k, cache_v, state_ssm_re, state_ssm_im, state_delta, state_conv,
              norm1_g, w_in, att_qn_g, att_kn_g, att_sink, ssm_lam_re, ssm_lam_im, ssm_log_dt,
              ssm_b_re, ssm_b_im, ssm_c_re, ssm_c_im, ssm_d, ssm_glu_w, ssm_glu_b,
              sg_norm_g, sg_w, sg_b, dn_conv_w, dn_a_log, dn_dt_bias, dn_norm_g,
              w_branch, w_out, norm2_g, w_ff1, w_ff2):
    xp, xs = x_prompt, x_sample
    new_p = [[] for _ in range(7)]
    new_s = [[] for _ in range(7)]
    for l in range(DEPTH):
        prm = {
            'norm1_g': norm1_g[l], 'w_in': w_in[l], 'att_qn_g': att_qn_g[l], 'att_kn_g': att_kn_g[l],
            'att_sink': att_sink[l], 'ssm_lam_re': ssm_lam_re[l], 'ssm_lam_im': ssm_lam_im[l],
            'ssm_log_dt': ssm_log_dt[l], 'ssm_b_re': ssm_b_re[l], 'ssm_b_im': ssm_b_im[l],
            'ssm_c_re': ssm_c_re[l], 'ssm_c_im': ssm_c_im[l], 'ssm_d': ssm_d[l], 'ssm_glu_w': ssm_glu_w[l],
            'ssm_glu_b': ssm_glu_b[l], 'sg_norm_g': sg_norm_g[l], 'sg_w': sg_w[l], 'sg_b': sg_b[l],
            'dn_conv_w': dn_conv_w[l], 'dn_a_log': dn_a_log[l], 'dn_dt_bias': dn_dt_bias[l],
            'dn_norm_g': dn_norm_g[l], 'w_branch': w_branch[l], 'w_out': w_out[l], 'norm2_g': norm2_g[l],
            'w_ff1': w_ff1[l], 'w_ff2': w_ff2[l],
        }
        xp, sp = _layer(xp, 0, None, prm, True)
        st = (cache_k[l], cache_v[l], state_ssm_re[l], state_ssm_im[l], state_delta[l], state_conv[l])
        xs, ss = _layer(xs, PAST_LEN, st, prm, False)
        for i in range(7):
            new_p[i].append(sp[i])
            new_s[i].append(ss[i])
    p_k, p_v, p_ssm_re, p_ssm_im, p_delta, p_conv, p_chunk_v = [jnp.stack(a, axis=0) for a in new_p]
    s_k, s_v, s_ssm_re, s_ssm_im, s_delta, s_conv, s_chunk_v = [jnp.stack(a, axis=0) for a in new_s]
    return (xp, xs, p_k, p_v, p_ssm_re, p_ssm_im, p_delta, p_conv, p_chunk_v,
            s_k, s_v, s_ssm_re, s_ssm_im, s_delta, s_conv, s_chunk_v)
```

```cpp
#include <hip/hip_runtime.h>
#include <cstdio>
#include <cstdint>
namespace pg8 {
#define PG8_LAS __attribute__((address_space(3)))
typedef unsigned short bf16_t;
typedef short bf16x8 __attribute__((ext_vector_type(8)));
typedef float f32x4 __attribute__((ext_vector_type(4)));
typedef unsigned u32x4 __attribute__((ext_vector_type(4)));
constexpr int BM = 256, BK = 64, HALF = 128, HTB = HALF * BK * 2  , STAGE_BYTES = 8 * HTB, NXCD = 8, WGM = 8;

__host__ __device__ __forceinline__ int lds_byte(int r, int c) { const int st = (r >> 4) * 2 + (c >> 5), rr = r & 15, cc = c & 31, ob = rr * 64 + cc * 2; return st * 1024 + (ob ^ (((ob >> 9) & 1) << 5)); }
__host__ __device__ __forceinline__ void stage_rc(int b, int& R, int& C) { const int st = b / 1024, sb = b % 1024, swz = sb ^ (((sb >> 9) & 1) << 5); R = (st >> 1) * 16 + swz / 64; C = (st & 1) * 32 + (swz % 64) / 2; }
__host__ __device__ __forceinline__ int perm32(int rho) { const int n = rho >> 4, i = rho & 15; return 8 * (i >> 2) + 4 * n + (i & 3); }

struct Unit { int pm, pn; };
struct Gemm { const bf16_t* A; const bf16_t* Bt; int M, N, K; };

struct StaticOrder {
    int nM, nN, nwg, G, c;
    __host__ __device__ void init(int M, int N, int G_, int c_) { nM = M / BM; nN = N / BM; nwg = nM * nN; G = G_; c = c_; }
    __host__ __device__ bool next(int i, Unit& u) const {
        const long L = (long)i * G + c; if (L >= nwg) return false;
        int wgid = (int)L; { const int q = nwg / NXCD, r = nwg % NXCD, xcd = wgid % NXCD, off = wgid / NXCD; wgid = (xcd < r ? xcd * (q + 1) : r * (q + 1) + (xcd - r) * q) + off; }
        const int nig = WGM * nN, gid = wgid / nig, fm = gid * WGM, gsz = (nM - fm) < WGM ? (nM - fm) : WGM;
        u.pm = fm + ((wgid % nig) % gsz); u.pn = (wgid % nig) / gsz; return true;
    }
    __device__ __forceinline__ void a_ready(const Unit&) const {}
    __device__ __forceinline__ void done(const Unit&) const {}
};

typedef float f32x2 __attribute__((ext_vector_type(2)));
typedef __bf16 bf16x2_t __attribute__((ext_vector_type(2)));
__device__ __forceinline__ unsigned cvt_pk_bf16(float lo, float hi) { f32x2 v = {lo, hi}; bf16x2_t b = __builtin_convertvector(v, bf16x2_t); return __builtin_bit_cast(unsigned, b); }
__device__ __forceinline__ float bflo(unsigned w) { return __uint_as_float(w << 16); }
__device__ __forceinline__ float bfhi(unsigned w) { return __uint_as_float(w & 0xffff0000u); }
constexpr int MROWS = 8224;
constexpr float RMS_EPS = 1e-6f;

__device__ __forceinline__ float row_rstd(const float* P, int row) {
    const f32x4* p = (const f32x4*)(P + (size_t)row * 32); float s = 0.f;
#pragma unroll
    for (int i = 0; i < 8; ++i) { const f32x4 v = p[i]; s += (v[0] + v[1]) + (v[2] + v[3]); }
    return __builtin_amdgcn_rsqf(s * (1.0f / 2048.0f) + RMS_EPS);
}
struct EpiIn {
    static constexpr bool PERM = true, AFTER_DRAIN = false, HOOK = false;
    bf16_t* Z; float* ZAB; bf16_t* G; const float* ssq;
    __device__ __forceinline__ void operator()(const f32x4 (&acc)[2][2][4][2], const Unit& u, int wr, int wc, int fr, int fq) const {
        const int row0 = u.pm * BM + wr * 64 + fr, colw = wc * 32 + 8 * fq;
#pragma unroll
        for (int ai = 0; ai < 2; ++ai)
#pragma unroll
            for (int m = 0; m < 4; ++m) { const int row = row0 + ai * HALF + m * 16;
                const float rs = row_rstd(ssq, row);
#pragma unroll
                for (int bj = 0; bj < 2; ++bj) { f32x4 v0 = acc[ai][bj][m][0] * rs, v1 = acc[ai][bj][m][1] * rs; const int col = colw + bj * HALF;
                    if (u.pn < 17) { u32x4 w; w.x = cvt_pk_bf16(v0[0], v0[1]); w.y = cvt_pk_bf16(v0[2], v0[3]); w.z = cvt_pk_bf16(v1[0], v1[1]); w.w = cvt_pk_bf16(v1[2], v1[3]);
                        *(u32x4*)(Z + (size_t)row * 4352 + u.pn * BM + col) = w; }
                    else if (u.pn == 17) { if (col == 0) { *(f32x4*)(ZAB + (size_t)row * 8) = v0; *(f32x4*)(ZAB + (size_t)row * 8 + 4) = v1; } }
                    else { float s[8];
#pragma unroll
                        for (int i = 0; i < 4; ++i) { s[i] = fmaxf(__builtin_amdgcn_rcpf(1.0f + __expf(-v0[i])), 1e-18f); s[4 + i] = fmaxf(__builtin_amdgcn_rcpf(1.0f + __expf(-v1[i])), 1e-18f); }
                        u32x4 w; w.x = cvt_pk_bf16(s[0], s[1]); w.y = cvt_pk_bf16(s[2], s[3]); w.z = cvt_pk_bf16(s[4], s[5]); w.w = cvt_pk_bf16(s[6], s[7]);
                        *(u32x4*)(G + (size_t)row * 8192 + (u.pn - 18) * BM + col) = w; } } }
    }
};
struct EpiFf1 {
    static constexpr bool PERM = true, AFTER_DRAIN = false, HOOK = false;
    bf16_t* H; const float* ssq;
    __device__ __forceinline__ void operator()(const f32x4 (&acc)[2][2][4][2], const Unit& u, int wr, int wc, int fr, int fq) const {
        const int row0 = u.pm * BM + wr * 64 + fr, col0 = u.pn * BM + wc * 32 + 8 * fq;
#pragma unroll
        for (int ai = 0; ai < 2; ++ai)
#pragma unroll
            for (int m = 0; m < 4; ++m) { const int row = row0 + ai * HALF + m * 16;
                const float rs = row_rstd(ssq, row);
#pragma unroll
                for (int bj = 0; bj < 2; ++bj) { f32x4 v0 = acc[ai][bj][m][0] * rs, v1 = acc[ai][bj][m][1] * rs;
#pragma unroll
                    for (int i = 0; i < 4; ++i) { const float a = fmaxf(v0[i], 0.f), b = fmaxf(v1[i], 0.f); v0[i] = a * a; v1[i] = b * b; }
                    u32x4 w; w.x = cvt_pk_bf16(v0[0], v0[1]); w.y = cvt_pk_bf16(v0[2], v0[3]); w.z = cvt_pk_bf16(v1[0], v1[1]); w.w = cvt_pk_bf16(v1[2], v1[3]);
                    *(u32x4*)(H + (size_t)row * 8192 + col0 + bj * HALF) = w; } }
    }
};
struct EpiRes {
    static constexpr bool PERM = true, AFTER_DRAIN = false, HOOK = false;
    const float* Rp; const float* Rs; float* Xp; float* Xs; bf16_t* XB; float* ssq_out;
    __device__ __forceinline__ void operator()(const f32x4 (&acc)[2][2][4][2], const Unit& u, int wr, int wc, int fr, int fq) const {
        const int row0 = u.pm * BM + wr * 64 + fr, col0 = u.pn * BM + wc * 32 + 8 * fq;
#pragma unroll
        for (int ai = 0; ai < 2; ++ai)
#pragma unroll
            for (int m = 0; m < 4; ++m) { const int row = row0 + ai * HALF + m * 16;
                if (row - fr + 15 < MROWS) {
                    const float* rp = row < 8192 ? Rp + (size_t)row * 2048 : Rs + (size_t)(row - 8192) * 2048;
                    float* xp = row < 8192 ? Xp + (size_t)row * 2048 : Xs + (size_t)(row - 8192) * 2048;
                    float sq = 0.f;
#pragma unroll
                    for (int bj = 0; bj < 2; ++bj) { const int col = col0 + bj * HALF;
                        const f32x4 r0 = *(const f32x4*)(rp + col), r1 = *(const f32x4*)(rp + col + 4);
                        const f32x4 v0 = acc[ai][bj][m][0] + r0, v1 = acc[ai][bj][m][1] + r1;
                        *(f32x4*)(xp + col) = v0; *(f32x4*)(xp + col + 4) = v1;
                        u32x4 w; w.x = cvt_pk_bf16(v0[0], v0[1]); w.y = cvt_pk_bf16(v0[2], v0[3]); w.z = cvt_pk_bf16(v1[0], v1[1]); w.w = cvt_pk_bf16(v1[2], v1[3]);
                        *(u32x4*)(XB + (size_t)row * 2048 + col) = w;
                        sq += (v0[0] * v0[0] + v0[1] * v0[1]) + (v0[2] * v0[2] + v0[3] * v0[3]) + (v1[0] * v1[0] + v1[1] * v1[1]) + (v1[2] * v1[2] + v1[3] * v1[3]); }
                    sq += __shfl_xor(sq, 16); sq += __shfl_xor(sq, 32);
                    if (fq == 0) ssq_out[(size_t)row * 32 + u.pn * 4 + wc] = sq;
                } else if (fq == 0) ssq_out[(size_t)row * 32 + u.pn * 4 + wc] = 0.f;
                asm volatile("" ::: "memory"); }
    }
};
struct EpiGate {
    static constexpr bool PERM = true, AFTER_DRAIN = false, HOOK = true;
    const bf16_t* G; bf16_t* GS;
    __device__ __forceinline__ void hook(f32x4 (&acc)[2][2][4][2], const Unit& u, int bidx, int wr, int wc, int fr, int fq) const {
        const bf16_t* gp0 = G + (size_t)(u.pm * BM + wr * 64 + fr) * 8192 + (size_t)(bidx - 1) * 2048 + u.pn * BM + wc * 32 + 8 * fq;
#pragma unroll
        for (int ai = 0; ai < 2; ++ai)
#pragma unroll
            for (int m = 0; m < 4; ++m)
#pragma unroll
                for (int bj = 0; bj < 2; ++bj) { const bf16_t* gp = gp0 + (size_t)(ai * HALF + m * 16) * 8192 + bj * HALF;
                    const u32x4 ga = *(const u32x4*)gp, gb = *(const u32x4*)(gp + 2048);
                    acc[ai][bj][m][0][0] *= bflo(ga.x) * __builtin_amdgcn_rcpf(bflo(gb.x)); acc[ai][bj][m][0][1] *= bfhi(ga.x) * __builtin_amdgcn_rcpf(bfhi(gb.x));
                    acc[ai][bj][m][0][2] *= bflo(ga.y) * __builtin_amdgcn_rcpf(bflo(gb.y)); acc[ai][bj][m][0][3] *= bfhi(ga.y) * __builtin_amdgcn_rcpf(bfhi(gb.y));
                    acc[ai][bj][m][1][0] *= bflo(ga.z) * __builtin_amdgcn_rcpf(bflo(gb.z)); acc[ai][bj][m][1][1] *= bfhi(ga.z) * __builtin_amdgcn_rcpf(bfhi(gb.z));
                    acc[ai][bj][m][1][2] *= bflo(ga.w) * __builtin_amdgcn_rcpf(bflo(gb.w)); acc[ai][bj][m][1][3] *= bfhi(ga.w) * __builtin_amdgcn_rcpf(bfhi(gb.w));
                    if (bj == 1 && (m & 1)) asm volatile("" ::: "memory"); }
        asm volatile("s_waitcnt vmcnt(0)" ::: "memory");
    }
    __device__ __forceinline__ void operator()(const f32x4 (&acc)[2][2][4][2], const Unit& u, int wr, int wc, int fr, int fq) const {
        const int row0 = u.pm * BM + wr * 64 + fr, col0 = u.pn * BM + wc * 32 + 8 * fq;
#pragma unroll
        for (int ai = 0; ai < 2; ++ai)
#pragma unroll
            for (int m = 0; m < 4; ++m) { const size_t row = (size_t)(row0 + ai * HALF + m * 16);
#pragma unroll
                for (int bj = 0; bj < 2; ++bj) { const u32x4 g = *(const u32x4*)(G + row * 8192 + 3 * 2048 + col0 + bj * HALF);
                    const f32x4 a0 = acc[ai][bj][m][0], a1 = acc[ai][bj][m][1];
                    u32x4 w; w.x = cvt_pk_bf16(a0[0] * bflo(g.x), a0[1] * bfhi(g.x)); w.y = cvt_pk_bf16(a0[2] * bflo(g.y), a0[3] * bfhi(g.y));
                    w.z = cvt_pk_bf16(a1[0] * bflo(g.z), a1[1] * bfhi(g.z)); w.w = cvt_pk_bf16(a1[2] * bflo(g.w), a1[3] * bfhi(g.w));
                    *(u32x4*)(GS + row * 2048 + col0 + bj * HALF) = w; }
                asm volatile("" ::: "memory"); }
    }
};
template <class Epi, class Sched, bool ALIGN_EPI = false, bool SP2 = false>
__device__ __forceinline__ void gemm_phase(PG8_LAS unsigned char* lds, const Gemm g, const Sched& S, const Epi& E) {
    int tid_ = threadIdx.x; asm volatile("" : "+v"(tid_));
    const int tid = tid_, wid = __builtin_amdgcn_readfirstlane(tid >> 6), lane = tid & 63, wr = wid >> 2, wc = wid & 3, fr = lane & 15, fq = lane >> 4;
    const int K = g.K, nt = K / BK;
    unsigned voffA[2], voffB[2];
#pragma unroll
    for (int i = 0; i < 2; ++i) { int R, C; stage_rc(tid * 16 + i * 8192, R, C); const int Rb = Epi::PERM ? ((R & ~31) + perm32(R & 31)) : R;
        voffA[i] = (unsigned)(R * K + C) * 2u; voffB[i] = (unsigned)(Rb * K + C) * 2u; }
    const size_t kstep = (size_t)(BK * 2);
    const size_t hstep = (size_t)HALF * K * 2;
    const size_t tstep = 2 * hstep;
    const unsigned ldsw = (unsigned)wid * 1024u;
    const int aoff = lds_byte(wr * 64 + fr, fq * 8), boff = lds_byte(wc * 32 + fr, fq * 8);
#define PG8_SA(b, h) (((b) * 2 + (h)) * HTB)
#define PG8_SB(b, h) ((4 + (b) * 2 + (h)) * HTB)
#define PG8_STAGE(bufoff, gbase, voff) do { _Pragma("unroll") for (int _i = 0; _i < 2; ++_i) \
        __builtin_amdgcn_global_load_lds((const unsigned*)((const char*)(gbase) + (voff)[_i]), (PG8_LAS unsigned*)(lds + (bufoff) + ldsw + _i * 8192), 16, 0, 0); } while (0)
#define PG8_LDA(dst, b, h) do { _Pragma("unroll") for (int m = 0; m < 4; ++m) _Pragma("unroll") for (int k = 0; k < 2; ++k) dst[m][k] = *(const PG8_LAS bf16x8*)(lds + PG8_SA(b, h) + aoff + m * 2048 + k * 1024); } while (0)
#define PG8_LDB(dst, b, h) do { _Pragma("unroll") for (int n = 0; n < 2; ++n) _Pragma("unroll") for (int k = 0; k < 2; ++k) dst[n][k] = *(const PG8_LAS bf16x8*)(lds + PG8_SB(b, h) + boff + n * 2048 + k * 1024); } while (0)
#define PG8_MMA(ai, bj, At, Bt) do { __builtin_amdgcn_s_setprio(1); _Pragma("unroll") for (int m = 0; m < 4; ++m) _Pragma("unroll") for (int n = 0; n < 2; ++n) _Pragma("unroll") for (int k = 0; k < 2; ++k) \
        acc[ai][bj][m][n] = __builtin_amdgcn_mfma_f32_16x16x32_bf16(Bt[n][k], At[m][k], acc[ai][bj][m][n], 0, 0, 0); __builtin_amdgcn_s_setprio(0); } while (0)
#define PG8_WAIT_V(n) asm volatile("s_waitcnt vmcnt(" #n ")" ::: "memory")
#define PG8_WAIT_L(n) asm volatile("s_waitcnt lgkmcnt(" #n ")" ::: "memory")
#define PG8_BAR __builtin_amdgcn_s_barrier()
#define PG8_SCHED __builtin_amdgcn_sched_barrier(0)
    Unit cur, nxt; int ui = 0;
    if (!S.next(0, cur)) return;
    f32x4 acc[2][2][4][2];
#pragma unroll
    for (int a = 0; a < 2; ++a)
#pragma unroll
        for (int b = 0; b < 2; ++b)
#pragma unroll
            for (int m = 0; m < 4; ++m)
#pragma unroll
                for (int n = 0; n < 2; ++n) acc[a][b][m][n] = (f32x4){0.f, 0.f, 0.f, 0.f};
    bf16x8 At[4][2], B0[2][2], B1[2][2];
    const char* cA = (const char*)g.A + (size_t)cur.pm * tstep; const char* cB = (const char*)g.Bt + (size_t)cur.pn * tstep;
    S.a_ready(cur);
    if constexpr (SP2) {
        PG8_STAGE(PG8_SB(0, 0), cB, voffB); PG8_STAGE(PG8_SB(0, 1), cB + hstep, voffB); PG8_STAGE(PG8_SA(0, 0), cA, voffA); PG8_STAGE(PG8_SA(0, 1), cA + hstep, voffA);
        if (wr == 1) PG8_BAR;
        PG8_WAIT_V(2); PG8_BAR;
        PG8_STAGE(PG8_SB(1, 0), cB + kstep, voffB); PG8_STAGE(PG8_SA(1, 0), cA + kstep, voffA); PG8_STAGE(PG8_SB(1, 1), cB + hstep + kstep, voffB);
        PG8_WAIT_V(6); PG8_BAR;
    } else {
        PG8_STAGE(PG8_SB(0, 0), cB, voffB); PG8_STAGE(PG8_SA(0, 0), cA, voffA); PG8_STAGE(PG8_SB(0, 1), cB + hstep, voffB); PG8_STAGE(PG8_SA(0, 1), cA + hstep, voffA);
        if (wr == 1) PG8_BAR;
        PG8_WAIT_V(4); PG8_BAR;
        PG8_STAGE(PG8_SB(1, 0), cB + kstep, voffB); PG8_STAGE(PG8_SA(1, 0), cA + kstep, voffA); PG8_STAGE(PG8_SB(1, 1), cB + hstep + kstep, voffB);
        PG8_WAIT_V(6); PG8_BAR;
    }
    for (;;) {
        const bool has_next = S.next(ui + 1, nxt);
        const char* nA = has_next ? (const char*)g.A + (size_t)nxt.pm * tstep : cA; const char* nB = has_next ? (const char*)g.Bt + (size_t)nxt.pn * tstep : cB;
        for (int t = 0; t < nt; t += 2) {
            const bool last = (t == nt - 2);
            const char* a1 = cA + (size_t)(t + 1) * kstep;
            const char* a2 = last ? nA : cA + (size_t)(t + 2) * kstep; const char* b2 = last ? nB : cB + (size_t)(t + 2) * kstep;
            const char* a3 = a2 + kstep; const char* b3 = b2 + kstep;
            if (last && has_next) S.a_ready(nxt);
            if constexpr (SP2) {
            PG8_LDB(B0, 0, 0); PG8_LDB(B1, 0, 1); PG8_SCHED; PG8_LDA(At, 0, 0); PG8_STAGE(PG8_SA(1, 1), a1 + hstep, voffA);
            PG8_WAIT_V(8); PG8_WAIT_L(0); PG8_BAR; PG8_MMA(0, 0, At, B0); PG8_MMA(0, 1, At, B1); PG8_BAR; PG8_SCHED;
            PG8_LDA(At, 0, 1); PG8_STAGE(PG8_SB(0, 0), b2, voffB); PG8_STAGE(PG8_SB(0, 1), b2 + hstep, voffB); PG8_STAGE(PG8_SA(0, 0), a2, voffA);
            PG8_WAIT_V(8); PG8_WAIT_L(0); PG8_BAR; PG8_MMA(1, 0, At, B0); PG8_MMA(1, 1, At, B1); PG8_BAR; PG8_SCHED;
            PG8_LDB(B0, 1, 0); PG8_LDB(B1, 1, 1); PG8_SCHED; PG8_LDA(At, 1, 0); PG8_STAGE(PG8_SA(0, 1), a2 + hstep, voffA);
            PG8_WAIT_V(8); PG8_WAIT_L(0); PG8_BAR; PG8_MMA(0, 0, At, B0); PG8_MMA(0, 1, At, B1); PG8_BAR; PG8_SCHED;
            PG8_LDA(At, 1, 1); PG8_STAGE(PG8_SB(1, 0), b3, voffB); PG8_STAGE(PG8_SB(1, 1), b3 + hstep, voffB); PG8_STAGE(PG8_SA(1, 0), a3, voffA);
            PG8_WAIT_V(8); PG8_WAIT_L(0); PG8_BAR; PG8_MMA(1, 0, At, B0); PG8_MMA(1, 1, At, B1); PG8_BAR; PG8_SCHED;
            } else {
            PG8_LDB(B0, 0, 0); PG8_SCHED; PG8_LDA(At, 0, 0); PG8_STAGE(PG8_SA(1, 1), a1 + hstep, voffA);
            PG8_WAIT_L(8); PG8_BAR; PG8_WAIT_L(0); PG8_MMA(0, 0, At, B0); PG8_BAR; PG8_SCHED;
            PG8_LDB(B1, 0, 1); PG8_STAGE(PG8_SB(0, 0), b2, voffB);
            PG8_BAR; PG8_WAIT_L(0); PG8_MMA(0, 1, At, B1); PG8_BAR;
            PG8_LDA(At, 0, 1); PG8_STAGE(PG8_SA(0, 0), a2, voffA);
            PG8_BAR; PG8_WAIT_L(0); PG8_MMA(1, 0, At, B0); PG8_BAR; PG8_SCHED;
            PG8_STAGE(PG8_SB(0, 1), b2 + hstep, voffB);
            PG8_WAIT_V(6); PG8_BAR; PG8_MMA(1, 1, At, B1); PG8_BAR;
            PG8_LDB(B0, 1, 0); PG8_SCHED; PG8_LDA(At, 1, 0); PG8_STAGE(PG8_SA(0, 1), a2 + hstep, voffA);
            PG8_WAIT_L(8); PG8_BAR; PG8_WAIT_L(0); PG8_MMA(0, 0, At, B0); PG8_BAR; PG8_SCHED;
            PG8_LDB(B1, 1, 1); PG8_STAGE(PG8_SB(1, 0), b3, voffB);
            PG8_BAR; PG8_WAIT_L(0); PG8_MMA(0, 1, At, B1); PG8_BAR;
            PG8_LDA(At, 1, 1); PG8_STAGE(PG8_SA(1, 0), a3, voffA);
            PG8_BAR; PG8_WAIT_L(0); PG8_MMA(1, 0, At, B0); PG8_BAR; PG8_SCHED;
            PG8_STAGE(PG8_SB(1, 1), b3 + hstep, voffB);
            PG8_WAIT_V(6); PG8_BAR; PG8_MMA(1, 1, At, B1); PG8_BAR;
            }
            if constexpr (Epi::HOOK) { if ((((t + 2) & 7) == 0) && !last) { E.hook(acc, cur, (t + 2) >> 3, wr, wc, fr, fq); PG8_SCHED; } }
        }
        if constexpr (ALIGN_EPI) { if (wr == 0) PG8_BAR; }
        if constexpr (!Epi::AFTER_DRAIN) { E(acc, cur, wr, wc, fr, fq); S.done(cur); }
        if (!has_next) break;
#pragma unroll
        for (int a = 0; a < 2; ++a)
#pragma unroll
            for (int b = 0; b < 2; ++b)
#pragma unroll
                for (int m = 0; m < 4; ++m)
#pragma unroll
                    for (int n = 0; n < 2; ++n) acc[a][b][m][n] = (f32x4){0.f, 0.f, 0.f, 0.f};
        cur = nxt; cA = nA; cB = nB; ++ui;
        if constexpr (ALIGN_EPI) { if (wr == 1) PG8_BAR; }
    }
    PG8_WAIT_V(0);
    if constexpr (!ALIGN_EPI) { if (wr == 0) PG8_BAR; }
    PG8_BAR;
    if constexpr (Epi::AFTER_DRAIN) { E.fused(acc, cur, wr, wc, fr, fq, lds, wid, lane); S.done(cur); }
#undef PG8_SA
#undef PG8_SB
#undef PG8_STAGE
#undef PG8_LDA
#undef PG8_LDB
#undef PG8_MMA
#undef PG8_WAIT_V
#undef PG8_WAIT_L
#undef PG8_BAR
#undef PG8_SCHED
}
}
constexpr int NWAVES = 8;
constexpr int DM = 2048, SEQ = 4096, NB = 2, MP = NB * SEQ  , NS = 32  , MPAD = 8448, DEPTH = 4, DFF = 8192;
constexpr int NIN = 12552, NINP = 12800, ZW = 4352, GW = 8192, PASTLEN = 16384;
constexpr int ZC_Q = 0, ZC_K = 512, ZC_V = 640, ZC_SU = 768, ZC_GU = 1280, ZC_GV = 1792, ZC_DQ = 2304, ZC_DK = 2816, ZC_DV = 3328, ZC_DG = 3840;
constexpr float LOG2E = 1.4426950408889634f;

constexpr size_t MiB = 1u << 20;
constexpr size_t WS_CTL = 0, CTL_ZERO_BYTES = 1 * MiB;
constexpr size_t WS_ROPE = 1 * MiB;
constexpr size_t WS_ABAR = 3 * MiB;
constexpr size_t WS_A32 = WS_ABAR + 65536;
constexpr size_t WS_CFRAG = WS_ABAR + 131072;
constexpr size_t WS_BBAR = 4 * MiB;
constexpr size_t WS_WTRIL = 5 * MiB;
constexpr size_t WS_WG = 6 * MiB;
constexpr size_t WS_E = 8 * MiB;
constexpr size_t WS_ZAB = 12 * MiB;
constexpr size_t WS_GE = 13 * MiB;
constexpr size_t WS_WIN = 16 * MiB;
constexpr size_t WS_WB = 216 * MiB;
constexpr size_t WS_WO = 248 * MiB;
constexpr size_t WS_W1 = 280 * MiB;
constexpr size_t WS_W2 = 408 * MiB;
constexpr size_t WS_XB = 536 * MiB;
constexpr size_t WS_Z = 570 * MiB;
constexpr size_t WS_G = 642 * MiB;
constexpr size_t WS_YCAT = 774 * MiB;
constexpr size_t WS_GS = 808 * MiB;
constexpr size_t WS_H = 842 * MiB;
constexpr size_t WS_OD = 974 * MiB;
constexpr size_t WS_U0 = 990 * MiB;
constexpr size_t WS_WN = 1006 * MiB;
constexpr size_t WS_QG = 1014 * MiB;
constexpr size_t WS_QK = 1022 * MiB;
constexpr size_t WS_KE = 1026 * MiB;
constexpr size_t WS_SSQP = 1034 * MiB;
constexpr size_t WS_END = 1046 * MiB;
constexpr int CW_TMO = 0;
constexpr int CW_BAR = 4096;

constexpr size_t O_YP = 0, O_YS = 16777216, O_PK = O_YS + 65536, O_PV = O_PK + 131072, O_PSR = O_PV + 131072, O_PSI = O_PSR + 16384, O_PD = O_PSI + 16384,
                 O_PC = O_PD + 524288, O_PCV = O_PC + 36864, O_SK = O_PCV + 524288, O_SV = O_SK + 2097152, O_SSR = O_SV + 2097152, O_SSI = O_SSR + 262144,
                 O_SD = O_SSI + 262144, O_SC = O_SD + 8388608, O_SCV = O_SC + 589824, O_END = O_SCV + 65536;

constexpr int RING_OFF = 0, RING_BYTES = 131072;
constexpr int LDSCTL_OFF = RING_BYTES, MISC_OFF = LDSCTL_OFF + 320;
constexpr int LDS_BYTES = 147456;
static_assert(MISC_OFF + 128 <= LDS_BYTES, "LDS map");

#define GAS __attribute__((address_space(1)))
#define LAS __attribute__((address_space(3)))
typedef unsigned short bf16;
typedef unsigned v4u __attribute__((ext_vector_type(4)));
typedef float f32x4 __attribute__((ext_vector_type(4)));
typedef short bf16x8 __attribute__((ext_vector_type(8)));
typedef GAS unsigned gu32;
typedef GAS unsigned long long gu64;
#define RLX_AGENT __ATOMIC_RELAXED, __HIP_MEMORY_SCOPE_AGENT
#define LDS_WAIT() asm volatile("s_waitcnt lgkmcnt(0)" ::: "memory")
#define VM_WAIT() asm volatile("s_waitcnt vmcnt(0)" ::: "memory")
__device__ __forceinline__ unsigned long long rt() { return __builtin_amdgcn_s_memrealtime(); }
__device__ __forceinline__ unsigned f2bf(float f) { unsigned u = __builtin_bit_cast(unsigned, f); return (u + 0x7fffu + ((u >> 16) & 1u)) >> 16; }
__device__ __forceinline__ unsigned pk2(float lo, float hi) { return f2bf(lo) | (f2bf(hi) << 16); }

#define XB_TMO      128
#define XB_XCNT(j)  (256  + 64 * (j))
#define XB_XSUB(j)  (1280 + 64 * (j))
#define XB_XGEN(j)  (2304 + 64 * (j))
#define XB_TOP      3328
#define XB_TOPGEN   3392
#define XCD_BAR_WORDS 3456
#define XB_SPIN_CAP (1u << 18)

__device__ __forceinline__ unsigned xb_ld(unsigned* p)              { return __hip_atomic_load(p, __ATOMIC_RELAXED, __HIP_MEMORY_SCOPE_AGENT); }
__device__ __forceinline__ unsigned xb_add(unsigned* p, unsigned v) { return __hip_atomic_fetch_add(p, v, __ATOMIC_RELAXED, __HIP_MEMORY_SCOPE_AGENT); }
__device__ __forceinline__ unsigned xb_xcc_id() { return (unsigned)__builtin_amdgcn_s_getreg((3 << 11) | 20) & 0xFu; }
#define XB_SPIN(cond, bar) do { unsigned _sp = 0; while (cond) { __builtin_amdgcn_s_sleep(1); \
    if ((++_sp & 255u) == 0u) { if (xb_ld(&(bar)[XB_TMO])) break; if (_sp > XB_SPIN_CAP) { atomicAdd(&(bar)[XB_TMO], 1u); break; } } } } while (0)

struct XcdBarrier {
    unsigned* bar; unsigned x;
    volatile LAS unsigned* st;
};

__device__ __forceinline__ XcdBarrier xcd_barrier_post(unsigned* bar, volatile LAS unsigned* st) {
    XcdBarrier b; b.bar = bar; b.x = xb_xcc_id(); b.st = st;
    if (threadIdx.x == 0) (void)xb_add(&bar[XB_XCNT(b.x)], 1u);
    return b;
}
__device__ __forceinline__ void xcd_barrier_complete(unsigned* bar, unsigned x, unsigned& nloc, unsigned& nx) {
    const unsigned G = gridDim.x * gridDim.y * gridDim.z;
    unsigned sum, cnt, mine, sp = 0u;
    for (;;) {
        sum = 0u; cnt = 0u; mine = 0u;
#pragma unroll
        for (unsigned j = 0; j < 16; ++j) { const unsigned c = xb_ld(&bar[XB_XCNT(j)]); sum += c; cnt += (c > 0u) ? 1u : 0u; mine = (j == x) ? c : mine; }
        if (sum == G) break;
        __builtin_amdgcn_s_sleep(1);
        if ((++sp & 255u) == 0u) { if (xb_ld(&bar[XB_TMO])) break; if (sp > XB_SPIN_CAP) { atomicAdd(&bar[XB_TMO], 1u); break; } }
    }
    nloc = mine > 0u ? mine : 1u; nx = cnt > 0u ? cnt : 1u;
}

__device__ __forceinline__ void xcd_barrier(const XcdBarrier& b) {
    asm volatile("s_waitcnt vmcnt(0)" ::: "memory");
    __syncthreads();
    if (threadIdx.x == 0) {
        unsigned* bar = b.bar;
        __builtin_amdgcn_s_waitcnt(0);
        unsigned nloc = b.st[0], nx = b.st[1];
        if (nloc == 0u) { xcd_barrier_complete(bar, b.x, nloc, nx); b.st[0] = nloc; b.st[1] = nx; }
        const unsigned old = xb_add(&bar[XB_XSUB(b.x)], 1u);
        const unsigned gen = old / nloc;
        if (old + 1u == (gen + 1u) * nloc) {
            __builtin_amdgcn_fence(__ATOMIC_RELEASE, "agent");
            asm volatile("s_waitcnt vmcnt(0)" ::: "memory");
            const unsigned og = xb_add(&bar[XB_TOP], 1u);
            const unsigned tg = og / nx;
            if (og + 1u == (tg + 1u) * nx) xb_add(&bar[XB_TOPGEN], 1u);
            else XB_SPIN(xb_ld(&bar[XB_TOPGEN]) == tg, bar);
            __builtin_amdgcn_fence(__ATOMIC_ACQUIRE, "agent");
            xb_add(&bar[XB_XGEN(b.x)], 1u);
            asm volatile("s_waitcnt vmcnt(0)" ::: "memory");
        } else {
            XB_SPIN(xb_ld(&bar[XB_XGEN(b.x)]) == gen, bar);
            __builtin_amdgcn_fence(__ATOMIC_ACQUIRE, "agent");
            asm volatile("s_waitcnt vmcnt(0)" ::: "memory");
        }
    }
    __syncthreads();
}
typedef float f32x16 __attribute__((ext_vector_type(16)));
typedef float f32x2v __attribute__((ext_vector_type(2)));
typedef unsigned v2u __attribute__((ext_vector_type(2)));
#define DI __device__ __forceinline__
#define MFMA32(a, b, c) __builtin_amdgcn_mfma_f32_32x32x16_bf16((a), (b), (c), 0, 0, 0)
#define MFMA16(a, b, c) __builtin_amdgcn_mfma_f32_16x16x32_bf16((a), (b), (c), 0, 0, 0)
DI float bf2f(unsigned short h) { return __uint_as_float((unsigned)h << 16); }
DI float bflo(unsigned w) { return __uint_as_float(w << 16); }
DI float bfhi(unsigned w) { return __uint_as_float(w & 0xffff0000u); }
DI unsigned cvtpk(float lo, float hi) { return pg8::cvt_pk_bf16(lo, hi); }
DI unsigned short cvt1(float v) { return (unsigned short)(pg8::cvt_pk_bf16(v, 0.f) & 0xffffu); }
#define CR(k) (((k) & 3) + 8 * ((k) >> 2))
DI int crow(int reg, int h) { return (reg & 3) + 8 * (reg >> 2) + 4 * h; }
DI bf16x8 pack8(float a0, float a1, float a2, float a3, float a4, float a5, float a6, float a7) {
    v4u p; p.x = cvtpk(a0, a1); p.y = cvtpk(a2, a3); p.z = cvtpk(a4, a5); p.w = cvtpk(a6, a7); return __builtin_bit_cast(bf16x8, p); }
DI bf16x8 pack_step(const f32x16& x, int s) { return s == 0 ? pack8(x[0], x[1], x[2], x[3], x[4], x[5], x[6], x[7]) : pack8(x[8], x[9], x[10], x[11], x[12], x[13], x[14], x[15]); }
DI float wave_sum(float v) {
#pragma unroll
    for (int o = 1; o < 64; o <<= 1) v += __shfl_xor(v, o);
    return v;
}
DI float wave_max(float v) {
#pragma unroll
    for (int o = 1; o < 64; o <<= 1) v = fmaxf(v, __shfl_xor(v, o));
    return v;
}
DI float gelu_tanh(float x) {
    const float t = 1.5957691216057308f * (x + 0.044715f * x * x * x);
    return x * __builtin_amdgcn_rcpf(1.0f + __expf(-t));
}
DI float sigmoidf_(float x) { return __builtin_amdgcn_rcpf(1.0f + __expf(-x)); }
DI float siluf_(float x) { return x * __builtin_amdgcn_rcpf(1.0f + __expf(-x)); }
DI float softplusf_(float x) { return x > 20.f ? x : log1pf(__expf(x)); }
DI int frag_off(int row, int k, int nks) { const int rt = row >> 5, r = row & 31, ks = k >> 4, w = k & 15, h = (w >> 2) & 1, j = ((w >> 3) << 2) | (w & 3); return (((rt * nks + ks) * 64) + r + 32 * h) * 8 + j; }

DI int opaque_tid() { int t = threadIdx.x; asm volatile("" : "+v"(t)); return t; }
struct Frame {
    LAS unsigned char* lds;
    volatile LAS unsigned* MISC;
    gu32* ctl;
    unsigned char* ws;
    const float* const* in;
    int tid, lane, wave, vcu, G;
};
struct Args { const float* in[35]; float* out; unsigned char* ws; };
enum { I_XP = 0, I_XS, I_CK, I_CV, I_SSR, I_SSI, I_SD, I_SC, I_N1G, I_WIN, I_QNG, I_KNG, I_SINK, I_LAMR, I_LAMI, I_LOGDT, I_BRE, I_BIM, I_CRE, I_CIM, I_SSMD, I_GLUW, I_GLUB,
       I_SGNG, I_SGW, I_SGB, I_CONVW, I_ALOG, I_DTB, I_DNG, I_WBR, I_WOUT, I_N2G, I_WFF1, I_WFF2 };

template <int MODE>
DI void p0_transpose_item(const float* W, int K, int Nsrc, bf16* WT, const float* gain, LAS float* scr, int kb, int nb, int lane) {
    const int k0 = 64 * kb, n0 = 32 * nb;
    const int nd = n0 + (lane & 31);
    const int ns = MODE == 1 ? (nd < 4360 ? nd : (nd < 4608 ? -1 : nd - 248)) : nd;
#pragma unroll 8
    for (int i = 0; i < 32; ++i) { const int kk = 2 * i + (lane >> 5); float v = ns >= 0 ? W[(size_t)(k0 + kk) * Nsrc + ns] : 0.f; if (gain) v *= gain[k0 + kk]; scr[kk * 33 + (lane & 31)] = v; }
    LDS_WAIT(); asm volatile("" ::: "memory");
    const int c = lane & 7;
#pragma unroll
    for (int j = 0; j < 4; ++j) { const int n = (lane >> 3) + 8 * j; const LAS float* s = scr + (8 * c) * 33 + n;
        v4u o; o.x = cvtpk(s[0 * 33], s[1 * 33]); o.y = cvtpk(s[2 * 33], s[3 * 33]); o.z = cvtpk(s[4 * 33], s[5 * 33]); o.w = cvtpk(s[6 * 33], s[7 * 33]);
        *(GAS v4u*)(WT + (size_t)(n0 + n) * K + k0 + 8 * c) = o; }
    LDS_WAIT(); asm volatile("" ::: "memory");
}

DI void p0_prologue(Frame& F, const Args& A) {
    LAS float* scr = (LAS float*)(F.lds + RING_OFF + F.wave * 16384);
    const int gw = F.vcu * NWAVES + F.wave, NGW = F.G * NWAVES, lane = F.lane;
    unsigned char* ws = F.ws;
    constexpr int IT_IN = 32 * 400, IT_SQ = 32 * 64, IT_W1 = 32 * 256, IT_W2 = 128 * 64, IT_GLU = 8 * 16, IT_L = IT_IN + 2 * IT_SQ + IT_W1 + IT_W2 + IT_GLU;
    for (int it = gw; it < DEPTH * IT_L; it += NGW) {
        const int l = it / IT_L; int r = it % IT_L;
        if (r < IT_IN) { p0_transpose_item<1>(A.in[I_WIN] + (size_t)l * DM * NIN, DM, NIN, (bf16*)(ws + WS_WIN) + (size_t)l * NINP * DM, A.in[I_N1G] + l * DM, scr, r / 400, r % 400, lane); continue; } r -= IT_IN;
        if (r < IT_SQ) { p0_transpose_item<0>(A.in[I_WBR] + (size_t)l * DM * DM, DM, DM, (bf16*)(ws + WS_WB) + (size_t)l * DM * DM, nullptr, scr, r / 64, r % 64, lane); continue; } r -= IT_SQ;
        if (r < IT_SQ) { p0_transpose_item<0>(A.in[I_WOUT] + (size_t)l * DM * DM, DM, DM, (bf16*)(ws + WS_WO) + (size_t)l * DM * DM, nullptr, scr, r / 64, r % 64, lane); continue; } r -= IT_SQ;
        if (r < IT_W1) { p0_transpose_item<0>(A.in[I_WFF1] + (size_t)l * DM * DFF, DM, DFF, (bf16*)(ws + WS_W1) + (size_t)l * DFF * DM, A.in[I_N2G] + l * DM, scr, r / 256, r % 256, lane); continue; } r -= IT_W1;
        if (r < IT_W2) { p0_transpose_item<0>(A.in[I_WFF2] + (size_t)l * DFF * DM, DFF, DM, (bf16*)(ws + WS_W2) + (size_t)l * DM * DFF, nullptr, scr, r / 64, r % 64, lane); continue; } r -= IT_W2;
        p0_transpose_item<0>(A.in[I_GLUW] + (size_t)l * 512 * 512, 512, 512, (bf16*)(ws + WS_WG) + (size_t)l * 512 * 512, nullptr, scr, r / 16, r % 16, lane);
    }
    float* ssq0 = (float*)(ws + WS_SSQP);
    for (int m = gw; m < MPAD; m += NGW) {
        GAS v4u* o16 = (GAS v4u*)((bf16*)(ws + WS_XB) + (size_t)m * DM) + lane;
        if (m < pg8::MROWS) {
            const float* xrow = m < MP ? A.in[I_XP] + (size_t)m * DM : A.in[I_XS] + (size_t)(m - MP) * DM;
            const GAS f32x4* xr = (const GAS f32x4*)xrow + 2 * lane;
            float s = 0.f;
#pragma unroll
            for (int j = 0; j < 4; ++j) { const f32x4 a = xr[128 * j], b = xr[128 * j + 1];
                s += (a.x * a.x + a.y * a.y) + (a.z * a.z + a.w * a.w) + (b.x * b.x + b.y * b.y) + (b.z * b.z + b.w * b.w);
                v4u o; o.x = cvtpk(a.x, a.y); o.y = cvtpk(a.z, a.w); o.z = cvtpk(b.x, b.y); o.w = cvtpk(b.z, b.w); o16[64 * j] = o; }
            s = wave_sum(s);
            if (lane < 32) ssq0[(size_t)m * 32 + lane] = lane == 0 ? s : 0.f;
        } else {
#pragma unroll
            for (int j = 0; j < 4; ++j) o16[64 * j] = (v4u){0u, 0u, 0u, 0u};
            if (lane < 32) ssq0[(size_t)m * 32 + lane] = 0.f;
        }
    }
    const int gt = gw * 64 + lane, NGT = NGW * 64;
    {
        float* ct = (float*)(ws + WS_ROPE); float* st = ct + 4097 * 32;
        for (int e = gt; e < 4097 * 32; e += NGT) { const int p = e >> 5, i = e & 31; const double pos = p < 4096 ? (double)p : (double)PASTLEN;
            const float invf = powf(10000.0f, -(float)i / 32.0f); const float angf = (float)pos * invf;
            const double ang = (double)angf; const double n = rint(ang * 0.15915494309189535); const double r = ang - n * 6.283185307179586;
            ct[e] = cosf((float)r); st[e] = sinf((float)r); }
    }
    {
        f32x2v* abar = (f32x2v*)(ws + WS_ABAR); f32x2v* a32 = (f32x2v*)(ws + WS_A32); f32x2v* bbar = (f32x2v*)(ws + WS_BBAR);
        for (int e = gt; e < DEPTH * 32 * 64; e += NGT) { const int lg = e >> 6;
            const float lr = A.in[I_LAMR][e], li = A.in[I_LAMI][e], dt = expf(A.in[I_LOGDT][lg]);
            const float mag = expf(lr * dt), ar = mag * cosf(li * dt), ai = mag * sinf(li * dt);
            abar[e] = (f32x2v){ar, ai};
            const float m32 = expf(lr * dt * 32.f); a32[e] = (f32x2v){m32 * cosf(li * dt * 32.f), m32 * sinf(li * dt * 32.f)};
            const float nr = ar - 1.f, ni = ai, den = 1.f / (lr * lr + li * li); const float qr = (nr * lr + ni * li) * den, qi = (ni * lr - nr * li) * den;
            for (int c = 0; c < 16; ++c) { const float br = A.in[I_BRE][(size_t)e * 16 + c], bi = A.in[I_BIM][(size_t)e * 16 + c]; bbar[(size_t)e * 16 + c] = (f32x2v){qr * br - qi * bi, qr * bi + qi * br}; }
        }
        bf16* cf = (bf16*)(ws + WS_CFRAG);
        for (int e = gt; e < DEPTH * 32 * 4 * 64 * 8; e += NGT) { const int j = e & 7, ln = (e >> 3) & 63, kb = (e >> 9) & 3, lg = e >> 11;
            const int k = 32 * kb + 8 * (ln >> 4) + j, c = ln & 15, p = k >> 1;
            const float v = (k & 1) ? -A.in[I_CIM][((size_t)lg * 16 + c) * 64 + p] : A.in[I_CRE][((size_t)lg * 16 + c) * 64 + p];
            cf[e] = cvt1(v); }
    }
    {
        bf16* wt = (bf16*)(ws + WS_WTRIL);
        for (int e = gt; e < DEPTH * 4 * 128 * 128; e += NGT) { const int s = e & 127, t = (e >> 7) & 127; wt[e] = s <= t ? cvt1(A.in[I_SGW][e]) : (bf16)0; }
    }
}
struct Lyr {
    int l;
    const bf16* Z; const float* ZAB; bf16* YC;
    const float* cosT; const float* sinT;
    const Args* A; float* out; unsigned char* ws;
};

DI void attn_item(Frame& F, const Lyr& L, int item) {
    const int b = item >> 6, kvh = (item >> 5) & 1, blk = item & 31, tid = opaque_tid(), l = L.l;
    LAS bf16* Ks = (LAS bf16*)(F.lds); LAS bf16* VT = (LAS bf16*)(F.lds + 36864);
    {
        const int kap = tid & 255, tk = blk * 128 - 128 + kap;
        if (tid < 256) {
            if (tk >= 0) {
                const GAS v4u* src = (const GAS v4u*)(L.Z + (size_t)(b * SEQ + tk) * ZW + ZC_K + kvh * 64);
                float x[64]; float ss = 0.f;
#pragma unroll
                for (int i = 0; i < 8; ++i) { const v4u w = src[i]; x[8 * i] = bflo(w.x); x[8 * i + 1] = bfhi(w.x); x[8 * i + 2] = bflo(w.y); x[8 * i + 3] = bfhi(w.y); x[8 * i + 4] = bflo(w.z); x[8 * i + 5] = bfhi(w.z); x[8 * i + 6] = bflo(w.w); x[8 * i + 7] = bfhi(w.w); }
#pragma unroll
                for (int i = 0; i < 64; ++i) ss += x[i] * x[i];
                const float rs = __builtin_amdgcn_rsqf(ss * (1.f / 64.f) + pg8::RMS_EPS);
                const float* kg = L.A->in[I_KNG] + l * 64;
                const bool wr = blk == 31 && kap >= 128;
                GAS float* pk = (GAS float*)(L.out + O_PK + ((size_t)((l * NB + b) * 128 + (kap - 128)) * 2 + kvh) * 64);
                const GAS f32x4* ct = (const GAS f32x4*)(L.cosT + tk * 32); const GAS f32x4* st4 = (const GAS f32x4*)(L.sinT + tk * 32);
#pragma unroll
                for (int i4 = 0; i4 < 8; ++i4) { const f32x4 c = ct[i4], s = st4[i4]; float lo[4], hi[4];
#pragma unroll
                    for (int q = 0; q < 4; ++q) { const int i = 4 * i4 + q; const float x1 = x[i] * rs * kg[i], x2 = x[i + 32] * rs * kg[i + 32]; lo[q] = x1 * c[q] - x2 * s[q]; hi[q] = x2 * c[q] + x1 * s[q]; }
                    *(LAS v2u*)(Ks + kap * 72 + 4 * i4) = (v2u){cvtpk(lo[0], lo[1]), cvtpk(lo[2], lo[3])}; *(LAS v2u*)(Ks + kap * 72 + 32 + 4 * i4) = (v2u){cvtpk(hi[0], hi[1]), cvtpk(hi[2], hi[3])};
                    if (wr) { *(GAS f32x4*)(pk + 4 * i4) = (f32x4){lo[0], lo[1], lo[2], lo[3]}; *(GAS f32x4*)(pk + 32 + 4 * i4) = (f32x4){hi[0], hi[1], hi[2], hi[3]}; }
                    if (i4 & 1) asm volatile("" ::: "memory"); }
            } else {
#pragma unroll
                for (int i = 0; i < 8; ++i) *(LAS v4u*)(Ks + kap * 72 + 8 * i) = (v4u){0u, 0u, 0u, 0u};
            }
        } else {
            if (tk >= 0) {
                const GAS v4u* src = (const GAS v4u*)(L.Z + (size_t)(b * SEQ + tk) * ZW + ZC_V + kvh * 64);
#pragma unroll
                for (int i = 0; i < 8; ++i) { const v4u w = src[i]; const unsigned ww[4] = {w.x, w.y, w.z, w.w};
#pragma unroll
                    for (int q = 0; q < 4; ++q) { VT[(8 * i + 2 * q) * 264 + kap] = (bf16)(ww[q] & 0xffffu); VT[(8 * i + 2 * q + 1) * 264 + kap] = (bf16)(ww[q] >> 16); }
                    if (blk == 31 && kap >= 128) { GAS f32x4* pv = (GAS f32x4*)(L.out + O_PV + ((size_t)((l * NB + b) * 128 + (kap - 128)) * 2 + kvh) * 64) + 2 * i;
                        pv[0] = (f32x4){bflo(w.x), bfhi(w.x), bflo(w.y), bfhi(w.y)}; pv[1] = (f32x4){bflo(w.z), bfhi(w.z), bflo(w.w), bfhi(w.w)}; } }
            } else {
#pragma unroll
                for (int d = 0; d < 64; ++d) VT[d * 264 + kap] = (bf16)0;
            }
        }
    }
    __syncthreads();
    const int w = F.wave, lane = opaque_tid() & 63, r = lane & 31, h = lane >> 5, g = w >> 1, head = kvh * 4 + g;
    const float sinkl = L.A->in[I_SINK][l * 8 + head] * LOG2E;
    const float* qg = L.A->in[I_QNG] + l * 64;
#pragma unroll 1
    for (int sub = 0; sub < 2; ++sub) {
        const int q0 = (w & 1) * 64 + sub * 32, tq = blk * 128 + q0 + r;
        bf16x8 qf[4];
        {
            const GAS v4u* src = (const GAS v4u*)(L.Z + (size_t)(b * SEQ + tq) * ZW + ZC_Q + head * 64 + 8 * h);
            float x[4][8]; float ss = 0.f;
#pragma unroll
            for (int ks = 0; ks < 4; ++ks) { const v4u wv = src[2 * ks]; x[ks][0] = bflo(wv.x); x[ks][1] = bfhi(wv.x); x[ks][2] = bflo(wv.y); x[ks][3] = bfhi(wv.y); x[ks][4] = bflo(wv.z); x[ks][5] = bfhi(wv.z); x[ks][6] = bflo(wv.w); x[ks][7] = bfhi(wv.w);
#pragma unroll
                for (int j = 0; j < 8; ++j) ss += x[ks][j] * x[ks][j]; }
            ss += __shfl_xor(ss, 32);
            const float rs = __builtin_amdgcn_rsqf(ss * (1.f / 64.f) + pg8::RMS_EPS) ;
            const float sc = 0.125f * LOG2E;
            float o[4][8];
#pragma unroll
            for (int kp = 0; kp < 2; ++kp)
#pragma unroll
                for (int j = 0; j < 8; ++j) { const int i = 16 * kp + 8 * h + j; const float c = L.cosT[tq * 32 + i], s = L.sinT[tq * 32 + i];
                    const float x1 = x[kp][j] * rs * qg[i], x2 = x[kp + 2][j] * rs * qg[i + 32];
                    o[kp][j] = (x1 * c - x2 * s) * sc; o[kp + 2][j] = (x2 * c + x1 * s) * sc; }
#pragma unroll
            for (int ks = 0; ks < 4; ++ks) qf[ks] = pack8(o[ks][0], o[ks][1], o[ks][2], o[ks][3], o[ks][4], o[ks][5], o[ks][6], o[ks][7]);
        }
        f32x16 st[5];
#pragma unroll
        for (int kt = 0; kt < 5; ++kt) {
#pragma unroll
            for (int i = 0; i < 16; ++i) st[kt][i] = 0.f;
#pragma unroll
            for (int ks = 0; ks < 4; ++ks) { const bf16x8 a = *(const LAS bf16x8*)(Ks + (q0 + 32 * kt + r) * 72 + 16 * ks + 8 * h); st[kt] = MFMA32(a, qf[ks], st[kt]); }
        }
        float mx = sinkl; const int rlo = r + 1 - 4 * h, kmin = 128 - q0 - 4 * h;
#pragma unroll
        for (int kt = 0; kt < 5; ++kt)
#pragma unroll
            for (int i = 0; i < 16; ++i) { const int kk = 32 * kt + CR(i);
                const bool ok = (kk >= rlo) && (kk <= rlo + 127) && (blk > 0 || kk >= kmin);
                st[kt][i] = ok ? st[kt][i] : -INFINITY; mx = fmaxf(mx, st[kt][i]); }
        mx = fmaxf(mx, __shfl_xor(mx, 32));
        float sum = 0.f;
#pragma unroll
        for (int kt = 0; kt < 5; ++kt)
#pragma unroll
            for (int i = 0; i < 16; ++i) { const float p = __builtin_amdgcn_exp2f(st[kt][i] - mx); st[kt][i] = p; sum += p; }
        sum += __shfl_xor(sum, 32);
        const float inv = __builtin_amdgcn_rcpf(sum + __builtin_amdgcn_exp2f(sinkl - mx));
#pragma unroll
        for (int kt = 0; kt < 5; ++kt) st[kt] = st[kt] * inv;
        f32x16 o2[2];
#pragma unroll
        for (int dt = 0; dt < 2; ++dt) {
#pragma unroll
            for (int i = 0; i < 16; ++i) o2[dt][i] = 0.f; }
#pragma unroll
        for (int kt = 0; kt < 5; ++kt)
#pragma unroll
            for (int s = 0; s < 2; ++s) { const bf16x8 pa = pack_step(st[kt], s);
#pragma unroll
                for (int dt = 0; dt < 2; ++dt) { const LAS bf16* vp = VT + (dt * 32 + r) * 264 + q0 + 32 * kt + 16 * s + 4 * h;
                    const v2u lo = *(const LAS v2u*)vp, hi = *(const LAS v2u*)(vp + 8); const v4u bb = {lo.x, lo.y, hi.x, hi.y};
                    o2[dt] = MFMA32(pa, __builtin_bit_cast(bf16x8, bb), o2[dt]); } }
        GAS bf16* yo = (GAS bf16*)L.YC + (size_t)(b * SEQ + blk * 128 + q0 + 4 * h) * DM + head * 64 + r;
#pragma unroll
        for (int i = 0; i < 16; ++i) {
#pragma unroll
            for (int dt = 0; dt < 2; ++dt) yo[CR(i) * DM + dt * 32] = cvt1(o2[dt][i]); }
    }
    __syncthreads();
}
DI void sgate_item(Frame& F, const Lyr& L, int item) {
    const int b = item >> 7, n = (item >> 2) & 31, g = item & 3, tid = opaque_tid(), l = L.l;
    LAS bf16* VT = (LAS bf16*)(F.lds);
    const int t = tid >> 2, qd = tid & 3, m0 = b * SEQ + n * 128;
    {
        const GAS v4u* src = (const GAS v4u*)(L.Z + (size_t)(m0 + t) * ZW + ZC_GV + qd * 128);
        float ss = 0.f;
#pragma unroll 4
        for (int i = 0; i < 16; ++i) { const v4u w = src[i]; const unsigned ww[4] = {w.x, w.y, w.z, w.w};
#pragma unroll
            for (int q = 0; q < 4; ++q) { const float a = gelu_tanh(bflo(ww[q])), c = gelu_tanh(bfhi(ww[q])); ss += a * a + c * c; } }
        ss += __shfl_xor(ss, 1); ss += __shfl_xor(ss, 2);
        const float rs = __builtin_amdgcn_rsqf(ss * (1.f / 512.f) + pg8::RMS_EPS);
        const GAS v4u* sg = (const GAS v4u*)(L.Z + (size_t)(m0 + t) * ZW + ZC_GV + g * 128 + qd * 32);
        const float* gn = L.A->in[I_SGNG] + l * 512 + g * 128 + qd * 32;
#pragma unroll
        for (int i = 0; i < 4; ++i) { const v4u w = sg[i]; const unsigned ww[4] = {w.x, w.y, w.z, w.w};
#pragma unroll
            for (int q = 0; q < 4; ++q) { const int hc = qd * 32 + 8 * i + 2 * q; const float a = gelu_tanh(bflo(ww[q])) * rs * gn[8 * i + 2 * q], c = gelu_tanh(bfhi(ww[q])) * rs * gn[8 * i + 2 * q + 1];
                VT[hc * 136 + t] = cvt1(a); VT[(hc + 1) * 136 + t] = cvt1(c);
                if (n == 31) { float* pc = L.out + O_PCV + ((size_t)(l * NB + b) * 128 + t) * 512 + g * 128 + hc; pc[0] = a; pc[1] = c; } } }
    }
    __syncthreads();
    const int w = F.wave, lane = opaque_tid() & 63, r = lane & 31, h = lane >> 5, tt = w >> 1;
    const bf16* Wt = (const bf16*)(L.ws + WS_WTRIL) + (size_t)(l * 4 + g) * 16384;
    f32x16 acc[2];
#pragma unroll
    for (int i = 0; i < 2; ++i)
#pragma unroll
        for (int k = 0; k < 16; ++k) acc[i][k] = 0.f;
    for (int ks = 0; ks < 2 * (tt + 1); ++ks) {
        const bf16x8 a = *(const GAS bf16x8*)(Wt + (tt * 32 + r) * 128 + 16 * ks + 8 * h);
#pragma unroll
        for (int i = 0; i < 2; ++i) { const int ht = 2 * (w & 1) + i; const bf16x8 bq = *(const LAS bf16x8*)(VT + (ht * 32 + r) * 136 + 16 * ks + 8 * h); acc[i] = MFMA32(a, bq, acc[i]); }
    }
    const float* bias = L.A->in[I_SGB] + (l * 4 + g) * 128;
#pragma unroll
    for (int i = 0; i < 2; ++i) { const int hc = (2 * (w & 1) + i) * 32 + r;
        const GAS bf16* zu = (const GAS bf16*)L.Z + (size_t)(m0 + tt * 32 + 4 * h) * ZW + ZC_GU + g * 128 + hc; GAS bf16* yo = (GAS bf16*)L.YC + (size_t)(m0 + tt * 32 + 4 * h) * DM + 1024 + g * 128 + hc;
        const float* bs = bias + tt * 32 + 4 * h;
#pragma unroll
        for (int k = 0; k < 16; ++k) { const float u = gelu_tanh(bf2f(zu[CR(k) * ZW])); yo[CR(k) * DM] = cvt1(u * (acc[i][k] + bs[CR(k)])); } }
    __syncthreads();
}

DI void ssm_pass1_task(Frame& F, const Lyr& L, int task) {
    const int b = task >> 12, blk = (task >> 5) & 127, g = task & 31, p = opaque_tid() & 63, l = L.l;
    const int e = (l * 32 + g) * 64 + p;
    const f32x2v a = ((const f32x2v*)(L.ws + WS_ABAR))[e];
    f32x2v bb[16];
    const GAS f32x4* bp = (const GAS f32x4*)((const f32x2v*)(L.ws + WS_BBAR) + (size_t)e * 16);
#pragma unroll
    for (int c = 0; c < 8; ++c) { const f32x4 v = bp[c]; bb[2 * c] = (f32x2v){v.x, v.y}; bb[2 * c + 1] = (f32x2v){v.z, v.w}; }
    float sr = 0.f, si = 0.f;
    const bf16* zrow = L.Z + (size_t)(b * SEQ + blk * 32) * ZW + ZC_SU + g * 16;
#pragma unroll 2
    for (int t = 0; t < 32; ++t) {
        const GAS v4u* up = (const GAS v4u*)(zrow + (size_t)t * ZW); const v4u u0 = up[0], u1 = up[1];
        const unsigned ww[8] = {u0.x, u0.y, u0.z, u0.w, u1.x, u1.y, u1.z, u1.w};
        float br = 0.f, bi = 0.f;
#pragma unroll
        for (int q = 0; q < 8; ++q) { const float x0 = bflo(ww[q]), x1 = bfhi(ww[q]); br += bb[2 * q].x * x0 + bb[2 * q + 1].x * x1; bi += bb[2 * q].y * x0 + bb[2 * q + 1].y * x1; }
        const float nr = a.x * sr - a.y * si + br, ni = a.x * si + a.y * sr + bi; sr = nr; si = ni;
    }
    ((f32x2v*)(L.ws + WS_E))[((size_t)(b * 32 + g) * 128 + blk) * 64 + p] = (f32x2v){sr, si};
}
constexpr int DP_KF = 0, DP_VF = 32768, DP_QB = 65536, DP_KB = 82944, DP_AM = 100352, DP_GC = 116736, DP_BETA = DP_GC + 256, DP_EG = DP_GC + 512, DP_KEX = DP_GC + 768;
DI void dprep_item(Frame& F, const Lyr& L, int item) {
    const int b = item >> 8, h = (item >> 6) & 3, n = item & 63, l = L.l; int tid = opaque_tid();
    LAS float* Kf = (LAS float*)(F.lds + DP_KF); LAS float* Vf = (LAS float*)(F.lds + DP_VF);
    LAS bf16* Qb = (LAS bf16*)(F.lds + DP_QB); LAS bf16* Kb = (LAS bf16*)(F.lds + DP_KB);
    LAS float* Am = (LAS float*)(F.lds + DP_AM);
    LAS float* gcs = (LAS float*)(F.lds + DP_GC); LAS float* betas = (LAS float*)(F.lds + DP_BETA); LAS float* egs = (LAS float*)(F.lds + DP_EG); LAS float* kex = (LAS float*)(F.lds + DP_KEX);
    const int m0 = b * SEQ + n * 64;
    {
        const int t = tid >> 3, sub = tid & 7, tg = n * 64 + t;
#pragma unroll 1
        for (int wh = 0; wh < 3; ++wh) {
            const int ch0 = wh * 512 + h * 128 + sub * 16;
            const float* cw = L.A->in[I_CONVW] + (size_t)l * 4 * 1536 + ch0;
            float y[16];
#pragma unroll
            for (int c = 0; c < 16; ++c) y[c] = 0.f;
#pragma unroll
            for (int i = 0; i < 4; ++i) {
                if (tg - 3 + i >= 0) {
                    const GAS v4u* src = (const GAS v4u*)(L.Z + (size_t)(m0 + t - 3 + i) * ZW + ZC_DQ + ch0); const v4u a0 = src[0], a1 = src[1];
                    const unsigned ww[8] = {a0.x, a0.y, a0.z, a0.w, a1.x, a1.y, a1.z, a1.w};
#pragma unroll
                    for (int q = 0; q < 8; ++q) { y[2 * q] += cw[i * 1536 + 2 * q] * bflo(ww[q]); y[2 * q + 1] += cw[i * 1536 + 2 * q + 1] * bfhi(ww[q]); }
                    if (i == 3 && n == 63 && t >= 61) { float* pc = L.out + O_PC + ((size_t)(l * NB + b) * 3 + (t - 61)) * 1536 + ch0;
#pragma unroll
                        for (int q = 0; q < 8; ++q) { pc[2 * q] = bflo(ww[q]); pc[2 * q + 1] = bfhi(ww[q]); } }
                }
                asm volatile("" ::: "memory");
            }
            float ss = 0.f;
#pragma unroll
            for (int c = 0; c < 16; ++c) { y[c] = siluf_(y[c]); ss += y[c] * y[c]; }
            ss += __shfl_xor(ss, 1); ss += __shfl_xor(ss, 2); ss += __shfl_xor(ss, 4);
            const float rn = wh == 0 ? __builtin_amdgcn_rsqf(ss + pg8::RMS_EPS) * 0.08838834764831845f : (wh == 1 ? __builtin_amdgcn_rsqf(ss + pg8::RMS_EPS) : 1.0f);
            LAS bf16* bdst = (wh == 0 ? Qb : Kb) + t * 136 + sub * 16; LAS float* fdst = (wh == 1 ? Kf : Vf) + t * 128 + sub * 16;
#pragma unroll
            for (int c = 0; c < 16; c += 2) { const float v0 = y[c] * rn, v1 = y[c + 1] * rn;
                if (wh < 2) *(LAS unsigned*)(bdst + c) = cvtpk(v0, v1);
                if (wh > 0) { fdst[c] = v0; fdst[c + 1] = v1; } }
        }
    }
    tid = opaque_tid();
    if (tid < 64) {
        const int t = tid; const float* zab = L.ZAB + (size_t)(m0 + t) * 8;
        const float gg = -__expf(L.A->in[I_ALOG][l * 4 + h]) * softplusf_(zab[h] + L.A->in[I_DTB][l * 4 + h]);
        float c = gg;
#pragma unroll
        for (int o = 1; o < 64; o <<= 1) { const float v = __shfl_up(c, o); if (t >= o) c += v; }
        const float clast = __shfl(c, 63);
        gcs[t] = c; betas[t] = sigmoidf_(zab[4 + h]); egs[t] = __expf(c); kex[t] = __expf(clast - c);
        if (t == 63) ((float*)(L.ws + WS_GE))[item] = __expf(c);
    }
    __syncthreads();
    {
        const int w = F.wave, lane = opaque_tid() & 63, r = lane & 31, hh = lane >> 5, which = w >> 2, tt = (w >> 1) & 1, st = w & 1;
        f32x16 acc;
#pragma unroll
        for (int k = 0; k < 16; ++k) acc[k] = 0.f;
        const LAS bf16* Ap = (which ? Qb : Kb) + (tt * 32 + r) * 136 + 8 * hh; const LAS bf16* Bp = Kb + (st * 32 + r) * 136 + 8 * hh;
#pragma unroll
        for (int ks = 0; ks < 8; ++ks) acc = MFMA32(*(const LAS bf16x8*)(Ap + 16 * ks), *(const LAS bf16x8*)(Bp + 16 * ks), acc);
        bf16* QKo = (bf16*)(L.ws + WS_QK) + (size_t)item * 4096;
        const int s = st * 32 + r; const float gs = gcs[s];
        const int tb = tt * 32 + 4 * hh; const LAS float* gct = gcs + tb; const LAS float* bet = betas + tb; LAS float* Amp = Am + tb * 64 + s; bf16* qko = QKo + frag_off(tb, s, 4);
#pragma unroll
        for (int k = 0; k < 16; ++k) { const int t = tb + CR(k); const float dec = __expf(gct[CR(k)] - gs);
            if (which == 0) Amp[CR(k) * 64] = t > s ? bet[CR(k)] * acc[k] * dec : 0.f;
            else qko[CR(k) * 8] = cvt1(t >= s ? acc[k] * dec : 0.f); }
    }
    __syncthreads();
    tid = opaque_tid();
    {
        const int u = tid & 255;
        if (tid < 256) { const int t = u >> 2, d0 = (u & 3) * 32; bf16* QG = (bf16*)(L.ws + WS_QG) + (size_t)item * 8192; const float e = egs[t];
#pragma unroll 2
          for (int d = 0; d < 32; d += 4) { const int dk = d0 + d;
              const v2u o = {cvtpk(bf2f(Qb[t * 136 + dk]) * e, bf2f(Qb[t * 136 + dk + 1]) * e), cvtpk(bf2f(Qb[t * 136 + dk + 2]) * e, bf2f(Qb[t * 136 + dk + 3]) * e)};
              *(GAS v2u*)(QG + frag_off(t, dk, 8)) = o; } }
        else { const int dk = u >> 1, s0 = (u & 1) * 32; bf16* KE = (bf16*)(L.ws + WS_KE) + (size_t)item * 8192;
#pragma unroll 2
          for (int s = 0; s < 32; s += 4) { const int tk = s0 + s;
              const v2u o = {cvtpk(Kf[tk * 128 + dk] * kex[tk], Kf[(tk + 1) * 128 + dk] * kex[tk + 1]), cvtpk(Kf[(tk + 2) * 128 + dk] * kex[tk + 2], Kf[(tk + 3) * 128 + dk] * kex[tk + 3])};
              *(GAS v2u*)(KE + frag_off(dk, tk, 4)) = o; } }
    }
    __syncthreads();
    tid = opaque_tid();
    if (tid < 256) {
        const int c = tid; const bool isw = c >= 128; LAS float* X = isw ? Kf + (c - 128) : Vf + c;
        float* U0 = (float*)(L.ws + WS_U0) + (size_t)item * 8192 + (c & 127); bf16* WN = (bf16*)(L.ws + WS_WN) + (size_t)item * 8192;
#pragma unroll 1
        for (int tb = 0; tb < 4; ++tb) {
            float a[16];
#pragma unroll
            for (int i = 0; i < 16; ++i) { const int t = tb * 16 + i; a[i] = betas[t] * (isw ? egs[t] : 1.0f) * X[t * 128]; }
#pragma unroll 1
            for (int sb = 0; sb < tb; ++sb) {
                float xs[16];
#pragma unroll
                for (int j = 0; j < 16; ++j) xs[j] = X[(sb * 16 + j) * 128];
#pragma unroll
                for (int i = 0; i < 16; ++i) { const LAS f32x4* ar = (const LAS f32x4*)(Am + (tb * 16 + i) * 64 + sb * 16);
#pragma unroll
                    for (int j4 = 0; j4 < 4; ++j4) { const f32x4 av = ar[j4]; a[i] -= av.x * xs[4 * j4]; a[i] -= av.y * xs[4 * j4 + 1]; a[i] -= av.z * xs[4 * j4 + 2]; a[i] -= av.w * xs[4 * j4 + 3]; }
                    if ((i & 3) == 3) asm volatile("" ::: "memory"); }
            }
#pragma unroll
            for (int i = 1; i < 16; ++i) { const LAS float* ar = Am + (tb * 16 + i) * 64 + tb * 16;
#pragma unroll
                for (int j = 0; j < i; ++j) a[i] -= ar[j] * a[j];
                if ((i & 3) == 3) asm volatile("" ::: "memory"); }
#pragma unroll
            for (int i = 0; i < 16; ++i) { const int t = tb * 16 + i; X[t * 128] = a[i];
                if (!isw) U0[t * 128] = a[i]; else WN[frag_off(t, c - 128, 8)] = cvt1(-a[i]); }
        }
    }
    __syncthreads();
}
DI void dscan_task(Frame& F, const Lyr& L, int task) {
    const int bh = task >> 2, sl = task & 3, b = bh >> 2, h = bh & 3, lane = opaque_tid() & 63, r = lane & 31, hh = lane >> 5, dv0 = sl * 32, l = L.l;
    f32x16 S[4];
#pragma unroll
    for (int d = 0; d < 4; ++d)
#pragma unroll
        for (int k = 0; k < 16; ++k) S[d][k] = 0.f;
    float* OD = (float*)(L.ws + WS_OD);
#pragma unroll 1
    for (int n = 0; n < 64; ++n) {
        const size_t item = (size_t)bh * 64 + n;
        const GAS bf16x8* WN = (const GAS bf16x8*)((const bf16*)(L.ws + WS_WN) + item * 8192) + lane;
        const GAS bf16x8* QG = (const GAS bf16x8*)((const bf16*)(L.ws + WS_QG) + item * 8192) + lane;
        const GAS bf16x8* QK = (const GAS bf16x8*)((const bf16*)(L.ws + WS_QK) + item * 4096) + lane;
        const GAS bf16x8* KE = (const GAS bf16x8*)((const bf16*)(L.ws + WS_KE) + item * 8192) + lane;
        const GAS float* U0 = (const GAS float*)((const float*)(L.ws + WS_U0) + item * 8192) + (4 * hh) * 128 + dv0 + r;
        const float ge = ((const float*)(L.ws + WS_GE))[item];
        bf16x8 Sb[8];
#pragma unroll
        for (int d = 0; d < 4; ++d) { Sb[2 * d] = pack_step(S[d], 0); Sb[2 * d + 1] = pack_step(S[d], 1); }
        f32x16 U[2], O[2];
#pragma unroll
        for (int rt = 0; rt < 2; ++rt) {
#pragma unroll
            for (int k = 0; k < 16; ++k) { U[rt][k] = U0[(rt * 32 + CR(k)) * 128]; O[rt][k] = 0.f; }
#pragma unroll
            for (int ks = 0; ks < 8; ++ks) U[rt] = MFMA32(WN[(rt * 8 + ks) * 64], Sb[ks], U[rt]);
#pragma unroll
            for (int ks = 0; ks < 8; ++ks) O[rt] = MFMA32(QG[(rt * 8 + ks) * 64], Sb[ks], O[rt]);
            asm volatile("" ::: "memory");
        }
        bf16x8 Ub[4];
#pragma unroll
        for (int rt = 0; rt < 2; ++rt) { Ub[2 * rt] = pack_step(U[rt], 0); Ub[2 * rt + 1] = pack_step(U[rt], 1); }
#pragma unroll
        for (int rt = 0; rt < 2; ++rt)
#pragma unroll
            for (int ks = 0; ks < 4; ++ks) O[rt] = MFMA32(QK[(rt * 4 + ks) * 64], Ub[ks], O[rt]);
#pragma unroll
        for (int d = 0; d < 4; ++d) { S[d] = S[d] * ge;
#pragma unroll
            for (int ks = 0; ks < 4; ++ks) S[d] = MFMA32(KE[(d * 4 + ks) * 64], Ub[ks], S[d]); }
        GAS float* ODp = (GAS float*)OD + (size_t)(b * SEQ + n * 64 + 4 * hh) * 512 + h * 128 + dv0 + r;
#pragma unroll
        for (int rt = 0; rt < 2; ++rt)
#pragma unroll
            for (int k = 0; k < 16; ++k) ODp[(rt * 32 + CR(k)) * 512] = O[rt][k];
    }
    GAS float* PD = (GAS float*)(L.out + O_PD + ((size_t)(l * NB + b) * 4 + h) * 16384) + (4 * hh) * 128 + dv0 + r;
#pragma unroll
    for (int d = 0; d < 4; ++d)
#pragma unroll
        for (int k = 0; k < 16; ++k) PD[(d * 32 + CR(k)) * 128] = S[d][k];
}

DI void ssm_pass2_item(Frame& F, const Lyr& L, int item) {
    const int b = item >> 7, blk = item & 127, w = F.wave, lane = opaque_tid() & 63, l = L.l;
    LAS bf16* Sw = (LAS bf16*)(F.lds + w * 8704); LAS bf16* Y = (LAS bf16*)(F.lds + 69632);
    const int m0 = b * SEQ + blk * 32;
#pragma unroll 1
    for (int gi = 0; gi < 4; ++gi) {
        const int g = 4 * w + gi, p = lane, e = (l * 32 + g) * 64 + p;
        const f32x2v a = ((const f32x2v*)(L.ws + WS_ABAR))[e], a32 = ((const f32x2v*)(L.ws + WS_A32))[e];
        float sr = 0.f, si = 0.f;
        const GAS f32x2v* E = (const GAS f32x2v*)(L.ws + WS_E) + (size_t)(b * 32 + g) * 128 * 64 + p;
#pragma unroll 4
        for (int i = 0; i < blk; ++i) { const f32x2v ev = E[i * 64]; const float nr = a32.x * sr - a32.y * si + ev.x, ni = a32.x * si + a32.y * sr + ev.y; sr = nr; si = ni; }
        f32x2v bb[16];
        const GAS f32x4* bp = (const GAS f32x4*)((const f32x2v*)(L.ws + WS_BBAR) + (size_t)e * 16);
#pragma unroll
        for (int c = 0; c < 8; ++c) { const f32x4 v = bp[c]; bb[2 * c] = (f32x2v){v.x, v.y}; bb[2 * c + 1] = (f32x2v){v.z, v.w}; }
        const bf16* zrow = L.Z + (size_t)m0 * ZW + ZC_SU + g * 16;
#pragma unroll 2
        for (int t = 0; t < 32; ++t) {
            const GAS v4u* up = (const GAS v4u*)(zrow + (size_t)t * ZW); const v4u u0 = up[0], u1 = up[1];
            const unsigned ww[8] = {u0.x, u0.y, u0.z, u0.w, u1.x, u1.y, u1.z, u1.w};
            float br = 0.f, bi = 0.f;
#pragma unroll
            for (int q = 0; q < 8; ++q) { const float x0 = bflo(ww[q]), x1 = bfhi(ww[q]); br += bb[2 * q].x * x0 + bb[2 * q + 1].x * x1; bi += bb[2 * q].y * x0 + bb[2 * q + 1].y * x1; }
            const float nr = a.x * sr - a.y * si + br, ni = a.x * si + a.y * sr + bi; sr = nr; si = ni;
            *(LAS unsigned*)(Sw + t * 136 + 2 * p) = cvtpk(sr, si);
        }
        if (blk == 127) { L.out[O_PSR + (size_t)((l * NB + b) * 32 + g) * 64 + p] = sr; L.out[O_PSI + (size_t)((l * NB + b) * 32 + g) * 64 + p] = si; }
        LDS_WAIT(); asm volatile("" ::: "memory");
        const int r16 = lane & 15, q4 = lane >> 4;
        const GAS bf16x8* Cf = (const GAS bf16x8*)((const bf16*)(L.ws + WS_CFRAG) + (size_t)(l * 32 + g) * 2048) + lane;
        f32x4 yy[2] = {{0.f, 0.f, 0.f, 0.f}, {0.f, 0.f, 0.f, 0.f}};
#pragma unroll
        for (int kb = 0; kb < 4; ++kb) { const bf16x8 cb = Cf[kb * 64];
#pragma unroll
            for (int rt = 0; rt < 2; ++rt) yy[rt] = MFMA16(*(const LAS bf16x8*)(Sw + (rt * 16 + r16) * 136 + 32 * kb + 8 * q4), cb, yy[rt]); }
        const float dsk = L.A->in[I_SSMD][l * 512 + g * 16 + r16];
#pragma unroll
        for (int rt = 0; rt < 2; ++rt)
#pragma unroll
            for (int k = 0; k < 4; ++k) { const int t = rt * 16 + 4 * q4 + k; const float u = bf2f(zrow[(size_t)t * ZW + r16]);
                Y[t * 520 + g * 16 + r16] = cvt1(gelu_tanh(yy[rt][k] + dsk * u)); }
        LDS_WAIT(); asm volatile("" ::: "memory");
    }
    __syncthreads();
    {
        const int r = lane & 31, hh = lane >> 5;
        const bf16* Wg = (const bf16*)(L.ws + WS_WG) + (size_t)l * 262144;
        f32x16 acc[2];
#pragma unroll
        for (int ct = 0; ct < 2; ++ct)
#pragma unroll
            for (int k = 0; k < 16; ++k) acc[ct][k] = 0.f;
#pragma unroll 4
        for (int ks = 0; ks < 32; ++ks) { const bf16x8 a = *(const LAS bf16x8*)(Y + r * 520 + 16 * ks + 8 * hh);
#pragma unroll
            for (int ct = 0; ct < 2; ++ct) acc[ct] = MFMA32(a, *(const GAS bf16x8*)(Wg + (size_t)(64 * w + 32 * ct + r) * 512 + 16 * ks + 8 * hh), acc[ct]); }
#pragma unroll
        for (int ct = 0; ct < 2; ++ct) { const int nn = 64 * w + 32 * ct + r; const float bg = L.A->in[I_GLUB][l * 512 + nn];
            const LAS bf16* Yp = Y + (4 * hh) * 520 + nn; GAS bf16* yo = (GAS bf16*)L.YC + (size_t)(m0 + 4 * hh) * DM + 512 + nn;
#pragma unroll
            for (int k = 0; k < 16; ++k) { const float y = bf2f(Yp[CR(k) * 520]); yo[CR(k) * DM] = cvt1(y * sigmoidf_(acc[ct][k] + bg)); } }
    }
    __syncthreads();
}

DI void dpost_rows(Frame& F, const Lyr& L) {
    const int gw = F.vcu * NWAVES + F.wave, NGW = F.G * NWAVES, lane = opaque_tid() & 63, l = L.l;
    const float* OD = (const float*)(L.ws + WS_OD);
    for (int rw = gw; rw < MP * 4; rw += NGW) { const int m = rw >> 2, h = rw & 3;
        const f32x2v o = *(const GAS f32x2v*)(OD + (size_t)m * 512 + h * 128 + 2 * lane);
        const float ss = wave_sum(o.x * o.x + o.y * o.y);
        const float rs = __builtin_amdgcn_rsqf(ss * (1.f / 128.f) + pg8::RMS_EPS);
        const unsigned zg = *(const GAS unsigned*)(L.Z + (size_t)m * ZW + ZC_DG + h * 128 + 2 * lane);
        const float g0 = L.A->in[I_DNG][l * 128 + 2 * lane], g1 = L.A->in[I_DNG][l * 128 + 2 * lane + 1];
        *(GAS unsigned*)(L.YC + (size_t)m * DM + 1536 + h * 128 + 2 * lane) = cvtpk(o.x * rs * g0 * siluf_(bflo(zg)), o.y * rs * g1 * siluf_(bfhi(zg)));
    }
}
DI float block_sum(LAS float* red, float v, int tid, int grp_waves) {
    v = wave_sum(v);
    __syncthreads();
    if ((tid & 63) == 0) red[tid >> 6] = v;
    __syncthreads();
    const int w = tid >> 6, g0 = (w / grp_waves) * grp_waves; float s = 0.f;
    for (int i = 0; i < grp_waves; ++i) s += red[g0 + i];
    return s;
}
DI void sample_item(Frame& F, const Lyr& L, int b) {
    const int tid = opaque_tid(), lane = tid & 63, w = F.wave, l = L.l, row = MP + b;
    const bf16* zrow = L.Z + (size_t)row * ZW; const float* zab = L.ZAB + (size_t)row * 8;
    bf16* yrow = L.YC + (size_t)row * DM;
    LAS float* fl = (LAS float*)F.lds;
    LAS float* q_l = fl;
    LAS float* k_l = fl + 512;
    LAS float* v_l = fl + 640;
    LAS float* sc_l = fl + 768;
    LAS float* red = fl + 1792;
    LAS float* s_l = fl + 1808;
    LAS float* y_l = fl + 5904;
    LAS float* dq_l = fl + 6416;
    LAS float* dk_l = fl + 6928;
    LAS float* dv_l = fl + 7440;
    const Args& A = *L.A;
    const float* cosr = L.cosT + 4096 * 32; const float* sinr = L.sinT + 4096 * 32;
    {
        const int d = lane, i = d & 31;
        { const float x = bf2f(zrow[ZC_Q + tid]); const float ss = wave_sum(x * x); const float xn = x * __builtin_amdgcn_rsqf(ss * (1.f / 64.f) + pg8::RMS_EPS) * A.in[I_QNG][l * 64 + d];
          const float pr = __shfl_xor(xn, 32); const float c = cosr[i], s = sinr[i]; q_l[tid] = (d < 32 ? xn * c - pr * s : xn * c + pr * s) * 0.125f; }
        if (w < 2) { const float x = bf2f(zrow[ZC_K + tid]); const float ss = wave_sum(x * x); const float xn = x * __builtin_amdgcn_rsqf(ss * (1.f / 64.f) + pg8::RMS_EPS) * A.in[I_KNG][l * 64 + d];
          const float pr = __shfl_xor(xn, 32); const float c = cosr[i], s = sinr[i]; k_l[tid] = d < 32 ? xn * c - pr * s : xn * c + pr * s; }
        else if (w < 4) v_l[tid - 128] = bf2f(zrow[ZC_V + tid - 128]);
    }
    __syncthreads();
    {
        const float* ck = A.in[I_CK] + (size_t)(l * NS + b) * 128 * 128; const float* cv = A.in[I_CV] + (size_t)(l * NS + b) * 128 * 128;
        float* ok = L.out + O_SK + (size_t)(l * NS + b) * 16384; float* ov = L.out + O_SV + (size_t)(l * NS + b) * 16384;
        for (int idx = tid; idx < 16384; idx += 512) { const int i = idx >> 7, c = idx & 127; ok[idx] = i < 127 ? ck[idx + 128] : k_l[c]; ov[idx] = i < 127 ? cv[idx + 128] : v_l[c]; }
        const int head = w, kvh = head >> 2;
        float sc[2];
#pragma unroll
        for (int jj = 0; jj < 2; ++jj) { const int j = lane + 64 * jj; float acc = 0.f;
            if (j < 127) { const GAS f32x4* kp = (const GAS f32x4*)(ck + (size_t)(j + 1) * 128 + kvh * 64);
#pragma unroll 4
                for (int d4 = 0; d4 < 16; ++d4) { const f32x4 kv = kp[d4]; const LAS float* qp = q_l + head * 64 + 4 * d4; acc += kv.x * qp[0] + kv.y * qp[1] + kv.z * qp[2] + kv.w * qp[3]; } }
            else { for (int d = 0; d < 64; ++d) acc += k_l[kvh * 64 + d] * q_l[head * 64 + d]; }
            sc[jj] = acc; }
        const float sink = A.in[I_SINK][l * 8 + head];
        const float mx = fmaxf(wave_max(fmaxf(sc[0], sc[1])), sink);
        const float p0 = __expf(sc[0] - mx), p1 = __expf(sc[1] - mx);
        const float inv = 1.f / (wave_sum(p0 + p1) + __expf(sink - mx));
        sc_l[head * 128 + lane] = p0 * inv; sc_l[head * 128 + lane + 64] = p1 * inv;
        LDS_WAIT(); asm volatile("" ::: "memory");
        float o = 0.f;
        for (int j = 0; j < 127; ++j) o += sc_l[head * 128 + j] * cv[(size_t)(j + 1) * 128 + kvh * 64 + lane];
        o += sc_l[head * 128 + 127] * v_l[kvh * 64 + lane];
        yrow[head * 64 + lane] = cvt1(o);
    }
    __syncthreads();
    {
#pragma unroll 1
        for (int k = 0; k < 4; ++k) { const int idx = tid + 512 * k, g = idx >> 6, e = l * 2048 + idx;
            const f32x2v a = ((const f32x2v*)(L.ws + WS_ABAR))[e];
            const float s0r = A.in[I_SSR][(size_t)(l * NS + b) * 2048 + idx], s0i = A.in[I_SSI][(size_t)(l * NS + b) * 2048 + idx];
            float br = 0.f, bi = 0.f; const f32x2v* bbp = (const f32x2v*)(L.ws + WS_BBAR) + (size_t)e * 16;
#pragma unroll
            for (int c = 0; c < 16; ++c) { const float u = bf2f(zrow[ZC_SU + g * 16 + c]); const f32x2v bv = bbp[c]; br += bv.x * u; bi += bv.y * u; }
            const float sr = a.x * s0r - a.y * s0i + br, si = a.x * s0i + a.y * s0r + bi;
            L.out[O_SSR + (size_t)(l * NS + b) * 2048 + idx] = sr; L.out[O_SSI + (size_t)(l * NS + b) * 2048 + idx] = si;
            s_l[2 * idx] = sr; s_l[2 * idx + 1] = si; }
    }
    __syncthreads();
    {
        const int g = tid >> 4, c = tid & 15; const float* cr = A.in[I_CRE] + ((size_t)(l * 32 + g) * 16 + c) * 64; const float* ci = A.in[I_CIM] + ((size_t)(l * 32 + g) * 16 + c) * 64;
        float acc = 0.f;
        for (int p = 0; p < 64; ++p) acc += cr[p] * s_l[2 * (g * 64 + p)] - ci[p] * s_l[2 * (g * 64 + p) + 1];
        acc += A.in[I_SSMD][l * 512 + tid] * bf2f(zrow[ZC_SU + tid]);
        y_l[tid] = gelu_tanh(acc);
    }
    __syncthreads();
    {
        const float* gw = A.in[I_GLUW] + (size_t)l * 262144 + tid; float acc = A.in[I_GLUB][l * 512 + tid];
#pragma unroll 8
        for (int k = 0; k < 512; ++k) acc += y_l[k] * gw[(size_t)k * 512];
        yrow[512 + tid] = cvt1(y_l[tid] * sigmoidf_(acc));
    }
    {
        const float u = gelu_tanh(bf2f(zrow[ZC_GU + tid])), v = gelu_tanh(bf2f(zrow[ZC_GV + tid]));
        const float ss = block_sum(red, v * v, tid, 8);
        const float vn = v * __builtin_amdgcn_rsqf(ss * (1.f / 512.f) + pg8::RMS_EPS) * A.in[I_SGNG][l * 512 + tid];
        L.out[O_SCV + (size_t)(l * NS + b) * 512 + tid] = vn;
        const int g = tid >> 7;
        yrow[1024 + tid] = cvt1(u * (A.in[I_SGW][(size_t)(l * 4 + g) * 16384] * vn + A.in[I_SGB][(l * 4 + g) * 128]));
    }
    {
        const int h = tid >> 7, d = tid & 127;
        float y3[3];
#pragma unroll
        for (int k = 0; k < 3; ++k) { const int ch = tid + 512 * k; const float x = bf2f(zrow[ZC_DQ + ch]);
            const float* sc0 = A.in[I_SC] + (size_t)(l * NS + b) * 3 * 1536 + ch; const float* cw = A.in[I_CONVW] + (size_t)l * 4 * 1536 + ch;
            const float b0 = sc0[0], b1 = sc0[1536], b2 = sc0[3072];
            y3[k] = siluf_(cw[0] * b0 + cw[1536] * b1 + cw[3072] * b2 + cw[4608] * x);
            float* oc = L.out + O_SC + (size_t)(l * NS + b) * 3 * 1536 + ch; oc[0] = b1; oc[1536] = b2; oc[3072] = x; }
        const float sq = block_sum(red, y3[0] * y3[0], tid, 2), sk = block_sum(red, y3[1] * y3[1], tid, 2);
        const float qn = y3[0] * __builtin_amdgcn_rsqf(sq + pg8::RMS_EPS) * 0.08838834764831845f, kn = y3[1] * __builtin_amdgcn_rsqf(sk + pg8::RMS_EPS);
        dq_l[tid] = qn; dk_l[tid] = kn; dv_l[tid] = y3[2];
        const float qk = block_sum(red, qn * kn, tid, 2);
        const float gg = -__expf(A.in[I_ALOG][l * 4 + h]) * softplusf_(zab[h] + A.in[I_DTB][l * 4 + h]);
        const float eg = __expf(gg), beta = sigmoidf_(zab[4 + h]);
        const float* S0 = A.in[I_SD] + ((size_t)(l * NS + b) * 4 + h) * 16384 + d;
        float kS = 0.f;
#pragma unroll 8
        for (int k = 0; k < 128; ++k) kS += dk_l[h * 128 + k] * S0[(size_t)k * 128];
        const float U = beta * (dv_l[tid] - eg * kS);
        float* S1 = L.out + O_SD + ((size_t)(l * NS + b) * 4 + h) * 16384 + d;
        float o = 0.f;
#pragma unroll 8
        for (int k = 0; k < 128; ++k) { const float sn = eg * S0[(size_t)k * 128] + dk_l[h * 128 + k] * U; S1[(size_t)k * 128] = sn; o += dq_l[h * 128 + k] * sn; }
        (void)qk;
        const float so = block_sum(red, o * o, tid, 2);
        yrow[1536 + tid] = cvt1(o * __builtin_amdgcn_rsqf(so * (1.f / 128.f) + pg8::RMS_EPS) * A.in[I_DNG][l * 128 + d] * siluf_(bf2f(zrow[ZC_DG + tid])));
    }
    __syncthreads();
}
__global__ void __launch_bounds__(NWAVES * 64, 2) hybrid_fwd(Args args) {
    extern __shared__ __attribute__((aligned(16))) unsigned char lds[];
    Frame F;
    F.lds = (LAS unsigned char*)lds;
    F.MISC = (volatile LAS unsigned*)(F.lds + MISC_OFF);
    F.tid = threadIdx.x; F.lane = F.tid & 63; F.wave = __builtin_amdgcn_readfirstlane(F.tid >> 6);
    F.G = gridDim.x; { const int bx = blockIdx.x; F.vcu = (F.G % 8 == 0) ? (bx % 8) * (F.G / 8) + bx / 8 : bx; }
    F.ws = args.ws; F.ctl = (gu32*)(args.ws + WS_CTL);
    for (int u = F.tid; u < (LDS_BYTES - LDSCTL_OFF) / 4; u += NWAVES * 64) ((LAS unsigned*)(F.lds + LDSCTL_OFF))[u] = 0u;
    __syncthreads();
    XcdBarrier bar = xcd_barrier_post((unsigned*)(F.ctl + CW_BAR), F.MISC + 8);
    unsigned char* ws = args.ws;
#define GRID_BAR() do { XcdBarrier b2_ = bar; asm volatile("" : "+s"(b2_.bar), "+s"(b2_.x)); xcd_barrier(b2_); } while (0)
    const int bid = blockIdx.x, G = F.G;

#ifndef NO_P0
    p0_prologue(F, args);
#endif
    GRID_BAR();

#pragma unroll 1
    for (int l = 0; l < DEPTH; ++l) {
        asm volatile("" : "+s"(ws));
        float* ssq = (float*)(ws + WS_SSQP);
        bf16* XB = (bf16*)(ws + WS_XB); bf16* Zb = (bf16*)(ws + WS_Z); bf16* Gb = (bf16*)(ws + WS_G); bf16* YC = (bf16*)(ws + WS_YCAT); bf16* GS = (bf16*)(ws + WS_GS); bf16* Hb = (bf16*)(ws + WS_H);
        float* ZAB = (float*)(ws + WS_ZAB);
        float* outp = args.out; asm volatile("" : "+s"(outp));
        float* Xp = outp + O_YP; float* Xs = outp + O_YS;
        Lyr L; L.l = l; L.Z = Zb; L.ZAB = ZAB; L.YC = YC; L.cosT = (const float*)(ws + WS_ROPE); L.sinT = L.cosT + 4097 * 32; L.A = &args; L.out = outp; L.ws = ws;
        {
            pg8::Gemm g{XB, (const bf16*)(ws + WS_WIN) + (size_t)l * NINP * DM, MPAD, NINP, DM}; pg8::StaticOrder S; S.init(MPAD, NINP, G, bid);
            pg8::EpiIn E{Zb, ZAB, Gb, ssq + (size_t)(2 * l) * MPAD * 32};
#ifndef NO_GIN
            pg8::gemm_phase<pg8::EpiIn, pg8::StaticOrder, true, true>(F.lds + RING_OFF, g, S, E);
#endif
        }
        GRID_BAR();
        for (int it = bid; it < 1920; it += G) {
#ifndef NO_DPREP
            if (it < 512) dprep_item(F, L, it); else
#endif
#ifndef NO_ATTN
            if (it < 640) attn_item(F, L, it - 512); else
#endif
#ifndef NO_SGATE
            if (it < 896) sgate_item(F, L, it - 640); else
#endif
#ifndef NO_SSM1
            ssm_pass1_task(F, L, (it - 896) * 8 + F.wave);
#else
            {}
#endif
        }
        GRID_BAR();
#ifndef NO_DSCAN
        if (bid < 32) { if (F.wave == 0) dscan_task(F, L, bid); }
        else
#endif
        for (int it = bid - 32; it < 288; it += G - 32) {
#ifndef NO_SAMPLE
            if (it < 32) sample_item(F, L, it); else
#endif
#ifndef NO_SSM2
            ssm_pass2_item(F, L, it - 32);
#else
            {}
#endif
        }
        GRID_BAR();
#ifndef NO_DPOST
        dpost_rows(F, L);
#endif
        GRID_BAR();
        {
            pg8::Gemm g{YC, (const bf16*)(ws + WS_WB) + (size_t)l * DM * DM, MPAD, DM, DM}; pg8::StaticOrder S; S.init(MPAD, DM, G, bid);
            pg8::EpiGate E{Gb, GS};
#ifndef NO_GBR
            pg8::gemm_phase<pg8::EpiGate, pg8::StaticOrder, true, true>(F.lds + RING_OFF, g, S, E);
#endif
        }
        GRID_BAR();
        {
            pg8::Gemm g{GS, (const bf16*)(ws + WS_WO) + (size_t)l * DM * DM, MPAD, DM, DM}; pg8::StaticOrder S; S.init(MPAD, DM, G, bid);
            pg8::EpiRes E{l == 0 ? args.in[I_XP] : Xp, l == 0 ? args.in[I_XS] : Xs, Xp, Xs, XB, ssq + (size_t)(2 * l + 1) * MPAD * 32};
#ifndef NO_GRES
            pg8::gemm_phase<pg8::EpiRes, pg8::StaticOrder, true, true>(F.lds + RING_OFF, g, S, E);
#endif
        }
        GRID_BAR();
        {
            pg8::Gemm g{XB, (const bf16*)(ws + WS_W1) + (size_t)l * DFF * DM, MPAD, DFF, DM}; pg8::StaticOrder S; S.init(MPAD, DFF, G, bid);
            pg8::EpiFf1 E{Hb, ssq + (size_t)(2 * l + 1) * MPAD * 32};
#ifndef NO_GFF1
            pg8::gemm_phase<pg8::EpiFf1, pg8::StaticOrder, true, true>(F.lds + RING_OFF, g, S, E);
#endif
        }
        GRID_BAR();
        {
            pg8::Gemm g{Hb, (const bf16*)(ws + WS_W2) + (size_t)l * DM * DFF, MPAD, DM, DFF}; pg8::StaticOrder S; S.init(MPAD, DM, G, bid);
            pg8::EpiRes E{Xp, Xs, Xp, Xs, XB, ssq + (size_t)(2 * l + 2) * MPAD * 32};
#ifndef NO_GRES
            pg8::gemm_phase<pg8::EpiRes, pg8::StaticOrder, true, true>(F.lds + RING_OFF, g, S, E);
#endif
        }
        GRID_BAR();
    }
}

extern "C" void kernel_launch(void* const* d_in, const int* in_sizes, int n_in, void* d_out, int out_size, void* d_ws, size_t ws_size, hipStream_t stream) {
    static int grid = 0;
    if (grid == 0) {
        if (n_in != 35 || out_size != (int)O_END || ws_size < WS_END) { fprintf(stderr, "kernel_launch: unexpected problem shape (n_in %d, out %d, ws %zu)\n", n_in, out_size, ws_size); grid = -1; return; }
        int dev = 0, cus = 0, per_cu = 0;
        if (hipGetDevice(&dev) != hipSuccess || hipDeviceGetAttribute(&cus, hipDeviceAttributeMultiprocessorCount, dev) != hipSuccess) { grid = -1; return; }
        if (hipFuncSetAttribute((const void*)hybrid_fwd, hipFuncAttributeMaxDynamicSharedMemorySize, LDS_BYTES) != hipSuccess) { grid = -1; return; }
        if (hipOccupancyMaxActiveBlocksPerMultiprocessor(&per_cu, (const void*)hybrid_fwd, NWAVES * 64, LDS_BYTES) != hipSuccess || per_cu < 1)
            fprintf(stderr, "kernel_launch: occupancy query reports %d workgroups per CU\n", per_cu);
        (void)hipGetLastError();
        grid = cus;
    }
    if (grid < 0) return;
    if (hipMemsetAsync((char*)d_ws + WS_CTL, 0, CTL_ZERO_BYTES, stream) != hipSuccess) return;
    Args a{};
    for (int i = 0; i < 35; ++i) a.in[i] = (const float*)d_in[i];
    a.out = (float*)d_out; a.ws = (unsigned char*)d_ws;
    hipLaunchKernelGGL(hybrid_fwd, dim3(grid), dim3(NWAVES * 64), LDS_BYTES, stream, a);
}
```

```cpp
#include <hip/hip_runtime.h>
#include <cstdio>
#include <cstdint>
#ifndef REP_P0
#define REP_P0 1
#endif
#ifndef REP_A
#define REP_A 1
#endif
#ifndef REP_B
#define REP_B 1
#endif
#ifndef REP_GIN
#define REP_GIN 1
#endif
#ifndef REP_GFF1
#define REP_GFF1 1
#endif
#ifndef REP_THIN
#define REP_THIN 1
#endif
#ifndef REP_BAR
#define REP_BAR 1
#endif
#ifndef REP_G3
#define REP_G3 1
#endif
#ifndef REP_DPREP
#define REP_DPREP 1
#endif
#ifndef REP_AOTH
#define REP_AOTH 1
#endif
#ifndef REP_SCAN
#define REP_SCAN 1
#endif
#ifndef REP_BOTH
#define REP_BOTH 1
#endif
#ifndef PG8_B_AUX
#define PG8_B_AUX 0
#endif
#ifndef REP_SAMP
#define REP_SAMP 1
#endif
#ifndef PROBE_MFMA2
#define PROBE_MFMA2 0
#endif
#ifndef PROBE_LDS2
#define PROBE_LDS2 0
#endif
#ifndef PROBE_LDLY
#define PROBE_LDLY 0
#endif
#ifndef PROBE_CDLY
#define PROBE_CDLY 0
#endif
#ifndef PROBE_BAR2
#define PROBE_BAR2 0
#endif
#ifndef PROBE_ODLY
#define PROBE_ODLY 0
#endif
#ifndef PROBE_GFRAG
#define PROBE_GFRAG 0
#endif
#ifndef PROBE_ENDDLY
#define PROBE_ENDDLY 0
#endif
#ifndef PROBE_VMCAP
#define PROBE_VMCAP 0
#endif
#ifndef PROBE_WT
#define PROBE_WT 0
#endif
#ifndef PROBE_DET
#define PROBE_DET 0
#endif
#ifndef PROBE_CK
#define PROBE_CK 0
#endif
#ifndef PROBE_CKMODE
#define PROBE_CKMODE 0
#endif
#ifndef PROBE_DRAIN
#define PROBE_DRAIN 0
#endif
#ifndef PROBE_BARMASK
#define PROBE_BARMASK 0
#endif
#ifndef PROBE_HS
#define PROBE_HS -1
#endif
#ifndef PROBE_V0
#define PROBE_V0 0
#endif
#ifndef PROBE_INJ_L
#define PROBE_INJ_L 0
#endif
#ifndef PROBE_INJ_K
#define PROBE_INJ_K 10
#endif
#ifndef PROBE_M0NOP
#define PROBE_M0NOP 1
#endif
#ifndef PROBE_WTE
#define PROBE_WTE 0
#endif
namespace pg8 {
#define PG8_LAS __attribute__((address_space(3)))
typedef unsigned short bf16_t;
typedef short bf16x8 __attribute__((ext_vector_type(8)));
typedef float f32x4 __attribute__((ext_vector_type(4)));
typedef unsigned u32x4 __attribute__((ext_vector_type(4)));
constexpr int BM = 256, BK = 64, HALF = 128, HTB = HALF * BK * 2  , STAGE_BYTES = 8 * HTB, NXCD = 8, WGM = 8;

__host__ __device__ __forceinline__ int lds_byte(int r, int c) { const int st = (r >> 4) * 2 + (c >> 5), rr = r & 15, cc = c & 31, ob = rr * 64 + cc * 2; return st * 1024 + (ob ^ (((ob >> 9) & 1) << 5)); }
__host__ __device__ __forceinline__ void stage_rc(int b, int& R, int& C) { const int st = b / 1024, sb = b % 1024, swz = sb ^ (((sb >> 9) & 1) << 5); R = (st >> 1) * 16 + swz / 64; C = (st & 1) * 32 + (swz % 64) / 2; }
__host__ __device__ __forceinline__ int perm32(int rho) { const int n = rho >> 4, i = rho & 15; return 8 * (i >> 2) + 4 * n + (i & 3); }

struct Unit { int pm, pn, ui; };
struct Gemm { const bf16_t* A; const bf16_t* Bt; int M, N, K; };

struct StaticOrder {
    int nM, nN, nwg, G, c;
    __host__ __device__ __forceinline__ void init(int M, int N, int G_, int c_) { nM = M / BM; nN = N / BM; nwg = nM * nN; G = G_; c = c_; }
    __host__ __device__ __forceinline__ bool next(int i, Unit& u) const {
        const long L = (long)i * G + c; if (L >= nwg) return false;
        int wgid = (int)L; { const int q = nwg / NXCD, r = nwg % NXCD, xcd = wgid % NXCD, off = wgid / NXCD; wgid = (xcd < r ? xcd * (q + 1) : r * (q + 1) + (xcd - r) * q) + off; }
        const int nig = WGM * nN, gid = wgid / nig, fm = gid * WGM, gsz = (nM - fm) < WGM ? (nM - fm) : WGM;
        u.pm = fm + ((wgid % nig) % gsz); u.pn = (wgid % nig) / gsz; u.ui = i; return true;
    }
    __device__ __forceinline__ void a_ready(const Unit&) const {}
    __device__ __forceinline__ void done(const Unit&) const {}
};

struct SplitOrder {
    int G, c, L0, cnt;
    __host__ __device__ __forceinline__ void init(int G_, int c_, int L0_, int cnt_) { G = G_; c = c_; L0 = L0_; cnt = cnt_; }
    static __host__ __device__ __forceinline__ void map_grid(int L, int nM, int nN, int pn0, Unit& u) {
        const int nwg = nM * nN; int wgid = L; { const int q = nwg / NXCD, r = nwg % NXCD, xcd = wgid % NXCD, off = wgid / NXCD; wgid = (xcd < r ? xcd * (q + 1) : r * (q + 1) + (xcd - r) * q) + off; }
        const int nig = WGM * nN, gid = wgid / nig, fm = gid * WGM, gsz = (nM - fm) < WGM ? (nM - fm) : WGM;
        u.pm = fm + ((wgid % nig) % gsz); u.pn = pn0 + (wgid % nig) / gsz;
    }
    __host__ __device__ __forceinline__ bool next(int i, Unit& u) const {
        const int l = i * G + c; if (l >= cnt) return false;
        const int L = L0 + l;
        if (L < 576) map_grid(L, 32, 18, 0, u); else map_grid(L - 576, 32, 32, 18, u);
        u.ui = i; return true;
    }
    __device__ __forceinline__ void a_ready(const Unit&) const {}
    __device__ __forceinline__ void done(const Unit&) const {}
};
typedef float f32x2 __attribute__((ext_vector_type(2)));
typedef __bf16 bf16x2_t __attribute__((ext_vector_type(2)));
__device__ __forceinline__ unsigned cvt_pk_bf16(float lo, float hi) { f32x2 v = {lo, hi}; bf16x2_t b = __builtin_convertvector(v, bf16x2_t); return __builtin_bit_cast(unsigned, b); }
__device__ __forceinline__ float bflo(unsigned w) { return __uint_as_float(w << 16); }
__device__ __forceinline__ float bfhi(unsigned w) { return __uint_as_float(w & 0xffff0000u); }
constexpr int MROWS = 8224;
constexpr float RMS_EPS = 1e-6f;

__device__ __forceinline__ float row_rstd(const float* P, int row) {
    const f32x4* p = (const f32x4*)(P + (size_t)row * 32); float s = 0.f;
#pragma unroll
    for (int i = 0; i < 8; ++i) { const f32x4 v = p[i]; s += (v[0] + v[1]) + (v[2] + v[3]); }
    return __builtin_amdgcn_rsqf(s * (1.0f / 2048.0f) + RMS_EPS);
}
struct EpiIn {
    static constexpr bool PERM = true, AFTER_DRAIN = false, HOOK = false;
    bf16_t* Z; float* ZAB; bf16_t* G; const PG8_LAS float* rsl;
    float* SGQ;
    static __device__ __forceinline__ float gelu_t(float x) { const float t = 1.5957691216057308f * (x + 0.044715f * x * x * x); return x * __builtin_amdgcn_rcpf(1.0f + __expf(-t)); }
    __device__ __forceinline__ void operator()(const f32x4 (&acc)[2][2][4][2], const Unit& u, int wr, int wc, int fr, int fq) const {
        const int row0 = u.pm * BM + wr * 64 + fr, colw = wc * 32 + 8 * fq;
        const bool isg = u.pn >= 5 && u.pn <= 8;
#pragma unroll
        for (int ai = 0; ai < 2; ++ai)
#pragma unroll
            for (int m = 0; m < 4; ++m) { const int row = row0 + ai * HALF + m * 16;
                const float rs = rsl[u.ui * BM + (row - u.pm * BM)];
                float sq = 0.f;
#pragma unroll
                for (int bj = 0; bj < 2; ++bj) { f32x4 v0 = acc[ai][bj][m][0] * rs, v1 = acc[ai][bj][m][1] * rs; const int col = colw + bj * HALF;
                    if (u.pn < 17) {
                        if (isg) {
#pragma unroll
                            for (int i = 0; i < 4; ++i) { v0[i] = gelu_t(v0[i]); v1[i] = gelu_t(v1[i]); }
                            sq += (v0[0] * v0[0] + v0[1] * v0[1]) + (v0[2] * v0[2] + v0[3] * v0[3]) + (v1[0] * v1[0] + v1[1] * v1[1]) + (v1[2] * v1[2] + v1[3] * v1[3]); }
                        u32x4 w; w.x = cvt_pk_bf16(v0[0], v0[1]); w.y = cvt_pk_bf16(v0[2], v0[3]); w.z = cvt_pk_bf16(v1[0], v1[1]); w.w = cvt_pk_bf16(v1[2], v1[3]);
                        *(u32x4*)(Z + (size_t)row * 4352 + u.pn * BM + col) = w; }
                    else if (u.pn == 17) { if (col == 0) { *(f32x4*)(ZAB + (size_t)row * 8) = v0; *(f32x4*)(ZAB + (size_t)row * 8 + 4) = v1; } }
                    else { float s[8];
#pragma unroll
                        for (int i = 0; i < 4; ++i) { s[i] = fmaxf(__builtin_amdgcn_rcpf(1.0f + __expf(-v0[i])), 1e-18f); s[4 + i] = fmaxf(__builtin_amdgcn_rcpf(1.0f + __expf(-v1[i])), 1e-18f); }
                        u32x4 w; w.x = cvt_pk_bf16(s[0], s[1]); w.y = cvt_pk_bf16(s[2], s[3]); w.z = cvt_pk_bf16(s[4], s[5]); w.w = cvt_pk_bf16(s[6], s[7]);
                        *(u32x4*)(G + (size_t)row * 8192 + (u.pn - 18) * BM + col) = w; } }
                if (u.pn == 7 || u.pn == 8) { sq += __shfl_xor(sq, 16); sq += __shfl_xor(sq, 32); if (fq == 0) SGQ[(size_t)row * 8 + (u.pn - 7) * 4 + wc] = sq; } }
    }
};
struct EpiFf1 {
    static constexpr bool PERM = true, AFTER_DRAIN = false, HOOK = false;
    bf16_t* H; const PG8_LAS float* rsl;
    __device__ __forceinline__ void operator()(const f32x4 (&acc)[2][2][4][2], const Unit& u, int wr, int wc, int fr, int fq) const {
        const int row0 = u.pm * BM + wr * 64 + fr, col0 = u.pn * BM + wc * 32 + 8 * fq;
#pragma unroll
        for (int ai = 0; ai < 2; ++ai)
#pragma unroll
            for (int m = 0; m < 4; ++m) { const int row = row0 + ai * HALF + m * 16;
                const float rs = rsl[u.ui * BM + (row - u.pm * BM)];
#pragma unroll
                for (int bj = 0; bj < 2; ++bj) { f32x4 v0 = acc[ai][bj][m][0] * rs, v1 = acc[ai][bj][m][1] * rs;
#pragma unroll
                    for (int i = 0; i < 4; ++i) { const float a = fmaxf(v0[i], 0.f), b = fmaxf(v1[i], 0.f); v0[i] = a * a; v1[i] = b * b; }
                    u32x4 w; w.x = cvt_pk_bf16(v0[0], v0[1]); w.y = cvt_pk_bf16(v0[2], v0[3]); w.z = cvt_pk_bf16(v1[0], v1[1]); w.w = cvt_pk_bf16(v1[2], v1[3]);
                    *(u32x4*)(H + (size_t)row * 8192 + col0 + bj * HALF) = w; } }
    }
};
struct EpiRes {
    static constexpr bool PERM = true, AFTER_DRAIN = false, HOOK = false;
    const float* Rp; const float* Rs; float* Xp; float* Xs; bf16_t* XB; float* ssq_out;
    __device__ __forceinline__ void operator()(const f32x4 (&acc)[2][2][4][2], const Unit& u, int wr, int wc, int fr, int fq) const {
        const int row0 = u.pm * BM + wr * 64 + fr, col0 = u.pn * BM + wc * 32 + 8 * fq;
#pragma unroll
        for (int ai = 0; ai < 2; ++ai) {
            f32x4 res[4][2][2];
#pragma unroll
            for (int m = 0; m < 4; ++m) { const float* rp = Rp + (size_t)(row0 + ai * HALF + m * 16) * 2048 + col0;
#pragma unroll
                for (int bj = 0; bj < 2; ++bj) { res[m][bj][0] = *(const f32x4*)(rp + bj * HALF); res[m][bj][1] = *(const f32x4*)(rp + bj * HALF + 4); } }
#pragma unroll
            for (int m = 0; m < 4; ++m) { const int row = row0 + ai * HALF + m * 16; float* xp = Xp + (size_t)row * 2048 + col0; float sq = 0.f;
#pragma unroll
                for (int bj = 0; bj < 2; ++bj) {
                    const f32x4 v0 = acc[ai][bj][m][0] + res[m][bj][0], v1 = acc[ai][bj][m][1] + res[m][bj][1];
                    *(f32x4*)(xp + bj * HALF) = v0; *(f32x4*)(xp + bj * HALF + 4) = v1;
                    u32x4 w; w.x = cvt_pk_bf16(v0[0], v0[1]); w.y = cvt_pk_bf16(v0[2], v0[3]); w.z = cvt_pk_bf16(v1[0], v1[1]); w.w = cvt_pk_bf16(v1[2], v1[3]);
                    *(u32x4*)(XB + (size_t)row * 2048 + col0 + bj * HALF) = w;
                    sq += (v0[0] * v0[0] + v0[1] * v0[1]) + (v0[2] * v0[2] + v0[3] * v0[3]) + (v1[0] * v1[0] + v1[1] * v1[1]) + (v1[2] * v1[2] + v1[3] * v1[3]); }
                sq += __shfl_xor(sq, 16); sq += __shfl_xor(sq, 32);
                if (fq == 0) ssq_out[(size_t)row * 32 + u.pn * 4 + wc] = sq; }
            asm volatile("" ::: "memory"); }
    }
};
struct EpiGate {
    static constexpr bool PERM = true, AFTER_DRAIN = false, HOOK = true;
    const bf16_t* G; bf16_t* GS;
    __device__ __forceinline__ void hook(f32x4 (&acc)[2][2][4][2], const Unit& u, int bidx, int wr, int wc, int fr, int fq) const {
        const bf16_t* gp0 = G + (size_t)(u.pm * BM + wr * 64 + fr) * 8192 + (size_t)(bidx - 1) * 2048 + u.pn * BM + wc * 32 + 8 * fq;
#pragma unroll
        for (int ai = 0; ai < 2; ++ai)
#pragma unroll
            for (int m = 0; m < 4; ++m)
#pragma unroll
                for (int bj = 0; bj < 2; ++bj) { const bf16_t* gp = gp0 + (size_t)(ai * HALF + m * 16) * 8192 + bj * HALF;
                    const u32x4 ga = *(const u32x4*)gp, gb = *(const u32x4*)(gp + 2048);
                    acc[ai][bj][m][0][0] *= bflo(ga.x) * __builtin_amdgcn_rcpf(bflo(gb.x)); acc[ai][bj][m][0][1] *= bfhi(ga.x) * __builtin_amdgcn_rcpf(bfhi(gb.x));
                    acc[ai][bj][m][0][2] *= bflo(ga.y) * __builtin_amdgcn_rcpf(bflo(gb.y)); acc[ai][bj][m][0][3] *= bfhi(ga.y) * __builtin_amdgcn_rcpf(bfhi(gb.y));
                    acc[ai][bj][m][1][0] *= bflo(ga.z) * __builtin_amdgcn_rcpf(bflo(gb.z)); acc[ai][bj][m][1][1] *= bfhi(ga.z) * __builtin_amdgcn_rcpf(bfhi(gb.z));
                    acc[ai][bj][m][1][2] *= bflo(ga.w) * __builtin_amdgcn_rcpf(bflo(gb.w)); acc[ai][bj][m][1][3] *= bfhi(ga.w) * __builtin_amdgcn_rcpf(bfhi(gb.w));
                    if (bj == 1 && m == 3) asm volatile("" ::: "memory"); }
        asm volatile("s_waitcnt vmcnt(0)" ::: "memory");
    }
    __device__ __forceinline__ void operator()(const f32x4 (&acc)[2][2][4][2], const Unit& u, int wr, int wc, int fr, int fq) const {
        const int row0 = u.pm * BM + wr * 64 + fr, col0 = u.pn * BM + wc * 32 + 8 * fq;
#pragma unroll
        for (int ai = 0; ai < 2; ++ai) { u32x4 g[4][2];
#pragma unroll
            for (int m = 0; m < 4; ++m)
#pragma unroll
                for (int bj = 0; bj < 2; ++bj) g[m][bj] = *(const u32x4*)(G + (size_t)(row0 + ai * HALF + m * 16) * 8192 + 3 * 2048 + col0 + bj * HALF);
#pragma unroll
            for (int m = 0; m < 4; ++m)
#pragma unroll
                for (int bj = 0; bj < 2; ++bj) { const f32x4 a0 = acc[ai][bj][m][0], a1 = acc[ai][bj][m][1]; const u32x4 gg = g[m][bj];
                    u32x4 w; w.x = cvt_pk_bf16(a0[0] * bflo(gg.x), a0[1] * bfhi(gg.x)); w.y = cvt_pk_bf16(a0[2] * bflo(gg.y), a0[3] * bfhi(gg.y));
                    w.z = cvt_pk_bf16(a1[0] * bflo(gg.z), a1[1] * bfhi(gg.z)); w.w = cvt_pk_bf16(a1[2] * bflo(gg.w), a1[3] * bfhi(gg.w));
                    *(u32x4*)(GS + (size_t)(row0 + ai * HALF + m * 16) * 2048 + col0 + bj * HALF) = w; }
            asm volatile("" ::: "memory"); }
    }
};
template <class Epi, class Sched, bool ALIGN_EPI = false, bool SP2 = false>
__device__ __forceinline__ void gemm_phase(PG8_LAS unsigned char* lds, const Gemm g, const Sched& S, const Epi& E) {
    int tid_ = threadIdx.x; asm volatile("" : "+v"(tid_));
    const int tid = tid_, wid = __builtin_amdgcn_readfirstlane(tid >> 6), lane = tid & 63, wr = wid >> 2, wc = wid & 3, fr = lane & 15, fq = lane >> 4;
    const int K = g.K, nt = K / BK;
    unsigned voffA[2], voffB[2];
#pragma unroll
    for (int i = 0; i < 2; ++i) { int R, C; stage_rc(tid * 16 + i * 8192, R, C); const int Rb = Epi::PERM ? ((R & ~31) + perm32(R & 31)) : R;
        voffA[i] = (unsigned)(R * K + C) * 2u; voffB[i] = (unsigned)(Rb * K + C) * 2u; }
    const size_t kstep = (size_t)(BK * 2);
    const size_t hstep = (size_t)HALF * K * 2;
    const size_t tstep = 2 * hstep;
    const unsigned ldsw = (unsigned)wid * 1024u;
    const int aoff = lds_byte(wr * 64 + fr, fq * 8), boff = lds_byte(wc * 32 + fr, fq * 8);
#define PG8_SA(b, h) (((b) * 2 + (h)) * HTB)
#define PG8_SB(b, h) ((4 + (b) * 2 + (h)) * HTB)
#if PROBE_M0NOP
#define PG8_STAGE(bufoff, gbase, voff) do { _Pragma("unroll") for (int _i = 0; _i < 2; ++_i) { const unsigned la_ = (unsigned)(unsigned long)(lds + (bufoff) + ldsw + _i * 8192); const char* gb_ = (const char*)(gbase); \
        asm volatile("s_mov_b32 m0, %0\n\ts_nop 4\n\tglobal_load_lds_dwordx4 %1, %2" :: "s"(la_), "v"((voff)[_i]), "s"(gb_) : "memory", "m0"); } } while (0)
#define PG8_STAGEB(bufoff, gbase, voff) PG8_STAGE(bufoff, gbase, voff)
#else
#define PG8_STAGE(bufoff, gbase, voff) do { _Pragma("unroll") for (int _i = 0; _i < 2; ++_i) \
        __builtin_amdgcn_global_load_lds((const unsigned*)((const char*)(gbase) + (voff)[_i]), (PG8_LAS unsigned*)(lds + (bufoff) + ldsw + _i * 8192), 16, 0, 0); } while (0)
#define PG8_STAGEB(bufoff, gbase, voff) do { _Pragma("unroll") for (int _i = 0; _i < 2; ++_i) \
        __builtin_amdgcn_global_load_lds((const unsigned*)((const char*)(gbase) + (voff)[_i]), (PG8_LAS unsigned*)(lds + (bufoff) + ldsw + _i * 8192), 16, 0, PG8_B_AUX); } while (0)
#endif
#define PG8_LDA(dst, b, h) do { _Pragma("unroll") for (int m = 0; m < 4; ++m) _Pragma("unroll") for (int k = 0; k < 2; ++k) dst[m][k] = *(const PG8_LAS bf16x8*)(lds + PG8_SA(b, h) + aoff + m * 2048 + k * 1024); } while (0)
#define PG8_LDB(dst, b, h) do { _Pragma("unroll") for (int n = 0; n < 2; ++n) _Pragma("unroll") for (int k = 0; k < 2; ++k) dst[n][k] = *(const PG8_LAS bf16x8*)(lds + PG8_SB(b, h) + boff + n * 2048 + k * 1024); } while (0)
#define PG8_MMA(ai, bj, At, Bt) do { __builtin_amdgcn_s_setprio(1); _Pragma("unroll") for (int m = 0; m < 4; ++m) _Pragma("unroll") for (int n = 0; n < 2; ++n) _Pragma("unroll") for (int k = 0; k < 2; ++k) \
        acc[ai][bj][m][n] = __builtin_amdgcn_mfma_f32_16x16x32_bf16(Bt[n][k], At[m][k], acc[ai][bj][m][n], 0, 0, 0); __builtin_amdgcn_s_setprio(0); } while (0)
#if PROBE_V0
#define PG8_WAIT_V(n) asm volatile("s_waitcnt vmcnt(0)" ::: "memory")
#else
#define PG8_WAIT_V(n) asm volatile("s_waitcnt vmcnt(" #n ")" ::: "memory")
#endif
#define PG8_WAIT_L(n) asm volatile("s_waitcnt lgkmcnt(" #n ")" ::: "memory")
#define PG8_BAR __builtin_amdgcn_s_barrier()
#define PG8_SCHED __builtin_amdgcn_sched_barrier(0)
    Unit cur, nxt; int ui = 0;
    if (!S.next(0, cur)) return;
    f32x4 acc[2][2][4][2];
#pragma unroll
    for (int a = 0; a < 2; ++a)
#pragma unroll
        for (int b = 0; b < 2; ++b)
#pragma unroll
            for (int m = 0; m < 4; ++m)
#pragma unroll
                for (int n = 0; n < 2; ++n) acc[a][b][m][n] = (f32x4){0.f, 0.f, 0.f, 0.f};
    bf16x8 At[4][2], B0[2][2], B1[2][2];
    const char* cA = (const char*)g.A + (size_t)cur.pm * tstep; const char* cB = (const char*)g.Bt + (size_t)cur.pn * tstep;
    S.a_ready(cur);
    if constexpr (SP2) {
        PG8_STAGEB(PG8_SB(0, 0), cB, voffB); PG8_STAGEB(PG8_SB(0, 1), cB + hstep, voffB); PG8_STAGE(PG8_SA(0, 0), cA, voffA); PG8_STAGE(PG8_SA(0, 1), cA + hstep, voffA);
        if (wr == 1) PG8_BAR;
        PG8_WAIT_V(2); PG8_BAR;
        PG8_STAGEB(PG8_SB(1, 0), cB + kstep, voffB); PG8_STAGE(PG8_SA(1, 0), cA + kstep, voffA); PG8_STAGEB(PG8_SB(1, 1), cB + hstep + kstep, voffB);
        PG8_WAIT_V(6); PG8_BAR;
    } else {
        PG8_STAGEB(PG8_SB(0, 0), cB, voffB); PG8_STAGE(PG8_SA(0, 0), cA, voffA); PG8_STAGEB(PG8_SB(0, 1), cB + hstep, voffB); PG8_STAGE(PG8_SA(0, 1), cA + hstep, voffA);
        if (wr == 1) PG8_BAR;
        PG8_WAIT_V(4); PG8_BAR;
        PG8_STAGEB(PG8_SB(1, 0), cB + kstep, voffB); PG8_STAGE(PG8_SA(1, 0), cA + kstep, voffA); PG8_STAGEB(PG8_SB(1, 1), cB + hstep + kstep, voffB);
        PG8_WAIT_V(6); PG8_BAR;
    }
    for (;;) {
        const bool has_next = S.next(ui + 1, nxt);
        const char* nA = has_next ? (const char*)g.A + (size_t)nxt.pm * tstep : cA; const char* nB = has_next ? (const char*)g.Bt + (size_t)nxt.pn * tstep : cB;
        for (int t = 0; t < nt; t += 2) {
            const bool last = (t == nt - 2);
            const char* a1 = cA + (size_t)(t + 1) * kstep;
            const char* a2 = last ? nA : cA + (size_t)(t + 2) * kstep; const char* b2 = last ? nB : cB + (size_t)(t + 2) * kstep;
            const char* a3 = a2 + kstep; const char* b3 = b2 + kstep;
            if (last && has_next) S.a_ready(nxt);
            if constexpr (SP2) {
            PG8_LDB(B0, 0, 0); PG8_LDB(B1, 0, 1); PG8_SCHED; PG8_LDA(At, 0, 0); PG8_STAGE(PG8_SA(1, 1), a1 + hstep, voffA);
            PG8_WAIT_V(8); PG8_WAIT_L(0); PG8_BAR; PG8_MMA(0, 0, At, B0); PG8_MMA(0, 1, At, B1); PG8_BAR; PG8_SCHED;
            PG8_LDA(At, 0, 1); PG8_STAGEB(PG8_SB(0, 0), b2, voffB); PG8_STAGEB(PG8_SB(0, 1), b2 + hstep, voffB); PG8_STAGE(PG8_SA(0, 0), a2, voffA);
            PG8_WAIT_V(8); PG8_WAIT_L(0); PG8_BAR; PG8_MMA(1, 0, At, B0); PG8_MMA(1, 1, At, B1); PG8_BAR; PG8_SCHED;
            PG8_LDB(B0, 1, 0); PG8_LDB(B1, 1, 1); PG8_SCHED; PG8_LDA(At, 1, 0); PG8_STAGE(PG8_SA(0, 1), a2 + hstep, voffA);
            PG8_WAIT_V(8); PG8_WAIT_L(0); PG8_BAR; PG8_MMA(0, 0, At, B0); PG8_MMA(0, 1, At, B1); PG8_BAR; PG8_SCHED;
            PG8_LDA(At, 1, 1); PG8_STAGEB(PG8_SB(1, 0), b3, voffB); PG8_STAGEB(PG8_SB(1, 1), b3 + hstep, voffB); PG8_STAGE(PG8_SA(1, 0), a3, voffA);
            PG8_WAIT_V(8); PG8_WAIT_L(0); PG8_BAR; PG8_MMA(1, 0, At, B0); PG8_MMA(1, 1, At, B1); PG8_BAR; PG8_SCHED;
            } else {
            PG8_LDB(B0, 0, 0); PG8_SCHED; PG8_LDA(At, 0, 0); PG8_STAGE(PG8_SA(1, 1), a1 + hstep, voffA);
            PG8_WAIT_L(8); PG8_BAR; PG8_WAIT_L(0); PG8_MMA(0, 0, At, B0); PG8_BAR; PG8_SCHED;
            PG8_LDB(B1, 0, 1); PG8_STAGEB(PG8_SB(0, 0), b2, voffB);
            PG8_BAR; PG8_WAIT_L(0); PG8_MMA(0, 1, At, B1); PG8_BAR;
            PG8_LDA(At, 0, 1); PG8_STAGE(PG8_SA(0, 0), a2, voffA);
            PG8_BAR; PG8_WAIT_L(0); PG8_MMA(1, 0, At, B0); PG8_BAR; PG8_SCHED;
            PG8_STAGEB(PG8_SB(0, 1), b2 + hstep, voffB);
            PG8_WAIT_V(6); PG8_BAR; PG8_MMA(1, 1, At, B1); PG8_BAR;
            PG8_LDB(B0, 1, 0); PG8_SCHED; PG8_LDA(At, 1, 0); PG8_STAGE(PG8_SA(0, 1), a2 + hstep, voffA);
            PG8_WAIT_L(8); PG8_BAR; PG8_WAIT_L(0); PG8_MMA(0, 0, At, B0); PG8_BAR; PG8_SCHED;
            PG8_LDB(B1, 1, 1); PG8_STAGEB(PG8_SB(1, 0), b3, voffB);
            PG8_BAR; PG8_WAIT_L(0); PG8_MMA(0, 1, At, B1); PG8_BAR;
            PG8_LDA(At, 1, 1); PG8_STAGE(PG8_SA(1, 0), a3, voffA);
            PG8_BAR; PG8_WAIT_L(0); PG8_MMA(1, 0, At, B0); PG8_BAR; PG8_SCHED;
            PG8_STAGEB(PG8_SB(1, 1), b3 + hstep, voffB);
            PG8_WAIT_V(6); PG8_BAR; PG8_MMA(1, 1, At, B1); PG8_BAR;
            }
            if constexpr (Epi::HOOK) { if ((((t + 2) & 7) == 0) && !last) { E.hook(acc, cur, (t + 2) >> 3, wr, wc, fr, fq); PG8_SCHED; } }
        }
        if constexpr (ALIGN_EPI) { if (wr == 0) PG8_BAR; }
        if constexpr (!Epi::AFTER_DRAIN) { E(acc, cur, wr, wc, fr, fq); S.done(cur); }
        if (!has_next) break;
#pragma unroll
        for (int a = 0; a < 2; ++a)
#pragma unroll
            for (int b = 0; b < 2; ++b)
#pragma unroll
                for (int m = 0; m < 4; ++m)
#pragma unroll
                    for (int n = 0; n < 2; ++n) acc[a][b][m][n] = (f32x4){0.f, 0.f, 0.f, 0.f};
        cur = nxt; cA = nA; cB = nB; ++ui;
        if constexpr (ALIGN_EPI) { if (wr == 1) PG8_BAR; }
    }
    PG8_WAIT_V(0);
    if constexpr (!ALIGN_EPI) { if (wr == 0) PG8_BAR; }
    PG8_BAR;
    if constexpr (Epi::AFTER_DRAIN) { E.fused(acc, cur, wr, wc, fr, fq, lds, wid, lane); S.done(cur); }
#undef PG8_SA
#undef PG8_SB
#undef PG8_STAGE
#undef PG8_STAGEB
#undef PG8_LDA
#undef PG8_LDB
#undef PG8_MMA
#undef PG8_WAIT_V
#undef PG8_WAIT_L
#undef PG8_BAR
#undef PG8_SCHED
}
}
constexpr int NWAVES = 8;
constexpr int DM = 2048, SEQ = 4096, NB = 2, MP = NB * SEQ  , NS = 32  , MPAD = 8448, DEPTH = 4, DFF = 8192;
constexpr int NIN = 12552, NINP = 12800, ZW = 4352, GW = 8192, PASTLEN = 16384;
constexpr int ZC_Q = 0, ZC_K = 512, ZC_V = 640, ZC_SU = 768, ZC_GU = 1280, ZC_GV = 1792, ZC_DQ = 2304, ZC_DK = 2816, ZC_DV = 3328, ZC_DG = 3840;
constexpr float LOG2E = 1.4426950408889634f;

constexpr size_t MiB = 1u << 20;
constexpr size_t WS_CTL = 0, CTL_ZERO_BYTES = 1 * MiB;
constexpr size_t WS_ROPE = 1 * MiB;
constexpr size_t WS_ABAR = 3 * MiB;
constexpr size_t WS_A32 = WS_ABAR + 65536;
constexpr size_t WS_CFRAG = WS_ABAR + 131072;
constexpr size_t WS_BBAR = 4 * MiB;
constexpr size_t WS_WTRIL = 5 * MiB;
constexpr size_t WS_WG = 6 * MiB;
constexpr size_t WS_E = 8 * MiB;
constexpr size_t WS_ZAB = 12 * MiB;
constexpr size_t WS_GE = 13 * MiB;
constexpr size_t WS_WIN = 16 * MiB;
constexpr size_t WS_WB = 216 * MiB;
constexpr size_t WS_WO = 248 * MiB;
constexpr size_t WS_W1 = 280 * MiB;
constexpr size_t WS_W2 = 408 * MiB;
constexpr size_t WS_XB = 536 * MiB;
constexpr size_t WS_Z = 570 * MiB;
constexpr size_t WS_G = 642 * MiB;
constexpr size_t WS_YCAT = 774 * MiB;
constexpr size_t WS_GS = 808 * MiB;
constexpr size_t WS_H = 842 * MiB;
constexpr size_t WS_OD = 974 * MiB;
constexpr size_t WS_U0 = 990 * MiB;
constexpr size_t WS_WN = 1006 * MiB;
constexpr size_t WS_QG = 1014 * MiB;
constexpr size_t WS_QK = 1022 * MiB;
constexpr size_t WS_KE = 1026 * MiB;
constexpr size_t WS_SSQP = 1034 * MiB;
constexpr size_t WS_SSQS = 1046 * MiB;
constexpr size_t WS_SGQ = 1047 * MiB;
constexpr size_t WS_BFRAG = 1048 * MiB;
constexpr size_t WS_BU = 1049 * MiB;
constexpr size_t WS_END = 1113 * MiB;
constexpr int CW_TMO = 0;
constexpr int CW_QUEUE = 2048;
constexpr int CW_BAR = 4096;

constexpr size_t O_YP = 0, O_YS = 16777216, O_PK = O_YS + 65536, O_PV = O_PK + 131072, O_PSR = O_PV + 131072, O_PSI = O_PSR + 16384, O_PD = O_PSI + 16384,
                 O_PC = O_PD + 524288, O_PCV = O_PC + 36864, O_SK = O_PCV + 524288, O_SV = O_SK + 2097152, O_SSR = O_SV + 2097152, O_SSI = O_SSR + 262144,
                 O_SD = O_SSI + 262144, O_SC = O_SD + 8388608, O_SCV = O_SC + 589824, O_END = O_SCV + 65536;

constexpr int RING_OFF = 0, RING_BYTES = 131072;
constexpr int LDSCTL_OFF = 147456, MISC_OFF = LDSCTL_OFF + 320;
constexpr int LDS_BYTES = 148480;
static_assert(MISC_OFF + 128 <= LDS_BYTES, "LDS map");

#define GAS __attribute__((address_space(1)))
#define LAS __attribute__((address_space(3)))
typedef unsigned short bf16;
typedef unsigned v4u __attribute__((ext_vector_type(4)));
typedef float f32x4 __attribute__((ext_vector_type(4)));
typedef short bf16x8 __attribute__((ext_vector_type(8)));
typedef GAS unsigned gu32;
typedef GAS unsigned long long gu64;
#define RLX_AGENT __ATOMIC_RELAXED, __HIP_MEMORY_SCOPE_AGENT
#define LDS_WAIT() asm volatile("s_waitcnt lgkmcnt(0)" ::: "memory")
#define VM_WAIT() asm volatile("s_waitcnt vmcnt(0)" ::: "memory")
__device__ __forceinline__ unsigned long long rt() { return __builtin_amdgcn_s_memrealtime(); }
__device__ __forceinline__ unsigned f2bf(float f) { unsigned u = __builtin_bit_cast(unsigned, f); return (u + 0x7fffu + ((u >> 16) & 1u)) >> 16; }
__device__ __forceinline__ unsigned pk2(float lo, float hi) { return f2bf(lo) | (f2bf(hi) << 16); }

#define XB_TMO      128
#define XB_XCNT(j)  (256  + 64 * (j))
#define XB_XSUB(j)  (1280 + 64 * (j))
#define XB_XGEN(j)  (2304 + 64 * (j))
#define XB_TOP      3328
#define XB_TOPGEN   3392
#define XCD_BAR_WORDS 3456
#define XB_SPIN_CAP (1u << 18)

__device__ __forceinline__ unsigned xb_ld(unsigned* p)              { return __hip_atomic_load(p, __ATOMIC_RELAXED, __HIP_MEMORY_SCOPE_AGENT); }
__device__ __forceinline__ unsigned xb_add(unsigned* p, unsigned v) { return __hip_atomic_fetch_add(p, v, __ATOMIC_RELAXED, __HIP_MEMORY_SCOPE_AGENT); }
__device__ __forceinline__ unsigned xb_xcc_id() { return (unsigned)__builtin_amdgcn_s_getreg((3 << 11) | 20) & 0xFu; }
#define XB_SPIN(cond, bar) do { unsigned _sp = 0; while (cond) { __builtin_amdgcn_s_sleep(1); \
    if ((++_sp & 255u) == 0u) { if (xb_ld(&(bar)[XB_TMO])) break; if (_sp > XB_SPIN_CAP) { atomicAdd(&(bar)[XB_TMO], 1u); break; } } } } while (0)

struct XcdBarrier {
    unsigned* bar; unsigned x;
    volatile LAS unsigned* st;
};

__device__ __forceinline__ XcdBarrier xcd_barrier_post(unsigned* bar, volatile LAS unsigned* st) {
    XcdBarrier b; b.bar = bar; b.x = xb_xcc_id(); b.st = st;
    if (threadIdx.x == 0) (void)xb_add(&bar[XB_XCNT(b.x)], 1u);
    return b;
}
__device__ __forceinline__ void xcd_barrier_complete(unsigned* bar, unsigned x, unsigned& nloc, unsigned& nx) {
    const unsigned G = gridDim.x * gridDim.y * gridDim.z;
    unsigned sum, cnt, mine, sp = 0u;
    for (;;) {
        sum = 0u; cnt = 0u; mine = 0u;
#pragma unroll
        for (unsigned j = 0; j < 16; ++j) { const unsigned c = xb_ld(&bar[XB_XCNT(j)]); sum += c; cnt += (c > 0u) ? 1u : 0u; mine = (j == x) ? c : mine; }
        if (sum == G) break;
        __builtin_amdgcn_s_sleep(1);
        if ((++sp & 255u) == 0u) { if (xb_ld(&bar[XB_TMO])) break; if (sp > XB_SPIN_CAP) { atomicAdd(&bar[XB_TMO], 1u); break; } }
    }
    nloc = mine > 0u ? mine : 1u; nx = cnt > 0u ? cnt : 1u;
}

__device__ __forceinline__ void xcd_barrier(const XcdBarrier& b) {
    asm volatile("s_waitcnt vmcnt(0)" ::: "memory");
    __syncthreads();
    if (threadIdx.x == 0) {
        unsigned* bar = b.bar;
        __builtin_amdgcn_s_waitcnt(0);
        unsigned nloc = b.st[0], nx = b.st[1];
        if (nloc == 0u) { xcd_barrier_complete(bar, b.x, nloc, nx); b.st[0] = nloc; b.st[1] = nx; }
        const unsigned old = xb_add(&bar[XB_XSUB(b.x)], 1u);
        const unsigned gen = old / nloc;
        if (old + 1u == (gen + 1u) * nloc) {
            __builtin_amdgcn_fence(__ATOMIC_RELEASE, "agent");
            asm volatile("s_waitcnt vmcnt(0)" ::: "memory");
            const unsigned og = xb_add(&bar[XB_TOP], 1u);
            const unsigned tg = og / nx;
            if (og + 1u == (tg + 1u) * nx) xb_add(&bar[XB_TOPGEN], 1u);
            else XB_SPIN(xb_ld(&bar[XB_TOPGEN]) == tg, bar);
            __builtin_amdgcn_fence(__ATOMIC_ACQUIRE, "agent");
            xb_add(&bar[XB_XGEN(b.x)], 1u);
            asm volatile("s_waitcnt vmcnt(0)" ::: "memory");
        } else {
            XB_SPIN(xb_ld(&bar[XB_XGEN(b.x)]) == gen, bar);
            __builtin_amdgcn_fence(__ATOMIC_ACQUIRE, "agent");
            asm volatile("s_waitcnt vmcnt(0)" ::: "memory");
        }
    }
    __syncthreads();
}
typedef float f32x16 __attribute__((ext_vector_type(16)));
typedef float f32x2v __attribute__((ext_vector_type(2)));
typedef unsigned v2u __attribute__((ext_vector_type(2)));
#define DI __device__ __forceinline__
#define MFMA32(a, b, c) __builtin_amdgcn_mfma_f32_32x32x16_bf16((a), (b), (c), 0, 0, 0)
#define MFMA16(a, b, c) __builtin_amdgcn_mfma_f32_16x16x32_bf16((a), (b), (c), 0, 0, 0)
DI float bf2f(unsigned short h) { return __uint_as_float((unsigned)h << 16); }
DI float bflo(unsigned w) { return __uint_as_float(w << 16); }
DI float bfhi(unsigned w) { return __uint_as_float(w & 0xffff0000u); }
DI unsigned cvtpk(float lo, float hi) { return pg8::cvt_pk_bf16(lo, hi); }
DI unsigned short cvt1(float v) { return (unsigned short)(pg8::cvt_pk_bf16(v, 0.f) & 0xffffu); }
#define CR(k) (((k) & 3) + 8 * ((k) >> 2))
DI int crow(int reg, int h) { return (reg & 3) + 8 * (reg >> 2) + 4 * h; }
DI bf16x8 pack8(float a0, float a1, float a2, float a3, float a4, float a5, float a6, float a7) {
    v4u p; p.x = cvtpk(a0, a1); p.y = cvtpk(a2, a3); p.z = cvtpk(a4, a5); p.w = cvtpk(a6, a7); return __builtin_bit_cast(bf16x8, p); }
DI bf16x8 pack_step(const f32x16& x, int s) { return s == 0 ? pack8(x[0], x[1], x[2], x[3], x[4], x[5], x[6], x[7]) : pack8(x[8], x[9], x[10], x[11], x[12], x[13], x[14], x[15]); }
DI float wave_sum(float v) {
#pragma unroll
    for (int o = 1; o < 64; o <<= 1) v += __shfl_xor(v, o);
    return v;
}
DI float wave_max(float v) {
#pragma unroll
    for (int o = 1; o < 64; o <<= 1) v = fmaxf(v, __shfl_xor(v, o));
    return v;
}
DI float gelu_tanh(float x) {
    const float t = 1.5957691216057308f * (x + 0.044715f * x * x * x);
    return x * __builtin_amdgcn_rcpf(1.0f + __expf(-t));
}
DI float sigmoidf_(float x) { return __builtin_amdgcn_rcpf(1.0f + __expf(-x)); }
DI float siluf_(float x) { return x * __builtin_amdgcn_rcpf(1.0f + __expf(-x)); }
DI float softplusf_(float x) { const float e = __expf(-fabsf(x)); const float l = e < 1e-3f ? e * (1.f - 0.5f * e) : __logf(1.f + e); return fmaxf(x, 0.f) + l; }
DI int frag_off(int row, int k, int nks) { const int rt = row >> 5, r = row & 31, ks = k >> 4, w = k & 15, h = (w >> 2) & 1, j = ((w >> 3) << 2) | (w & 3); return (((rt * nks + ks) * 64) + r + 32 * h) * 8 + j; }

DI int opaque_tid() { int t = threadIdx.x; asm volatile("" : "+v"(t)); return t; }
struct Frame {
    LAS unsigned char* lds;
    volatile LAS unsigned* MISC;
    gu32* ctl;
    unsigned char* ws;
    const float* const* in;
    int tid, lane, wave, vcu, G;
};
struct Args { const float* in[35]; float* out; unsigned char* ws;
#if PROBE_CK
    int pass;
#endif
};
enum { I_XP = 0, I_XS, I_CK, I_CV, I_SSR, I_SSI, I_SD, I_SC, I_N1G, I_WIN, I_QNG, I_KNG, I_SINK, I_LAMR, I_LAMI, I_LOGDT, I_BRE, I_BIM, I_CRE, I_CIM, I_SSMD, I_GLUW, I_GLUB,
       I_SGNG, I_SGW, I_SGB, I_CONVW, I_ALOG, I_DTB, I_DNG, I_WBR, I_WOUT, I_N2G, I_WFF1, I_WFF2 };

template <int MODE>
DI void p0_transpose_item(const float* W, int K, int Nsrc, bf16* WT, const float* gain, LAS float* scr, int kb, int nb, int lane) {
    const int k0 = 64 * kb, n0 = 32 * nb;
    const int nd = n0 + (lane & 31);
    const int ns = MODE == 1 ? (nd < 4360 ? nd : (nd < 4608 ? -1 : nd - 248)) : nd;
    float tv[32];
#pragma unroll
    for (int i = 0; i < 32; ++i) { const int kk = 2 * i + (lane >> 5); tv[i] = ns >= 0 ? W[(size_t)(k0 + kk) * Nsrc + ns] : 0.f; }
#pragma unroll
    for (int i = 0; i < 32; ++i) { const int kk = 2 * i + (lane >> 5); float v = tv[i]; if (gain) v *= gain[k0 + kk]; scr[kk * 33 + (lane & 31)] = v; }
    LDS_WAIT(); asm volatile("" ::: "memory");
    const int c = lane & 7;
#pragma unroll
    for (int j = 0; j < 4; ++j) { const int n = (lane >> 3) + 8 * j; const LAS float* s = scr + (8 * c) * 33 + n;
        v4u o; o.x = cvtpk(s[0 * 33], s[1 * 33]); o.y = cvtpk(s[2 * 33], s[3 * 33]); o.z = cvtpk(s[4 * 33], s[5 * 33]); o.w = cvtpk(s[6 * 33], s[7 * 33]);
        *(GAS v4u*)(WT + (size_t)(n0 + n) * K + k0 + 8 * c) = o; }
    LDS_WAIT(); asm volatile("" ::: "memory");
}

DI void p0_prologue(Frame& F, const Args& A) {
    LAS float* scr = (LAS float*)(F.lds + RING_OFF + F.wave * 16384);
    const int gw = F.vcu * NWAVES + F.wave, NGW = F.G * NWAVES, lane = F.lane;
    unsigned char* ws = F.ws;
    constexpr int IT_IN = 32 * 400, IT_SQ = 32 * 64, IT_W1 = 32 * 256, IT_W2 = 128 * 64, IT_GLU = 8 * 16, IT_L = IT_IN + 2 * IT_SQ + IT_W1 + IT_W2 + IT_GLU;
    for (int it = gw; it < DEPTH * IT_L; it += NGW) {
        const int l = it / IT_L; int r = it % IT_L;
        if (r < IT_IN) { p0_transpose_item<1>(A.in[I_WIN] + (size_t)l * DM * NIN, DM, NIN, (bf16*)(ws + WS_WIN) + (size_t)l * NINP * DM, A.in[I_N1G] + l * DM, scr, r / 400, r % 400, lane); continue; } r -= IT_IN;
        if (r < IT_SQ) { p0_transpose_item<0>(A.in[I_WBR] + (size_t)l * DM * DM, DM, DM, (bf16*)(ws + WS_WB) + (size_t)l * DM * DM, nullptr, scr, r / 64, r % 64, lane); continue; } r -= IT_SQ;
        if (r < IT_SQ) { p0_transpose_item<0>(A.in[I_WOUT] + (size_t)l * DM * DM, DM, DM, (bf16*)(ws + WS_WO) + (size_t)l * DM * DM, nullptr, scr, r / 64, r % 64, lane); continue; } r -= IT_SQ;
        if (r < IT_W1) { p0_transpose_item<0>(A.in[I_WFF1] + (size_t)l * DM * DFF, DM, DFF, (bf16*)(ws + WS_W1) + (size_t)l * DFF * DM, A.in[I_N2G] + l * DM, scr, r / 256, r % 256, lane); continue; } r -= IT_W1;
        if (r < IT_W2) { p0_transpose_item<0>(A.in[I_WFF2] + (size_t)l * DFF * DM, DFF, DM, (bf16*)(ws + WS_W2) + (size_t)l * DM * DFF, nullptr, scr, r / 64, r % 64, lane); continue; } r -= IT_W2;
        p0_transpose_item<0>(A.in[I_GLUW] + (size_t)l * 512 * 512, 512, 512, (bf16*)(ws + WS_WG) + (size_t)l * 512 * 512, nullptr, scr, r / 16, r % 16, lane);
    }
    float* ssq0 = (float*)(ws + WS_SSQP);
    for (int m = gw; m < MPAD; m += NGW) {
        GAS v4u* o16 = (GAS v4u*)((bf16*)(ws + WS_XB) + (size_t)m * DM) + lane;
        if (m < pg8::MROWS) {
            const float* xrow = m < MP ? A.in[I_XP] + (size_t)m * DM : A.in[I_XS] + (size_t)(m - MP) * DM;
            const GAS f32x4* xr = (const GAS f32x4*)xrow + 2 * lane;
            float s = 0.f;
#pragma unroll
            for (int j = 0; j < 4; ++j) { const f32x4 a = xr[128 * j], b = xr[128 * j + 1];
                s += (a.x * a.x + a.y * a.y) + (a.z * a.z + a.w * a.w) + (b.x * b.x + b.y * b.y) + (b.z * b.z + b.w * b.w);
                v4u o; o.x = cvtpk(a.x, a.y); o.y = cvtpk(a.z, a.w); o.z = cvtpk(b.x, b.y); o.w = cvtpk(b.z, b.w); o16[64 * j] = o; }
            s = wave_sum(s);
            if (m < MP) { if (lane < 32) ssq0[(size_t)m * 32 + lane] = lane == 0 ? s : 0.f; }
            else { float* sq = (float*)(ws + WS_SSQS) + (m - MP) * 128; sq[lane] = lane == 0 ? s : 0.f; sq[64 + lane] = 0.f; }
        } else {
#pragma unroll
            for (int j = 0; j < 4; ++j) o16[64 * j] = (v4u){0u, 0u, 0u, 0u};
            if (lane < 32) ssq0[(size_t)m * 32 + lane] = 0.f;
        }
    }
    const int gt = gw * 64 + lane, NGT = NGW * 64;
    {
        float* ct = (float*)(ws + WS_ROPE); float* st = ct + 4097 * 32;
        for (int e = gt; e < 4097 * 32; e += NGT) { const int p = e >> 5, i = e & 31; const double pos = p < 4096 ? (double)p : (double)PASTLEN;
            const float invf = powf(10000.0f, -(float)i / 32.0f); const float angf = (float)pos * invf;
            const double ang = (double)angf; const double n = rint(ang * 0.15915494309189535); const double r = ang - n * 6.283185307179586;
            ct[e] = cosf((float)r); st[e] = sinf((float)r); }
    }
    {
        f32x2v* abar = (f32x2v*)(ws + WS_ABAR); f32x2v* a32 = (f32x2v*)(ws + WS_A32); f32x2v* bbar = (f32x2v*)(ws + WS_BBAR);
        for (int e = gt; e < DEPTH * 32 * 64; e += NGT) { const int lg = e >> 6;
            const float lr = A.in[I_LAMR][e], li = A.in[I_LAMI][e], dt = expf(A.in[I_LOGDT][lg]);
            const float mag = expf(lr * dt), ar = mag * cosf(li * dt), ai = mag * sinf(li * dt);
            abar[e] = (f32x2v){ar, ai};
            const float m32 = expf(lr * dt * 32.f); a32[e] = (f32x2v){m32 * cosf(li * dt * 32.f), m32 * sinf(li * dt * 32.f)};
            const float nr = ar - 1.f, ni = ai, den = 1.f / (lr * lr + li * li); const float qr = (nr * lr + ni * li) * den, qi = (ni * lr - nr * li) * den;
            for (int c = 0; c < 16; ++c) { const float br = A.in[I_BRE][(size_t)e * 16 + c], bi = A.in[I_BIM][(size_t)e * 16 + c]; bbar[(size_t)e * 16 + c] = (f32x2v){qr * br - qi * bi, qr * bi + qi * br}; }
        }
        bf16* bfr = (bf16*)(ws + WS_BFRAG);
        for (int e = gt; e < DEPTH * 32 * 4 * 64 * 8; e += NGT) { const int j = e & 7, ln = (e >> 3) & 63, tile = (e >> 9) & 3, lg = e >> 11;
            const int pst = 32 * (tile >> 1) + (ln & 31), c = 8 * (ln >> 5) + j; const size_t src = ((size_t)lg * 64 + pst) * 16 + c;
            const float lr = A.in[I_LAMR][lg * 64 + pst], li = A.in[I_LAMI][lg * 64 + pst], dt = expf(A.in[I_LOGDT][lg]);
            const float mag = expf(lr * dt), ar = mag * cosf(li * dt), ai = mag * sinf(li * dt);
            const float nr = ar - 1.f, ni = ai, den = 1.f / (lr * lr + li * li); const float qr = (nr * lr + ni * li) * den, qi = (ni * lr - nr * li) * den;
            const float br = A.in[I_BRE][src], bi = A.in[I_BIM][src];
            bfr[e] = cvt1((tile & 1) ? qr * bi + qi * br : qr * br - qi * bi); }
        bf16* cf = (bf16*)(ws + WS_CFRAG);
        for (int e = gt; e < DEPTH * 32 * 4 * 64 * 8; e += NGT) { const int j = e & 7, ln = (e >> 3) & 63, kb = (e >> 9) & 3, lg = e >> 11;
            const int k = 32 * kb + 8 * (ln >> 4) + j, c = ln & 15, p = k >> 1;
            const float v = (k & 1) ? -A.in[I_CIM][((size_t)lg * 16 + c) * 64 + p] : A.in[I_CRE][((size_t)lg * 16 + c) * 64 + p];
            cf[e] = cvt1(v); }
    }
    {
        bf16* wt = (bf16*)(ws + WS_WTRIL);
        for (int e = gt; e < DEPTH * 4 * 128 * 128; e += NGT) { const int s = e & 127, t = (e >> 7) & 127; wt[e] = s <= t ? cvt1(A.in[I_SGW][e]) : (bf16)0; }
    }
}

#if PROBE_CK
DI void p0_xonly(Frame& F, const Args& A) {
    const int gw = F.vcu * NWAVES + F.wave, NGW = F.G * NWAVES, lane = opaque_tid() & 63;
    unsigned char* ws = F.ws;
    float* ssq0 = (float*)(ws + WS_SSQP);
    for (int m = gw; m < MPAD; m += NGW) {
        GAS v4u* o16 = (GAS v4u*)((bf16*)(ws + WS_XB) + (size_t)m * DM) + lane;
        if (m < pg8::MROWS) {
            const float* xrow = m < MP ? A.in[I_XP] + (size_t)m * DM : A.in[I_XS] + (size_t)(m - MP) * DM;
            const GAS f32x4* xr = (const GAS f32x4*)xrow + 2 * lane;
            float s = 0.f;
#pragma unroll
            for (int j = 0; j < 4; ++j) { const f32x4 a = xr[128 * j], b = xr[128 * j + 1];
                s += (a.x * a.x + a.y * a.y) + (a.z * a.z + a.w * a.w) + (b.x * b.x + b.y * b.y) + (b.z * b.z + b.w * b.w);
                v4u o; o.x = cvtpk(a.x, a.y); o.y = cvtpk(a.z, a.w); o.z = cvtpk(b.x, b.y); o.w = cvtpk(b.z, b.w); o16[64 * j] = o; }
            s = wave_sum(s);
            if (m < MP) { if (lane < 32) ssq0[(size_t)m * 32 + lane] = lane == 0 ? s : 0.f; }
            else { float* sq = (float*)(ws + WS_SSQS) + (m - MP) * 128; sq[lane] = lane == 0 ? s : 0.f; sq[64 + lane] = 0.f; }
        } else {
#pragma unroll
            for (int j = 0; j < 4; ++j) o16[64 * j] = (v4u){0u, 0u, 0u, 0u};
            if (lane < 32) ssq0[(size_t)m * 32 + lane] = 0.f;
        }
    }
}
#endif
struct Lyr {
    int l;
    const bf16* Z; const float* ZAB; bf16* YC;
    const float* cosT; const float* sinT;
    const Args* A; float* out; unsigned char* ws;
};

DI void attn_item(Frame& F, const Lyr& L, int item) {
    const int b = item >> 6, kvh = (item >> 5) & 1, blk = item & 31, tid = opaque_tid(), l = L.l;
    LAS bf16* Ks = (LAS bf16*)(F.lds); LAS bf16* VT = (LAS bf16*)(F.lds + 36864);
    {
        const int kap = tid & 255, tk = blk * 128 - 128 + kap;
        if (tid < 256) {
            if (tk >= 0) {
                const GAS v4u* src = (const GAS v4u*)(L.Z + (size_t)(b * SEQ + tk) * ZW + ZC_K + kvh * 64);
                float x[64]; float ss = 0.f;
#pragma unroll
                for (int i = 0; i < 8; ++i) { const v4u w = src[i]; x[8 * i] = bflo(w.x); x[8 * i + 1] = bfhi(w.x); x[8 * i + 2] = bflo(w.y); x[8 * i + 3] = bfhi(w.y); x[8 * i + 4] = bflo(w.z); x[8 * i + 5] = bfhi(w.z); x[8 * i + 6] = bflo(w.w); x[8 * i + 7] = bfhi(w.w); }
#pragma unroll
                for (int i = 0; i < 64; ++i) ss += x[i] * x[i];
                const float rs = __builtin_amdgcn_rsqf(ss * (1.f / 64.f) + pg8::RMS_EPS);
                const float* kg = L.A->in[I_KNG] + l * 64;
                const bool wr = blk == 31 && kap >= 128;
                GAS float* pk = (GAS float*)(L.out + O_PK + ((size_t)((l * NB + b) * 128 + (kap - 128)) * 2 + kvh) * 64);
                const GAS f32x4* ct = (const GAS f32x4*)(L.cosT + tk * 32); const GAS f32x4* st4 = (const GAS f32x4*)(L.sinT + tk * 32);
#pragma unroll
                for (int i4 = 0; i4 < 8; ++i4) { const f32x4 c = ct[i4], s = st4[i4]; float lo[4], hi[4];
#pragma unroll
                    for (int q = 0; q < 4; ++q) { const int i = 4 * i4 + q; const float x1 = x[i] * rs * kg[i], x2 = x[i + 32] * rs * kg[i + 32]; lo[q] = x1 * c[q] - x2 * s[q]; hi[q] = x2 * c[q] + x1 * s[q]; }
                    *(LAS v2u*)(Ks + kap * 72 + 4 * i4) = (v2u){cvtpk(lo[0], lo[1]), cvtpk(lo[2], lo[3])}; *(LAS v2u*)(Ks + kap * 72 + 32 + 4 * i4) = (v2u){cvtpk(hi[0], hi[1]), cvtpk(hi[2], hi[3])};
                    if (wr) { *(GAS f32x4*)(pk + 4 * i4) = (f32x4){lo[0], lo[1], lo[2], lo[3]}; *(GAS f32x4*)(pk + 32 + 4 * i4) = (f32x4){hi[0], hi[1], hi[2], hi[3]}; }
                    }
            } else {
#pragma unroll
                for (int i = 0; i < 8; ++i) *(LAS v4u*)(Ks + kap * 72 + 8 * i) = (v4u){0u, 0u, 0u, 0u};
            }
        } else {
            if (tk >= 0) {
                const GAS v4u* src = (const GAS v4u*)(L.Z + (size_t)(b * SEQ + tk) * ZW + ZC_V + kvh * 64);
#pragma unroll
                for (int i = 0; i < 8; ++i) { const v4u w = src[i]; const unsigned ww[4] = {w.x, w.y, w.z, w.w};
#pragma unroll
                    for (int q = 0; q < 4; ++q) { VT[(8 * i + 2 * q) * 264 + kap] = (bf16)(ww[q] & 0xffffu); VT[(8 * i + 2 * q + 1) * 264 + kap] = (bf16)(ww[q] >> 16); }
                    if (blk == 31 && kap >= 128) { GAS f32x4* pv = (GAS f32x4*)(L.out + O_PV + ((size_t)((l * NB + b) * 128 + (kap - 128)) * 2 + kvh) * 64) + 2 * i;
                        pv[0] = (f32x4){bflo(w.x), bfhi(w.x), bflo(w.y), bfhi(w.y)}; pv[1] = (f32x4){bflo(w.z), bfhi(w.z), bflo(w.w), bfhi(w.w)}; } }
            } else {
#pragma unroll
                for (int d = 0; d < 64; ++d) VT[d * 264 + kap] = (bf16)0;
            }
        }
    }
    __syncthreads();
    const int w = F.wave, lane = opaque_tid() & 63, r = lane & 31, h = lane >> 5, g = w >> 1, head = kvh * 4 + g;
    const float sinkl = L.A->in[I_SINK][l * 8 + head] * LOG2E;
    const float* qg = L.A->in[I_QNG] + l * 64;
#pragma unroll 1
    for (int sub = 0; sub < 2; ++sub) {
        const int q0 = (w & 1) * 64 + sub * 32, tq = blk * 128 + q0 + r;
        bf16x8 qf[4];
        {
            const GAS v4u* src = (const GAS v4u*)(L.Z + (size_t)(b * SEQ + tq) * ZW + ZC_Q + head * 64 + 8 * h);
            float x[4][8]; float ss = 0.f;
#pragma unroll
            for (int ks = 0; ks < 4; ++ks) { const v4u wv = src[2 * ks]; x[ks][0] = bflo(wv.x); x[ks][1] = bfhi(wv.x); x[ks][2] = bflo(wv.y); x[ks][3] = bfhi(wv.y); x[ks][4] = bflo(wv.z); x[ks][5] = bfhi(wv.z); x[ks][6] = bflo(wv.w); x[ks][7] = bfhi(wv.w);
#pragma unroll
                for (int j = 0; j < 8; ++j) ss += x[ks][j] * x[ks][j]; }
            ss += __shfl_xor(ss, 32);
            const float rs = __builtin_amdgcn_rsqf(ss * (1.f / 64.f) + pg8::RMS_EPS) ;
            const float sc = 0.125f * LOG2E;
            float o[4][8];
#pragma unroll
            for (int kp = 0; kp < 2; ++kp)
#pragma unroll
                for (int j = 0; j < 8; ++j) { const int i = 16 * kp + 8 * h + j; const float c = L.cosT[tq * 32 + i], s = L.sinT[tq * 32 + i];
                    const float x1 = x[kp][j] * rs * qg[i], x2 = x[kp + 2][j] * rs * qg[i + 32];
                    o[kp][j] = (x1 * c - x2 * s) * sc; o[kp + 2][j] = (x2 * c + x1 * s) * sc; }
#pragma unroll
            for (int ks = 0; ks < 4; ++ks) qf[ks] = pack8(o[ks][0], o[ks][1], o[ks][2], o[ks][3], o[ks][4], o[ks][5], o[ks][6], o[ks][7]);
        }
        f32x16 st[5];
#pragma unroll
        for (int kt = 0; kt < 5; ++kt) {
#pragma unroll
            for (int i = 0; i < 16; ++i) st[kt][i] = 0.f;
#pragma unroll
            for (int ks = 0; ks < 4; ++ks) { const bf16x8 a = *(const LAS bf16x8*)(Ks + (q0 + 32 * kt + r) * 72 + 16 * ks + 8 * h); st[kt] = MFMA32(a, qf[ks], st[kt]); }
        }
        float mx = sinkl; const int rlo = r + 1 - 4 * h, kmin = 128 - q0 - 4 * h;
#pragma unroll
        for (int kt = 0; kt < 5; ++kt)
#pragma unroll
            for (int i = 0; i < 16; ++i) { const int kk = 32 * kt + CR(i);
                const bool ok = (kk >= rlo) && (kk <= rlo + 127) && (blk > 0 || kk >= kmin);
                st[kt][i] = ok ? st[kt][i] : -INFINITY; mx = fmaxf(mx, st[kt][i]); }
        mx = fmaxf(mx, __shfl_xor(mx, 32));
        float sum = 0.f;
#pragma unroll
        for (int kt = 0; kt < 5; ++kt)
#pragma unroll
            for (int i = 0; i < 16; ++i) { const float p = __builtin_amdgcn_exp2f(st[kt][i] - mx); st[kt][i] = p; sum += p; }
        sum += __shfl_xor(sum, 32);
        const float inv = __builtin_amdgcn_rcpf(sum + __builtin_amdgcn_exp2f(sinkl - mx));
#pragma unroll
        for (int kt = 0; kt < 5; ++kt) st[kt] = st[kt] * inv;
        f32x16 o2[2];
#pragma unroll
        for (int dt = 0; dt < 2; ++dt) {
#pragma unroll
            for (int i = 0; i < 16; ++i) o2[dt][i] = 0.f; }
#pragma unroll
        for (int kt = 0; kt < 5; ++kt)
#pragma unroll
            for (int s = 0; s < 2; ++s) { const bf16x8 pa = pack_step(st[kt], s);
#pragma unroll
                for (int dt = 0; dt < 2; ++dt) { const LAS bf16* vp = VT + (dt * 32 + r) * 264 + q0 + 32 * kt + 16 * s + 4 * h;
                    const v2u lo = *(const LAS v2u*)vp, hi = *(const LAS v2u*)(vp + 8); const v4u bb = {lo.x, lo.y, hi.x, hi.y};
                    o2[dt] = MFMA32(pa, __builtin_bit_cast(bf16x8, bb), o2[dt]); } }
        GAS bf16* yo = (GAS bf16*)L.YC + (size_t)(b * SEQ + blk * 128 + q0 + 4 * h) * DM + head * 64 + r;
#pragma unroll
        for (int i = 0; i < 16; ++i) {
#pragma unroll
            for (int dt = 0; dt < 2; ++dt) yo[CR(i) * DM + dt * 32] = cvt1(o2[dt][i]); }
    }
    __syncthreads();
}
DI void sgate_item(Frame& F, const Lyr& L, int item) {
    const int b = item >> 7, n = (item >> 2) & 31, g = item & 3, tid = opaque_tid(), l = L.l;
    LAS bf16* VT = (LAS bf16*)(F.lds);
    const int t = tid >> 2, qd = tid & 3, m0 = b * SEQ + n * 128;
    {
        const GAS f32x4* sp = (const GAS f32x4*)((const float*)(L.ws + WS_SGQ) + (size_t)(m0 + t) * 8); const f32x4 s0 = sp[0], s1 = sp[1];
        const float ss = ((s0[0] + s0[1]) + (s0[2] + s0[3])) + ((s1[0] + s1[1]) + (s1[2] + s1[3]));
        const float rs = __builtin_amdgcn_rsqf(ss * (1.f / 512.f) + pg8::RMS_EPS);
        const GAS v4u* sg = (const GAS v4u*)(L.Z + (size_t)(m0 + t) * ZW + ZC_GV + g * 128 + qd * 32);
        const float* gn = L.A->in[I_SGNG] + l * 512 + g * 128 + qd * 32;
#pragma unroll
        for (int i = 0; i < 4; ++i) { const v4u w = sg[i]; const unsigned ww[4] = {w.x, w.y, w.z, w.w};
#pragma unroll
            for (int q = 0; q < 4; ++q) { const int hc = qd * 32 + 8 * i + 2 * q; const float a = bflo(ww[q]) * rs * gn[8 * i + 2 * q], c = bfhi(ww[q]) * rs * gn[8 * i + 2 * q + 1];
                VT[hc * 136 + t] = cvt1(a); VT[(hc + 1) * 136 + t] = cvt1(c);
                if (n == 31) { float* pc = L.out + O_PCV + ((size_t)(l * NB + b) * 128 + t) * 512 + g * 128 + hc; pc[0] = a; pc[1] = c; } } }
    }
    __syncthreads();
    const int w = F.wave, lane = opaque_tid() & 63, r = lane & 31, h = lane >> 5, tt = w >> 1;
    const bf16* Wt = (const bf16*)(L.ws + WS_WTRIL) + (size_t)(l * 4 + g) * 16384;
    f32x16 acc[2];
#pragma unroll
    for (int i = 0; i < 2; ++i)
#pragma unroll
        for (int k = 0; k < 16; ++k) acc[i][k] = 0.f;
    bf16x8 af[8];
#pragma unroll
    for (int ks = 0; ks < 8; ++ks) af[ks] = *(const GAS bf16x8*)(Wt + (tt * 32 + r) * 128 + 16 * ks + 8 * h);
#pragma unroll
    for (int ks = 0; ks < 8; ++ks) if (ks < 2 * (tt + 1)) {
#pragma unroll
        for (int i = 0; i < 2; ++i) { const int ht = 2 * (w & 1) + i; const bf16x8 bq = *(const LAS bf16x8*)(VT + (ht * 32 + r) * 136 + 16 * ks + 8 * h); acc[i] = MFMA32(af[ks], bq, acc[i]); }
    }
    const float* bias = L.A->in[I_SGB] + (l * 4 + g) * 128;
#pragma unroll
    for (int i = 0; i < 2; ++i) { const int hc = (2 * (w & 1) + i) * 32 + r;
        const GAS bf16* zu = (const GAS bf16*)L.Z + (size_t)(m0 + tt * 32 + 4 * h) * ZW + ZC_GU + g * 128 + hc; GAS bf16* yo = (GAS bf16*)L.YC + (size_t)(m0 + tt * 32 + 4 * h) * DM + 1024 + g * 128 + hc;
        const float* bs = bias + tt * 32 + 4 * h;
#pragma unroll
        for (int k = 0; k < 16; ++k) { const float u = bf2f(zu[CR(k) * ZW]); yo[CR(k) * DM] = cvt1(u * (acc[i][k] + bs[CR(k)])); } }
    __syncthreads();
}

DI void ssm_pass1_task(Frame& F, const Lyr& L, int task) {
    const int b = task >> 10, sb = (task >> 5) & 31, g = task & 31, lane = opaque_tid() & 63, p = lane, r = lane & 31, hh = lane >> 5, l = L.l, w = F.wave;
    LAS unsigned* Sw = (LAS unsigned*)(F.lds + w * 8704);
    const int e = (l * 32 + g) * 64 + p;
    const f32x2v a = ((const f32x2v*)(L.ws + WS_ABAR))[e];
    const GAS bf16x8* bfp = (const GAS bf16x8*)((const bf16*)(L.ws + WS_BFRAG) + (size_t)(l * 32 + g) * 2048) + lane;
    bf16x8 Bf[4];
#pragma unroll
    for (int t = 0; t < 4; ++t) Bf[t] = bfp[t * 64];
    const GAS bf16x8* up = (const GAS bf16x8*)(L.Z + (size_t)(b * SEQ + sb * 128 + r) * ZW + ZC_SU + g * 16 + 8 * hh);
    bf16x8 ub[4];
#pragma unroll
    for (int j = 0; j < 4; ++j) ub[j] = up[(size_t)j * 32 * ZW / 8];
    float sr = 0.f, si = 0.f;
    f32x16 zero;
#pragma unroll
    for (int k = 0; k < 16; ++k) zero[k] = 0.f;
#pragma unroll 1
    for (int j = 0; j < 4; ++j) {
        const bf16x8 uj = j == 0 ? ub[0] : j == 1 ? ub[1] : j == 2 ? ub[2] : ub[3];
#pragma unroll
        for (int q = 0; q < 2; ++q) { const f32x16 re = MFMA32(uj, Bf[2 * q], zero), im = MFMA32(uj, Bf[2 * q + 1], zero);
#pragma unroll
            for (int k = 0; k < 16; ++k) Sw[(CR(k) + 4 * hh) * 68 + 32 * q + r] = cvtpk(re[k], im[k]); }
        LDS_WAIT(); asm volatile("" ::: "memory");
        unsigned wv[32];
#pragma unroll
        for (int t = 0; t < 32; ++t) wv[t] = Sw[t * 68 + p];
        {
            GAS unsigned* bu = (GAS unsigned*)(L.ws + WS_BU) + ((size_t)(b * 32 + g) * 128 + sb * 4 + j) * 2048 + p;
#pragma unroll
            for (int t = 0; t < 32; ++t) bu[t * 64] = wv[t]; }
#pragma unroll
        for (int t = 0; t < 32; ++t) { const float nr = a.x * sr - a.y * si + bflo(wv[t]), ni = a.x * si + a.y * sr + bfhi(wv[t]); sr = nr; si = ni; }
        ((f32x2v*)(L.ws + WS_E))[((size_t)(b * 32 + g) * 128 + sb * 4 + j) * 64 + p] = (f32x2v){sr, si};
        LDS_WAIT(); asm volatile("" ::: "memory");
    }
}
constexpr int DP_KF = 0, DP_VF = 32768, DP_QB = 65536, DP_KB = 82944, DP_AM = 100352, DP_GC = 116736, DP_BETA = DP_GC + 256, DP_EG = DP_GC + 512, DP_KEX = DP_GC + 768;
DI void dprep_item(Frame& F, const Lyr& L, int item) {
    const int b = item >> 8, h = (item >> 6) & 3, n = item & 63, l = L.l; int tid = opaque_tid();
    LAS float* Kf = (LAS float*)(F.lds + DP_KF); LAS float* Vf = (LAS float*)(F.lds + DP_VF);
    LAS bf16* Qb = (LAS bf16*)(F.lds + DP_QB); LAS bf16* Kb = (LAS bf16*)(F.lds + DP_KB);
    LAS float* Am = (LAS float*)(F.lds + DP_AM);
    LAS float* gcs = (LAS float*)(F.lds + DP_GC); LAS float* betas = (LAS float*)(F.lds + DP_BETA); LAS float* egs = (LAS float*)(F.lds + DP_EG); LAS float* kex = (LAS float*)(F.lds + DP_KEX);
    const int m0 = b * SEQ + n * 64;
    {
        const int t = tid >> 3, sub = tid & 7, tg = n * 64 + t;
#pragma unroll 1
        for (int wh = 0; wh < 3; ++wh) {
            const int ch0 = wh * 512 + h * 128 + sub * 16;
            const float* cw = L.A->in[I_CONVW] + (size_t)l * 4 * 1536 + ch0;
            float y[16];
#pragma unroll
            for (int c = 0; c < 16; ++c) y[c] = 0.f;
#pragma unroll
            for (int i = 0; i < 4; ++i) {
                if (tg - 3 + i >= 0) {
                    const GAS v4u* src = (const GAS v4u*)(L.Z + (size_t)(m0 + t - 3 + i) * ZW + ZC_DQ + ch0); const v4u a0 = src[0], a1 = src[1];
                    const unsigned ww[8] = {a0.x, a0.y, a0.z, a0.w, a1.x, a1.y, a1.z, a1.w};
#pragma unroll
                    for (int q = 0; q < 8; ++q) { y[2 * q] += cw[i * 1536 + 2 * q] * bflo(ww[q]); y[2 * q + 1] += cw[i * 1536 + 2 * q + 1] * bfhi(ww[q]); }
                    if (i == 3 && n == 63 && t >= 61) { float* pc = L.out + O_PC + ((size_t)(l * NB + b) * 3 + (t - 61)) * 1536 + ch0;
#pragma unroll
                        for (int q = 0; q < 8; ++q) { pc[2 * q] = bflo(ww[q]); pc[2 * q + 1] = bfhi(ww[q]); } }
                }
            }
            float ss = 0.f;
#pragma unroll
            for (int c = 0; c < 16; ++c) { y[c] = siluf_(y[c]); ss += y[c] * y[c]; }
            ss += __shfl_xor(ss, 1); ss += __shfl_xor(ss, 2); ss += __shfl_xor(ss, 4);
            const float rn = wh == 0 ? __builtin_amdgcn_rsqf(ss + pg8::RMS_EPS) * 0.08838834764831845f : (wh == 1 ? __builtin_amdgcn_rsqf(ss + pg8::RMS_EPS) : 1.0f);
            LAS bf16* bdst = (wh == 0 ? Qb : Kb) + t * 136 + sub * 16; LAS float* fdst = (wh == 1 ? Kf : Vf) + t * 128 + sub * 16;
#pragma unroll
            for (int c = 0; c < 16; c += 2) { const float v0 = y[c] * rn, v1 = y[c + 1] * rn;
                if (wh < 2) *(LAS unsigned*)(bdst + c) = cvtpk(v0, v1);
                if (wh > 0) { fdst[c] = v0; fdst[c + 1] = v1; } }
        }
    }
    tid = opaque_tid();
    if (tid < 64) {
        const int t = tid; const float* zab = L.ZAB + (size_t)(m0 + t) * 8;
        const float gg = -__expf(L.A->in[I_ALOG][l * 4 + h]) * softplusf_(zab[h] + L.A->in[I_DTB][l * 4 + h]);
        float c = gg;
#pragma unroll
        for (int o = 1; o < 64; o <<= 1) { const float v = __shfl_up(c, o); if (t >= o) c += v; }
        const float clast = __shfl(c, 63);
        gcs[t] = c; betas[t] = sigmoidf_(zab[4 + h]); egs[t] = __expf(c); kex[t] = __expf(clast - c);
        if (t == 63) ((float*)(L.ws + WS_GE))[item] = __expf(c);
    }
    __syncthreads();
    {
        const int w = F.wave, lane = opaque_tid() & 63, r = lane & 31, hh = lane >> 5, which = w >> 2, tt = (w >> 1) & 1, st = w & 1;
        f32x16 acc;
#pragma unroll
        for (int k = 0; k < 16; ++k) acc[k] = 0.f;
        const LAS bf16* Ap = (which ? Qb : Kb) + (tt * 32 + r) * 136 + 8 * hh; const LAS bf16* Bp = Kb + (st * 32 + r) * 136 + 8 * hh;
#pragma unroll
        for (int ks = 0; ks < 8; ++ks) acc = MFMA32(*(const LAS bf16x8*)(Ap + 16 * ks), *(const LAS bf16x8*)(Bp + 16 * ks), acc);
        bf16* QKo = (bf16*)(L.ws + WS_QK) + (size_t)item * 4096;
        const int s = st * 32 + r; const float gs = gcs[s];
        const int tb = tt * 32 + 4 * hh; const LAS float* gct = gcs + tb; const LAS float* bet = betas + tb; LAS float* Amp = Am + tb * 64 + s; bf16* qko = QKo + frag_off(tb, s, 4);
#pragma unroll
        for (int k = 0; k < 16; ++k) { const int t = tb + CR(k); const float dec = __expf(gct[CR(k)] - gs);
            if (which == 0) Amp[CR(k) * 64] = t > s ? bet[CR(k)] * acc[k] * dec : 0.f;
            else qko[CR(k) * 8] = cvt1(t >= s ? acc[k] * dec : 0.f); }
    }
    __syncthreads();
    tid = opaque_tid();
    {
        const int u = tid & 255;
        if (tid < 256) { const int t = u >> 2, d0 = (u & 3) * 32; bf16* QG = (bf16*)(L.ws + WS_QG) + (size_t)item * 8192; const float e = egs[t];
#pragma unroll 2
          for (int d = 0; d < 32; d += 4) { const int dk = d0 + d;
              const v2u o = {cvtpk(bf2f(Qb[t * 136 + dk]) * e, bf2f(Qb[t * 136 + dk + 1]) * e), cvtpk(bf2f(Qb[t * 136 + dk + 2]) * e, bf2f(Qb[t * 136 + dk + 3]) * e)};
              *(GAS v2u*)(QG + frag_off(t, dk, 8)) = o; } }
        else { const int dk = u >> 1, s0 = (u & 1) * 32; bf16* KE = (bf16*)(L.ws + WS_KE) + (size_t)item * 8192;
#pragma unroll 2
          for (int s = 0; s < 32; s += 4) { const int tk = s0 + s;
              const v2u o = {cvtpk(Kf[tk * 128 + dk] * kex[tk], Kf[(tk + 1) * 128 + dk] * kex[tk + 1]), cvtpk(Kf[(tk + 2) * 128 + dk] * kex[tk + 2], Kf[(tk + 3) * 128 + dk] * kex[tk + 3])};
              *(GAS v2u*)(KE + frag_off(dk, tk, 4)) = o; } }
    }
    __syncthreads();
    tid = opaque_tid();
    if (tid < 256) {
        const int c = tid; const bool isw = c >= 128; LAS float* X = isw ? Kf + (c - 128) : Vf + c;
        unsigned* U0 = (unsigned*)(L.ws + WS_U0) + (size_t)item * 4096 + ((c & 127) >> 5) * 1024 + (c & 31); bf16* WN = (bf16*)(L.ws + WS_WN) + (size_t)item * 8192;
#pragma unroll 1
        for (int tb = 0; tb < 4; ++tb) {
            float a[16];
#pragma unroll
            for (int i = 0; i < 16; ++i) { const int t = tb * 16 + i; a[i] = betas[t] * (isw ? egs[t] : 1.0f) * X[t * 128]; }
#pragma unroll 1
            for (int sb = 0; sb < tb; ++sb) {
                float xs[16];
#pragma unroll
                for (int j = 0; j < 16; ++j) xs[j] = X[(sb * 16 + j) * 128];
#pragma unroll
                for (int i = 0; i < 16; ++i) { const LAS f32x4* ar = (const LAS f32x4*)(Am + (tb * 16 + i) * 64 + sb * 16);
#pragma unroll
                    for (int j4 = 0; j4 < 4; ++j4) { const f32x4 av = ar[j4]; a[i] -= av.x * xs[4 * j4]; a[i] -= av.y * xs[4 * j4 + 1]; a[i] -= av.z * xs[4 * j4 + 2]; a[i] -= av.w * xs[4 * j4 + 3]; }
                    if ((i & 3) == 3) asm volatile("" ::: "memory"); }
            }
#pragma unroll
            for (int i = 1; i < 16; ++i) { const LAS float* ar = Am + (tb * 16 + i) * 64 + tb * 16;
#pragma unroll
                for (int j = 0; j < i; ++j) a[i] -= ar[j] * a[j];
                if ((i & 3) == 3) asm volatile("" ::: "memory"); }
#pragma unroll
            for (int i = 0; i < 16; ++i) { const int t = tb * 16 + i; X[t * 128] = a[i];
                if (!isw) { if ((i & 1) == 0) U0[(((tb >> 1) * 8 + (((i & 3) >> 1) | ((2 * (tb & 1) + (i >> 3)) << 1))) * 64) + ((i >> 2) & 1) * 32] = cvtpk(a[i], a[i + 1 < 16 ? i + 1 : 15]); } else WN[frag_off(t, c - 128, 8)] = cvt1(-a[i]); }
        }
    }
    __syncthreads();
}
constexpr int SC_BUF = 57344, SC_WN = 0, SC_QG = 16384, SC_QK = 32768, SC_KE = 40960;
struct ScanRegs { v4u a[14]; };
DI void dscan_issue(ScanRegs& R, const unsigned char* ws, size_t item, int lw, int lane) {
    const GAS v4u* wn = (const GAS v4u*)(ws + WS_WN + item * 16384) + lane; const GAS v4u* qg = (const GAS v4u*)(ws + WS_QG + item * 16384) + lane;
    const GAS v4u* qk = (const GAS v4u*)(ws + WS_QK + item * 8192) + lane;  const GAS v4u* ke = (const GAS v4u*)(ws + WS_KE + item * 16384) + lane;
#pragma unroll
    for (int i = 0; i < 4; ++i) { const int f = lw + 4 * i; R.a[i] = wn[f * 64]; R.a[4 + i] = qg[f * 64]; R.a[8 + i] = ke[f * 64]; }
#pragma unroll
    for (int i = 0; i < 2; ++i) R.a[12 + i] = qk[(lw + 4 * i) * 64];
}
DI void dscan_store_a(const ScanRegs& R, LAS unsigned char* buf, int lw, int lane) {
    LAS v4u* b = (LAS v4u*)buf + lane;
#pragma unroll
    for (int i = 0; i < 4; ++i) { const int f = lw + 4 * i; b[(SC_WN / 16) + f * 64] = R.a[i]; b[(SC_QG / 16) + f * 64] = R.a[4 + i]; b[(SC_KE / 16) + f * 64] = R.a[8 + i]; }
#pragma unroll
    for (int i = 0; i < 2; ++i) b[(SC_QK / 16) + (lw + 4 * i) * 64] = R.a[12 + i];
}
#define SC_RD(off) (*(const LAS bf16x8*)(buf + (off)))
#define SC_SB() __builtin_amdgcn_sched_barrier(0)
DI void dscan_chunk(f32x16 (&S)[4], unsigned (&Uw)[16], unsigned (&Unw)[16], float& gen, const LAS unsigned char* buf, const GAS unsigned* U1, const GAS float* GE, GAS unsigned* od, int n) {
    f32x16 U[2];
#pragma unroll
    for (int rt = 0; rt < 2; ++rt)
#pragma unroll
        for (int kp = 0; kp < 8; ++kp) { U[rt][2 * kp] = bflo(Uw[rt * 8 + kp]); U[rt][2 * kp + 1] = bfhi(Uw[rt * 8 + kp]); }
    const float ge = gen;
    f32x16 O[2];
    bf16x8 fa[4], fb[4];
    fa[0] = SC_RD(SC_WN); fa[1] = SC_RD(SC_QG); fa[2] = SC_RD(SC_WN + 8 * 1024); fa[3] = SC_RD(SC_QG + 8 * 1024);
    const bool more = n + 1 < 64;
    f32x16 zero;
#pragma unroll
    for (int k = 0; k < 16; ++k) zero[k] = 0.f;
    bf16x8 qa[2], qb[2];
#pragma unroll
    for (int ks = 0; ks < 8; ++ks) {
        bf16x8 (&cur)[4] = (ks & 1) ? fb : fa; bf16x8 (&nxt)[4] = (ks & 1) ? fa : fb;
        if (ks < 7) { nxt[0] = SC_RD(SC_WN + (ks + 1) * 1024); nxt[1] = SC_RD(SC_QG + (ks + 1) * 1024); nxt[2] = SC_RD(SC_WN + (8 + ks + 1) * 1024); nxt[3] = SC_RD(SC_QG + (8 + ks + 1) * 1024); }
        else { qa[0] = SC_RD(SC_QK); qa[1] = SC_RD(SC_QK + 4 * 1024); }
        SC_SB();
        const bf16x8 sb = pack_step(S[ks >> 1], ks & 1);
        U[0] = MFMA32(cur[0], sb, U[0]); O[0] = MFMA32(cur[1], sb, ks == 0 ? zero : O[0]); U[1] = MFMA32(cur[2], sb, U[1]); O[1] = MFMA32(cur[3], sb, ks == 0 ? zero : O[1]);
        if (more) { if (ks == 0) gen = GE[n + 1];
#pragma unroll
            for (int j = 0; j < 2; ++j) Unw[(ks >> 2) * 8 + 2 * (ks & 3) + j] = U1[((ks >> 2) * 8 + 2 * (ks & 3) + j) * 64]; }
        if (ks & 1) S[ks >> 1] = S[ks >> 1] * ge;
        SC_SB();
    }
    bf16x8 Ub[4];
#pragma unroll
    for (int rt = 0; rt < 2; ++rt) { Ub[2 * rt] = pack_step(U[rt], 0); Ub[2 * rt + 1] = pack_step(U[rt], 1); }
#pragma unroll
    for (int ks = 0; ks < 4; ++ks) {
        bf16x8 (&cur)[2] = (ks & 1) ? qb : qa; bf16x8 (&nxt)[2] = (ks & 1) ? qa : qb;
        if (ks < 3) { nxt[0] = SC_RD(SC_QK + (ks + 1) * 1024); nxt[1] = SC_RD(SC_QK + (4 + ks + 1) * 1024); }
        else {
#pragma unroll
            for (int d = 0; d < 4; ++d) fa[d] = SC_RD(SC_KE + (d * 4) * 1024); }
        SC_SB();
        O[0] = MFMA32(cur[0], Ub[ks], O[0]); O[1] = MFMA32(cur[1], Ub[ks], O[1]);
        SC_SB();
    }
#pragma unroll
    for (int ks = 0; ks < 4; ++ks) {
        bf16x8 (&cur)[4] = (ks & 1) ? fb : fa; bf16x8 (&nxt)[4] = (ks & 1) ? fa : fb;
        if (ks < 3) {
#pragma unroll
            for (int d = 0; d < 4; ++d) nxt[d] = SC_RD(SC_KE + (d * 4 + ks + 1) * 1024); }
        SC_SB();
#pragma unroll
        for (int d = 0; d < 4; ++d) S[d] = MFMA32(cur[d], Ub[ks], S[d]);
#pragma unroll
        for (int j = 0; j < 4; ++j) od[((ks >> 1) * 8 + 4 * (ks & 1) + j) * 64] = cvtpk(O[ks >> 1][8 * (ks & 1) + 2 * j], O[ks >> 1][8 * (ks & 1) + 2 * j + 1]);
        SC_SB();
    }
}
DI void dscan_wg(Frame& F, const Lyr& L, int bh, size_t od_extra = 0, int hs_ = 0) {
    const int b = bh >> 2, h = bh & 3, w = F.wave, lane = opaque_tid() & 63, r = lane & 31, hh = lane >> 5, dv0 = (w & 3) * 32, l = L.l;
    const bool loader = w >= 4; const int lw = w - 4;
    const size_t item0 = (size_t)bh * 64;
    if (loader) {
        ScanRegs R0, R1, R2, R3;
        dscan_issue(R0, L.ws, item0, lw, lane);
        asm volatile("s_waitcnt vmcnt(0)" ::: "memory");
        dscan_store_a(R0, F.lds, lw, lane);
        asm volatile("s_waitcnt lgkmcnt(0)" ::: "memory");
        dscan_issue(R1, L.ws, item0 + 1, lw, lane);
        dscan_issue(R2, L.ws, item0 + 2, lw, lane);
        dscan_issue(R3, L.ws, item0 + 3, lw, lane);
#define SC_TRIP(RS, RN, BUFOFF, NEXT) \
            __builtin_amdgcn_s_barrier(); asm volatile("" ::: "memory"); \
            asm volatile("s_waitcnt vmcnt(28)" ::: "memory"); \
            dscan_store_a(RS, F.lds + (BUFOFF), lw, lane); \
            asm volatile("s_waitcnt lgkmcnt(0)" ::: "memory"); \
            dscan_issue(RN, L.ws, item0 + ((NEXT) < 64 ? (NEXT) : 63), lw, lane);
#pragma unroll 1
        for (int n = 0; n < 64; n += 4) {
            SC_TRIP(R1, R0, SC_BUF, n + 4)
            SC_TRIP(R2, R1, 0, n + 5)
            SC_TRIP(R3, R2, SC_BUF, n + 6)
            SC_TRIP(R0, R3, 0, n + 7)
        }
#undef SC_TRIP
        asm volatile("s_waitcnt vmcnt(0)" ::: "memory");
    } else {
        f32x16 S[4]; unsigned UA[16], UB[16];
#pragma unroll
        for (int d = 0; d < 4; ++d)
#pragma unroll
            for (int k = 0; k < 16; ++k) S[d][k] = 0.f;
        const int uoff = (4 * hh) * 128 + dv0 + r, sl = w & 3;
        GAS unsigned* ODp = (GAS unsigned*)(L.ws + WS_OD) + (item0 * 4 + sl) * 1024 + lane;
        const GAS unsigned* U0 = (const GAS unsigned*)((const unsigned*)(L.ws + WS_U0) + item0 * 4096) + sl * 1024 + lane;
        const GAS float* GE = (const GAS float*)(L.ws + WS_GE) + item0;
        float gen = GE[0];
#pragma unroll
        for (int rt = 0; rt < 2; ++rt)
#pragma unroll
            for (int kp = 0; kp < 8; ++kp) UA[rt * 8 + kp] = U0[(rt * 8 + kp) * 64];
#pragma unroll 1
        for (int n = 0; n < 64; n += 2) {
            __builtin_amdgcn_s_barrier(); asm volatile("" ::: "memory");
            dscan_chunk(S, UA, UB, gen, F.lds + lane * 16, U0 + (size_t)(n + 1) * 4096, GE, ODp + (size_t)n * 4096, n);
            __builtin_amdgcn_s_barrier(); asm volatile("" ::: "memory");
            dscan_chunk(S, UB, UA, gen, F.lds + SC_BUF + lane * 16, U0 + (size_t)(n + 2) * 4096, GE, ODp + (size_t)(n + 1) * 4096, n + 1);
        }
        GAS float* PD = (GAS float*)(L.out + O_PD + ((size_t)(l * NB + b) * 4 + h) * 16384);
#pragma unroll
        for (int d = 0; d < 4; ++d)
#pragma unroll
            for (int k = 0; k < 16; ++k) (PD + (d * 32 + CR(k)) * 128)[uoff] = S[d][k];
    }
    __syncthreads();
}

DI void ssm_pass2_item(Frame& F, const Lyr& L, int item) {
    const int b = item >> 7, blk = item & 127, w = F.wave, lane = opaque_tid() & 63, l = L.l;
    LAS bf16* Sw = (LAS bf16*)(F.lds + w * 8704); LAS bf16* Y = (LAS bf16*)(F.lds + 69632);
    const int m0 = b * SEQ + blk * 32;
#pragma unroll 1
    for (int gi = 0; gi < 4; ++gi) {
        const int g = 4 * w + gi, p = lane, e = (l * 32 + g) * 64 + p;
        const f32x2v a = ((const f32x2v*)(L.ws + WS_ABAR))[e], a32 = ((const f32x2v*)(L.ws + WS_A32))[e];
        float sr = 0.f, si = 0.f; unsigned wv[32];
        const GAS f32x2v* E = (const GAS f32x2v*)(L.ws + WS_E) + (size_t)(b * 32 + g) * 128 * 64 + p;
        {
            float t2r = a32.x * a32.x - a32.y * a32.y, t2i = 2.f * a32.x * a32.y; const float a128r = t2r * t2r - t2i * t2i, a128i = 2.f * t2r * t2i;
            const int sbn = blk >> 2, jn = blk & 3;
            const GAS unsigned* bu = (const GAS unsigned*)(L.ws + WS_BU) + ((size_t)(b * 32 + g) * 128 + blk) * 2048 + p;
            f32x2v evs[31];
#pragma unroll
            for (int i = 0; i < 31; ++i) evs[i] = E[(4 * (i < sbn ? i : 0) + 3) * 64];
            const f32x2v evl = E[(jn > 0 ? blk - 1 : 0) * 64];
#pragma unroll
            for (int t = 0; t < 16; ++t) wv[t] = bu[t * 64];
#pragma unroll
            for (int i = 0; i < 31; ++i) if (i < sbn) { const float nr = a128r * sr - a128i * si + evs[i].x, ni = a128r * si + a128i * sr + evs[i].y; sr = nr; si = ni; }
            if (jn > 0) { const f32x2v ev = evl;
                for (int j = 0; j < jn; ++j) { const float nr = a32.x * sr - a32.y * si, ni = a32.x * si + a32.y * sr; sr = nr; si = ni; }
                sr += ev.x; si += ev.y; }
        }
        const bf16* zrow = L.Z + (size_t)m0 * ZW + ZC_SU + g * 16;
        const int r16 = lane & 15, q4 = lane >> 4;
        const GAS bf16x8* Cf = (const GAS bf16x8*)((const bf16*)(L.ws + WS_CFRAG) + (size_t)(l * 32 + g) * 2048) + lane;
        bf16x8 cbv[4]; unsigned short uz[8];
#pragma unroll
        for (int kb = 0; kb < 4; ++kb) cbv[kb] = Cf[kb * 64];
        const float dsk = L.A->in[I_SSMD][l * 512 + g * 16 + r16];
#pragma unroll
        for (int rt = 0; rt < 2; ++rt)
#pragma unroll
            for (int k = 0; k < 4; ++k) uz[rt * 4 + k] = zrow[(size_t)(rt * 16 + 4 * q4 + k) * ZW + r16];
        {
            const GAS unsigned* bu2 = (const GAS unsigned*)(L.ws + WS_BU) + ((size_t)(b * 32 + g) * 128 + blk) * 2048 + p;
#pragma unroll
            for (int t = 16; t < 32; ++t) wv[t] = bu2[t * 64];
#pragma unroll
            for (int t = 0; t < 32; ++t) { const float nr = a.x * sr - a.y * si + bflo(wv[t]), ni = a.x * si + a.y * sr + bfhi(wv[t]); sr = nr; si = ni;
                *(LAS unsigned*)(Sw + t * 136 + 2 * p) = cvtpk(sr, si); }
        }
        if (blk == 127) { L.out[O_PSR + (size_t)((l * NB + b) * 32 + g) * 64 + p] = sr; L.out[O_PSI + (size_t)((l * NB + b) * 32 + g) * 64 + p] = si; }
        LDS_WAIT(); asm volatile("" ::: "memory");
        f32x4 yy[2] = {{0.f, 0.f, 0.f, 0.f}, {0.f, 0.f, 0.f, 0.f}};
#pragma unroll
        for (int kb = 0; kb < 4; ++kb) { const bf16x8 cb = cbv[kb];
#pragma unroll
            for (int rt = 0; rt < 2; ++rt) yy[rt] = MFMA16(*(const LAS bf16x8*)(Sw + (rt * 16 + r16) * 136 + 32 * kb + 8 * q4), cb, yy[rt]); }
#pragma unroll
        for (int rt = 0; rt < 2; ++rt)
#pragma unroll
            for (int k = 0; k < 4; ++k) { const int t = rt * 16 + 4 * q4 + k; const float u = bf2f(uz[rt * 4 + k]);
                Y[t * 520 + g * 16 + r16] = cvt1(gelu_tanh(yy[rt][k] + dsk * u)); }
        LDS_WAIT(); asm volatile("" ::: "memory");
    }
    {
        const int r = lane & 31, hh = lane >> 5;
        const bf16* Wg = (const bf16*)(L.ws + WS_WG) + (size_t)l * 262144;
        bf16x8 wq[16][2];
#pragma unroll
        for (int j = 0; j < 8; ++j)
#pragma unroll
            for (int ct = 0; ct < 2; ++ct) wq[j][ct] = *(const GAS bf16x8*)(Wg + (size_t)(64 * w + 32 * ct + r) * 512 + 16 * j + 8 * hh);
        __syncthreads();
        f32x16 acc[2];
#pragma unroll
        for (int ct = 0; ct < 2; ++ct)
#pragma unroll
            for (int k = 0; k < 16; ++k) acc[ct][k] = 0.f;
#pragma unroll
        for (int ks = 0; ks < 32; ++ks) {
            if ((ks & 7) == 0 && ks + 8 < 32) {
#pragma unroll
                for (int j = 0; j < 8; ++j)
#pragma unroll
                    for (int ct = 0; ct < 2; ++ct) wq[(ks + 8 + j) & 15][ct] = *(const GAS bf16x8*)(Wg + (size_t)(64 * w + 32 * ct + r) * 512 + 16 * (ks + 8 + j) + 8 * hh); }
            const bf16x8 a = *(const LAS bf16x8*)(Y + r * 520 + 16 * ks + 8 * hh);
#pragma unroll
            for (int ct = 0; ct < 2; ++ct) acc[ct] = MFMA32(a, wq[ks & 15][ct], acc[ct]); }
#pragma unroll
        for (int ct = 0; ct < 2; ++ct) { const int nn = 64 * w + 32 * ct + r; const float bg = L.A->in[I_GLUB][l * 512 + nn];
            const LAS bf16* Yp = Y + (4 * hh) * 520 + nn; GAS bf16* yo = (GAS bf16*)L.YC + (size_t)(m0 + 4 * hh) * DM + 512 + nn;
#pragma unroll
            for (int k = 0; k < 16; ++k) { const float y = bf2f(Yp[CR(k) * 520]); yo[CR(k) * DM] = cvt1(y * sigmoidf_(acc[ct][k] + bg)); } }
    }
    __syncthreads();
}

DI void dpost_rows(Frame& F, const Lyr& L) {
    const int gw = F.vcu * NWAVES + F.wave, NGW = F.G * NWAVES, lane = opaque_tid() & 63, l = L.l;
    const unsigned* OD = (const unsigned*)(L.ws + WS_OD);
    const float g0 = L.A->in[I_DNG][l * 128 + 2 * lane], g1 = L.A->in[I_DNG][l * 128 + 2 * lane + 1];
    for (int rw0 = gw * 4; rw0 < MP * 4; rw0 += NGW * 4) {
        f32x2v o[4]; unsigned zg[4];
#pragma unroll
        for (int j = 0; j < 4; ++j) { const int m = (rw0 + j) >> 2, h = (rw0 + j) & 3;
            { const int tp = m & 4095, t = tp & 63, tt = t & 31, kk = (tt & 3) | ((tt >> 3) << 2);
              const v2u ow = *(const GAS v2u*)(OD + (((((size_t)((m >> 12) * 4 + h) * 64 + (tp >> 6)) * 4 + (lane >> 4)) * 2 + (t >> 5)) * 8 + (kk >> 1)) * 64 + ((tt >> 2) & 1) * 32 + 2 * (lane & 15));
              o[j] = (kk & 1) ? (f32x2v){bfhi(ow.x), bfhi(ow.y)} : (f32x2v){bflo(ow.x), bflo(ow.y)}; }
            zg[j] = *(const GAS unsigned*)(L.Z + (size_t)m * ZW + ZC_DG + h * 128 + 2 * lane); }
#pragma unroll
        for (int j = 0; j < 4; ++j) { const int m = (rw0 + j) >> 2, h = (rw0 + j) & 3;
            const float ss = wave_sum(o[j].x * o[j].x + o[j].y * o[j].y);
            const float rs = __builtin_amdgcn_rsqf(ss * (1.f / 128.f) + pg8::RMS_EPS);
            *(GAS unsigned*)(L.YC + (size_t)m * DM + 1536 + h * 128 + 2 * lane) = cvtpk(o[j].x * rs * g0 * siluf_(bflo(zg[j])), o[j].y * rs * g1 * siluf_(bfhi(zg[j]))); }
    }
}
DI float block_sum(LAS float* red, float v, int tid, int grp_waves) {
    v = wave_sum(v);
    __syncthreads();
    if ((tid & 63) == 0) red[tid >> 6] = v;
    __syncthreads();
    const int w = tid >> 6, g0 = (w / grp_waves) * grp_waves; float s = 0.f;
    for (int i = 0; i < grp_waves; ++i) s += red[g0 + i];
    return s;
}
DI void sample_attn(Frame& F, const Lyr& L, int b) {
    const int tid = opaque_tid(), lane = tid & 63, w = F.wave, l = L.l, row = MP + b;
    const bf16* zrow = L.Z + (size_t)row * ZW; bf16* yrow = L.YC + (size_t)row * DM; const Args& A = *L.A;
    LAS float* fl = (LAS float*)F.lds; LAS float* q_l = fl; LAS float* k_l = fl + 512; LAS float* v_l = fl + 640; LAS float* sc_l = fl + 768;
    const float* cosr = L.cosT + 4096 * 32; const float* sinr = L.sinT + 4096 * 32;
    {
        const int d = lane, i = d & 31;
        { const float x = bf2f(zrow[ZC_Q + tid]); const float ss = wave_sum(x * x); const float xn = x * __builtin_amdgcn_rsqf(ss * (1.f / 64.f) + pg8::RMS_EPS) * A.in[I_QNG][l * 64 + d];
          const float pr = __shfl_xor(xn, 32); const float c = cosr[i], s = sinr[i]; q_l[tid] = (d < 32 ? xn * c - pr * s : xn * c + pr * s) * 0.125f; }
        if (w < 2) { const float x = bf2f(zrow[ZC_K + tid]); const float ss = wave_sum(x * x); const float xn = x * __builtin_amdgcn_rsqf(ss * (1.f / 64.f) + pg8::RMS_EPS) * A.in[I_KNG][l * 64 + d];
          const float pr = __shfl_xor(xn, 32); const float c = cosr[i], s = sinr[i]; k_l[tid] = d < 32 ? xn * c - pr * s : xn * c + pr * s; }
        else if (w < 4) v_l[tid - 128] = bf2f(zrow[ZC_V + tid - 128]);
    }
    __syncthreads();
    const float* ck = A.in[I_CK] + (size_t)(l * NS + b) * 16384; const float* cv = A.in[I_CV] + (size_t)(l * NS + b) * 16384;
    {
        GAS f32x4* ok = (GAS f32x4*)(L.out + O_SK + (size_t)(l * NS + b) * 16384); GAS f32x4* ov = (GAS f32x4*)(L.out + O_SV + (size_t)(l * NS + b) * 16384);
#pragma unroll
        for (int k = 0; k < 8; ++k) { const int idx = tid + 512 * k, i = idx >> 5, c4 = idx & 31;
            ok[idx] = i < 127 ? ((const GAS f32x4*)ck)[idx + 32] : *(const LAS f32x4*)(k_l + 4 * c4);
            ov[idx] = i < 127 ? ((const GAS f32x4*)cv)[idx + 32] : *(const LAS f32x4*)(v_l + 4 * c4); }
    }
    const int head = w, kvh = head >> 2;
    {
        float sc[2];
#pragma unroll
        for (int jj = 0; jj < 2; ++jj) { const int j = lane + 64 * jj; float acc = 0.f;
            if (j < 127) { const GAS f32x4* kp = (const GAS f32x4*)(ck + (size_t)(j + 1) * 128 + kvh * 64);
#pragma unroll
                for (int d4 = 0; d4 < 16; ++d4) { const f32x4 kv = kp[d4]; const f32x4 qv = *(const LAS f32x4*)(q_l + head * 64 + 4 * d4); acc += (kv.x * qv.x + kv.y * qv.y) + (kv.z * qv.z + kv.w * qv.w); } }
            else {
#pragma unroll
                for (int d4 = 0; d4 < 16; ++d4) { const f32x4 kv = *(const LAS f32x4*)(k_l + kvh * 64 + 4 * d4); const f32x4 qv = *(const LAS f32x4*)(q_l + head * 64 + 4 * d4); acc += (kv.x * qv.x + kv.y * qv.y) + (kv.z * qv.z + kv.w * qv.w); } }
            sc[jj] = acc; }
        const float sink = A.in[I_SINK][l * 8 + head];
        const float mx = fmaxf(wave_max(fmaxf(sc[0], sc[1])), sink);
        const float p0 = __expf(sc[0] - mx), p1 = __expf(sc[1] - mx);
        const float inv = 1.f / (wave_sum(p0 + p1) + __expf(sink - mx));
        sc_l[head * 128 + lane] = p0 * inv; sc_l[head * 128 + lane + 64] = p1 * inv;
        LDS_WAIT(); asm volatile("" ::: "memory");
    }
    {
        const int d4 = (lane & 15) * 4, ks = lane >> 4; f32x4 o = {0.f, 0.f, 0.f, 0.f};
        const int jend = ks == 3 ? 31 : 32;
#pragma unroll 8
        for (int jj = 0; jj < jend; ++jj) { const int j = 32 * ks + jj; const float p = sc_l[head * 128 + j]; const f32x4 v = *(const GAS f32x4*)(cv + (size_t)(j + 1) * 128 + kvh * 64 + d4); o += v * p; }
        if (ks == 3) { const float p = sc_l[head * 128 + 127]; o += *(const LAS f32x4*)(v_l + kvh * 64 + d4) * p; }
#pragma unroll
        for (int e = 0; e < 4; ++e) { o[e] += __shfl_xor(o[e], 16); o[e] += __shfl_xor(o[e], 32); }
        if (ks == 0) *(GAS v2u*)(yrow + head * 64 + d4) = (v2u){cvtpk(o[0], o[1]), cvtpk(o[2], o[3])};
    }
    __syncthreads();
}
DI void sample_ssm(Frame& F, const Lyr& L, int b) {
    const int tid = opaque_tid(), l = L.l, row = MP + b;
    const bf16* zrow = L.Z + (size_t)row * ZW; bf16* yrow = L.YC + (size_t)row * DM; const Args& A = *L.A;
    LAS float* fl = (LAS float*)F.lds; LAS float* s_l = fl; LAS float* y_l = fl + 4096; LAS float* part = fl + 4608;
#pragma unroll 1
    for (int k = 0; k < 4; ++k) { const int idx = tid + 512 * k, g = idx >> 6, e = l * 2048 + idx;
        const f32x2v a = ((const f32x2v*)(L.ws + WS_ABAR))[e];
        const float s0r = A.in[I_SSR][(size_t)(l * NS + b) * 2048 + idx], s0i = A.in[I_SSI][(size_t)(l * NS + b) * 2048 + idx];
        float br = 0.f, bi = 0.f; const GAS f32x4* bbp = (const GAS f32x4*)((const f32x2v*)(L.ws + WS_BBAR) + (size_t)e * 16);
        const GAS v4u* up = (const GAS v4u*)(zrow + ZC_SU + g * 16); const v4u u0 = up[0], u1 = up[1]; const unsigned ww[8] = {u0.x, u0.y, u0.z, u0.w, u1.x, u1.y, u1.z, u1.w};
#pragma unroll
        for (int c = 0; c < 8; ++c) { const f32x4 bv = bbp[c]; const float x0 = bflo(ww[c]), x1 = bfhi(ww[c]); br += bv.x * x0 + bv.z * x1; bi += bv.y * x0 + bv.w * x1; }
        const float sr = a.x * s0r - a.y * s0i + br, si = a.x * s0i + a.y * s0r + bi;
        L.out[O_SSR + (size_t)(l * NS + b) * 2048 + idx] = sr; L.out[O_SSI + (size_t)(l * NS + b) * 2048 + idx] = si;
        s_l[2 * idx] = sr; s_l[2 * idx + 1] = si; }
    __syncthreads();
    {
        const int g = tid >> 4, c = tid & 15; const GAS f32x4* cr = (const GAS f32x4*)(A.in[I_CRE] + ((size_t)(l * 32 + g) * 16 + c) * 64); const GAS f32x4* ci = (const GAS f32x4*)(A.in[I_CIM] + ((size_t)(l * 32 + g) * 16 + c) * 64);
        float acc = 0.f;
#pragma unroll
        for (int p4 = 0; p4 < 16; ++p4) { const f32x4 a = cr[p4], bq = ci[p4]; const LAS f32x4* sp = (const LAS f32x4*)(s_l + 2 * (g * 64 + 4 * p4)); const f32x4 s0 = sp[0], s1 = sp[1];
            acc += (a.x * s0.x - bq.x * s0.y) + (a.y * s0.z - bq.y * s0.w) + (a.z * s1.x - bq.z * s1.y) + (a.w * s1.z - bq.w * s1.w); }
        acc += A.in[I_SSMD][l * 512 + tid] * bf2f(zrow[ZC_SU + tid]);
        y_l[tid] = gelu_tanh(acc);
    }
    __syncthreads();
    {
        const int n4 = (tid & 127) * 4, ks = tid >> 7; const GAS f32x4* gw = (const GAS f32x4*)(A.in[I_GLUW] + (size_t)l * 262144 + (size_t)(ks * 128) * 512 + n4); f32x4 acc = {0.f, 0.f, 0.f, 0.f};
#pragma unroll 16
        for (int k = 0; k < 128; ++k) acc += gw[k * 128] * y_l[ks * 128 + k];
        *(LAS f32x4*)(part + ks * 512 + n4) = acc;
    }
    __syncthreads();
    { const float acc = A.in[I_GLUB][l * 512 + tid] + (part[tid] + part[512 + tid]) + (part[1024 + tid] + part[1536 + tid]); yrow[512 + tid] = cvt1(y_l[tid] * sigmoidf_(acc)); }
    __syncthreads();
}
DI void sample_sgate(Frame& F, const Lyr& L, int b) {
    const int tid = opaque_tid(), l = L.l, row = MP + b;
    const bf16* zrow = L.Z + (size_t)row * ZW; bf16* yrow = L.YC + (size_t)row * DM; const Args& A = *L.A;
    LAS float* red = (LAS float*)F.lds;
    const float u = bf2f(zrow[ZC_GU + tid]), v = bf2f(zrow[ZC_GV + tid]);
    const float ss = block_sum(red, v * v, tid, 8);
    const float vn = v * __builtin_amdgcn_rsqf(ss * (1.f / 512.f) + pg8::RMS_EPS) * A.in[I_SGNG][l * 512 + tid];
    L.out[O_SCV + (size_t)(l * NS + b) * 512 + tid] = vn;
    const int g = tid >> 7;
    yrow[1024 + tid] = cvt1(u * (A.in[I_SGW][(size_t)(l * 4 + g) * 16384] * vn + A.in[I_SGB][(l * 4 + g) * 128]));
    __syncthreads();
}
DI void sample_delta(Frame& F, const Lyr& L, int b, int h) {
    const int tid = opaque_tid(), l = L.l, row = MP + b;
    const bf16* zrow = L.Z + (size_t)row * ZW; const float* zab = L.ZAB + (size_t)row * 8; bf16* yrow = L.YC + (size_t)row * DM; const Args& A = *L.A;
    LAS float* fl = (LAS float*)F.lds; LAS float* red = fl; LAS float* q_l = fl + 16; LAS float* k_l = fl + 144; LAS float* v_l = fl + 272; LAS float* U_l = fl + 400; LAS float* part = fl + 528;
    float y = 0.f;
    if (tid < 384) { const int wh = tid >> 7, d = tid & 127, ch = wh * 512 + h * 128 + d; const float x = bf2f(zrow[ZC_DQ + ch]);
        const float* sc0 = A.in[I_SC] + (size_t)(l * NS + b) * 3 * 1536 + ch; const float* cw = A.in[I_CONVW] + (size_t)l * 4 * 1536 + ch;
        const float b0 = sc0[0], b1 = sc0[1536], b2 = sc0[3072];
        y = siluf_(cw[0] * b0 + cw[1536] * b1 + cw[3072] * b2 + cw[4608] * x);
        float* oc = L.out + O_SC + (size_t)(l * NS + b) * 3 * 1536 + ch; oc[0] = b1; oc[1536] = b2; oc[3072] = x; }
    const float ssq = block_sum(red, y * y, tid, 2);
    if (tid < 128) q_l[tid] = y * __builtin_amdgcn_rsqf(ssq + pg8::RMS_EPS) * 0.08838834764831845f;
    else if (tid < 256) k_l[tid - 128] = y * __builtin_amdgcn_rsqf(ssq + pg8::RMS_EPS);
    else if (tid < 384) v_l[tid - 256] = y;
    const float gg = -__expf(A.in[I_ALOG][l * 4 + h]) * softplusf_(zab[h] + A.in[I_DTB][l * 4 + h]);
    const float eg = __expf(gg), beta = sigmoidf_(zab[4 + h]);
    __syncthreads();
    const int dks = tid >> 5, dv4 = (tid & 31) * 4;
    const GAS f32x4* S0 = (const GAS f32x4*)(A.in[I_SD] + ((size_t)(l * NS + b) * 4 + h) * 16384 + (size_t)(dks * 8) * 128 + dv4);
    f32x4 s[8]; f32x4 ks = {0.f, 0.f, 0.f, 0.f};
#pragma unroll
    for (int i = 0; i < 8; ++i) s[i] = S0[i * 32];
#pragma unroll
    for (int i = 0; i < 8; ++i) ks += s[i] * k_l[dks * 8 + i];
    *(LAS f32x4*)(part + dks * 128 + dv4) = ks;
    __syncthreads();
    if (tid < 128) { float t = 0.f;
#pragma unroll
        for (int i = 0; i < 16; ++i) t += part[i * 128 + tid];
        U_l[tid] = beta * (v_l[tid] - eg * t); }
    __syncthreads();
    {
        const f32x4 U = *(const LAS f32x4*)(U_l + dv4); f32x4 o = {0.f, 0.f, 0.f, 0.f};
        GAS f32x4* S1 = (GAS f32x4*)(L.out + O_SD + ((size_t)(l * NS + b) * 4 + h) * 16384 + (size_t)(dks * 8) * 128 + dv4);
#pragma unroll
        for (int i = 0; i < 8; ++i) { const f32x4 sn = s[i] * eg + U * k_l[dks * 8 + i]; S1[i * 32] = sn; o += sn * q_l[dks * 8 + i]; }
        *(LAS f32x4*)(part + dks * 128 + dv4) = o;
    }
    __syncthreads();
    float o = 0.f;
    if (tid < 128) {
#pragma unroll
        for (int i = 0; i < 16; ++i) o += part[i * 128 + tid]; }
    const float so = block_sum(red, o * o, tid, 2);
    if (tid < 128) yrow[1536 + h * 128 + tid] = cvt1(o * __builtin_amdgcn_rsqf(so * (1.f / 128.f) + pg8::RMS_EPS) * A.in[I_DNG][l * 128 + tid] * siluf_(bf2f(zrow[ZC_DG + h * 128 + tid])));
    __syncthreads();
}
DI void sample_sub(Frame& F, const Lyr& L, int it) {
    const int part = it >> 5, b = it & 31;
    if (part < 4) sample_delta(F, L, b, part);
    else if (part == 4) sample_attn(F, L, b);
    else if (part == 5) sample_ssm(F, L, b);
    else sample_sgate(F, L, b);
}
enum { TH_IN = 0, TH_BR = 1, TH_RES = 2, TH_FF1 = 3 };
struct ThinArgs {
    const bf16* X; const bf16* Wt; int N, K;
    int first, stride;
    bf16* Z; float* ZAB; bf16* G; bf16* GS; bf16* H; bf16* XB;
    const float* R; float* Xs;
    const float* ssq_in; float* ssq_out;
};
template <int MODE>
DI void thin_gemm(Frame& F, const ThinArgs& T) {
    constexpr int NC = (MODE == TH_BR || MODE == TH_RES) ? 1 : 2;
    const int tid = opaque_tid(), lane = tid & 63, w = F.wave, r16 = lane & 15, q4 = lane >> 4;
    LAS float* red = (LAS float*)F.lds;
    LAS float* sqs = (LAS float*)(F.lds + 32768);
    LAS float* rsl = (LAS float*)(F.lds + 32768 + 4096);
    const int ncg = T.N / (16 * NC), K = T.K, kw = K / 8, nst = kw / 32;
    if (T.first >= ncg) return;
    if (MODE == TH_IN || MODE == TH_FF1) {
        const int row = tid >> 4, part = tid & 15; const f32x4 v = *(const GAS f32x4*)(T.ssq_in + row * 128 + part * 8), v2 = *(const GAS f32x4*)(T.ssq_in + row * 128 + part * 8 + 4);
        float s = ((v[0] + v[1]) + (v[2] + v[3])) + ((v2[0] + v2[1]) + (v2[2] + v2[3]));
        s += __shfl_xor(s, 1); s += __shfl_xor(s, 2); s += __shfl_xor(s, 4); s += __shfl_xor(s, 8);
        if (part == 0) rsl[row] = __builtin_amdgcn_rsqf(s * (1.0f / 2048.0f) + pg8::RMS_EPS);
        __syncthreads();
    }
    for (int cg = T.first; cg < ncg; cg += T.stride) {
        if (MODE == TH_IN && cg >= 137 && cg < 144) continue;
        const GAS bf16x8* wp0 = (const GAS bf16x8*)(T.Wt + (size_t)(cg * 16 * NC + r16) * K + w * kw + 8 * q4);
        const GAS bf16x8* wp1 = (const GAS bf16x8*)(T.Wt + (size_t)(cg * 16 * NC + (NC == 2 ? 16 : 0) + r16) * K + w * kw + 8 * q4);
        const GAS bf16x8* x0 = (const GAS bf16x8*)(T.X + (size_t)r16 * K + w * kw + 8 * q4);
        const GAS bf16x8* x1 = (const GAS bf16x8*)(T.X + (size_t)(16 + r16) * K + w * kw + 8 * q4);
        f32x4 a00 = {0.f, 0.f, 0.f, 0.f}, a01 = a00, a10 = a00, a11 = a00;
#pragma unroll 8
        for (int s = 0; s < nst; ++s) { const bf16x8 w0 = wp0[4 * s], xa = x0[4 * s], xb = x1[4 * s];
            a00 = MFMA16(w0, xa, a00); a01 = MFMA16(w0, xb, a01);
            if (NC == 2) { const bf16x8 w1 = wp1[4 * s]; a10 = MFMA16(w1, xa, a10); a11 = MFMA16(w1, xb, a11); } }
        LAS f32x4* rw = (LAS f32x4*)red + (w * 4) * 64 + lane;
        rw[0] = a00; rw[64] = a01; if (NC == 2) { rw[128] = a10; rw[192] = a11; }
        __syncthreads();
#pragma unroll
        for (int o = 0; o < NC; ++o) {
            const int e = tid + 512 * o, t = e >> 8, ln = (e >> 2) & 63, reg = e & 3, i = 16 * (t & 1) + (ln & 15), c = cg * 16 * NC + 16 * (t >> 1) + 4 * (ln >> 4) + reg;
            float v = 0.f;
            if (MODE == TH_BR) {
#pragma unroll
                for (int b = 0; b < 4; ++b) { const float g = bf2f(T.G[(size_t)i * 8192 + b * 2048 + c]);
                    v += g * (red[(((2 * b) * 4 + t) * 64 + ln) * 4 + reg] + red[(((2 * b + 1) * 4 + t) * 64 + ln) * 4 + reg]); }
            } else {
#pragma unroll
                for (int ww = 0; ww < 8; ++ww) v += red[((ww * 4 + t) * 64 + ln) * 4 + reg];
            }
            if (MODE == TH_IN) { const float z = v * rsl[i];
                if (c < 4352) T.Z[(size_t)i * ZW + c] = cvt1((c >= 1280 && c < 2304) ? gelu_tanh(z) : z);
                else if (c < 4360) T.ZAB[i * 8 + (c - 4352)] = z;
                else if (c >= 4608) T.G[(size_t)i * 8192 + (c - 4608)] = cvt1(fmaxf(sigmoidf_(z), 1e-18f)); }
            else if (MODE == TH_BR) T.GS[(size_t)i * DM + c] = cvt1(v);
            else if (MODE == TH_FF1) { const float a = fmaxf(v * rsl[i], 0.f); T.H[(size_t)i * DFF + c] = cvt1(a * a); }
            else { const float x = T.R[i * DM + c] + v; T.Xs[i * DM + c] = x; T.XB[(size_t)i * DM + c] = cvt1(x); sqs[e] = x * x; }
        }
        __syncthreads();
        if (MODE == TH_RES) { if (tid < 32) { const int rh = tid >> 4, rr = tid & 15; float s = 0.f;
#pragma unroll
                for (int ch = 0; ch < NC; ++ch)
#pragma unroll
                    for (int q = 0; q < 4; ++q)
#pragma unroll
                        for (int g = 0; g < 4; ++g) s += sqs[(2 * ch + rh) * 256 + (q * 16 + rr) * 4 + g];
                T.ssq_out[tid * 128 + cg] = s; } }
    }
    __syncthreads();
}
template <class Ord> DI void fill_rstd(LAS float* rsl, const Ord& S2, const float* P) {
    LAS int* pmv = (LAS int*)(rsl + 2048);
    const int t = opaque_tid();
    if (t < 8) { pg8::Unit u_; pmv[t] = S2.next(t, u_) ? u_.pm : -1; }
    __syncthreads();
#pragma unroll
    for (int pass = 0; pass < 2; ++pass) {
        f32x4 v[2][8]; int pm[2];
#pragma unroll
        for (int j = 0; j < 2; ++j) { const int idx = t + 512 * (2 * pass + j); pm[j] = pmv[idx >> 8];
            const GAS f32x4* p = (const GAS f32x4*)(P + (size_t)((pm[j] < 0 ? 0 : pm[j]) * 256 + (idx & 255)) * 32);
#pragma unroll
            for (int i = 0; i < 8; ++i) v[j][i] = p[i]; }
#pragma unroll
        for (int j = 0; j < 2; ++j) { const int idx = t + 512 * (2 * pass + j); float s = 0.f;
#pragma unroll
            for (int i = 0; i < 8; ++i) s += (v[j][i][0] + v[j][i][1]) + (v[j][i][2] + v[j][i][3]);
            if (pm[j] >= 0) rsl[idx] = __builtin_amdgcn_rsqf(s * (1.0f / 2048.0f) + pg8::RMS_EPS); }
    }
    __syncthreads();
}
__global__ void __launch_bounds__(NWAVES * 64, 2) hybrid_fwd(Args args) {
    extern __shared__ __attribute__((aligned(16))) unsigned char lds[];
    Frame F;
    F.lds = (LAS unsigned char*)lds;
    F.MISC = (volatile LAS unsigned*)(F.lds + MISC_OFF);
    F.tid = threadIdx.x; F.lane = F.tid & 63; F.wave = __builtin_amdgcn_readfirstlane(F.tid >> 6);
    F.G = gridDim.x; { const int bx = blockIdx.x; F.vcu = (F.G % 8 == 0) ? (bx % 8) * (F.G / 8) + bx / 8 : bx; }
    F.ws = args.ws; F.ctl = (gu32*)(args.ws + WS_CTL);
    for (int u = F.tid; u < (LDS_BYTES - LDSCTL_OFF) / 4; u += NWAVES * 64) ((LAS unsigned*)(F.lds + LDSCTL_OFF))[u] = 0u;
    __syncthreads();
    XcdBarrier bar = xcd_barrier_post((unsigned*)(F.ctl + CW_BAR), F.MISC + 8);
    unsigned char* ws = args.ws;
#define GRID_BARK(k) do { GRID_BAR(); if ((PROBE_BARMASK >> (k)) & 1) GRID_BAR(); } while (0)
#define GRID_BAR() do { for (int brep_ = 0; brep_ < REP_BAR; ++brep_) { XcdBarrier b2_ = bar; asm volatile("" : "+s"(b2_.bar), "+s"(b2_.x)); xcd_barrier(b2_); } } while (0)
    const int bid = blockIdx.x, G = F.G;

#ifndef NO_P0
    for (int rep_ = 0; rep_ < REP_P0; ++rep_) { p0_prologue(F, args); if (rep_ + 1 < REP_P0) GRID_BAR(); }
#endif
    GRID_BARK(0);

#pragma unroll 1
    for (int l = 0; l < DEPTH; ++l) {
        { GAS unsigned char* wsg_ = (GAS unsigned char*)args.ws; asm volatile("" : "+s"(wsg_)); ws = (unsigned char*)wsg_; }
        float* ssq = (float*)(ws + WS_SSQP);
        bf16* XB = (bf16*)(ws + WS_XB); bf16* Zb = (bf16*)(ws + WS_Z); bf16* Gb = (bf16*)(ws + WS_G); bf16* YC = (bf16*)(ws + WS_YCAT); bf16* GS = (bf16*)(ws + WS_GS); bf16* Hb = (bf16*)(ws + WS_H);
        float* ZAB = (float*)(ws + WS_ZAB);
        float* outp; { GAS float* og_ = (GAS float*)args.out; asm volatile("" : "+s"(og_)); outp = (float*)og_; }
        float* Xp = outp + O_YP; float* Xs = outp + O_YS;
        Lyr L; L.l = l; L.Z = Zb; L.ZAB = ZAB; L.YC = YC; L.cosT = (const float*)(ws + WS_ROPE); L.sinT = L.cosT + 4097 * 32; L.A = &args; L.out = outp; L.ws = ws;
        float* ssqs = (float*)(ws + WS_SSQS);
        ThinArgs T{}; T.Z = Zb + (size_t)MP * ZW; T.ZAB = ZAB + (size_t)MP * 8; T.G = Gb + (size_t)MP * GW; T.GS = GS + (size_t)MP * DM; T.H = Hb + (size_t)MP * DFF; T.XB = XB + (size_t)MP * DM; T.Xs = Xs; T.first = F.vcu; T.stride = G;
        {
            pg8::Gemm g{XB, (const bf16*)(ws + WS_WIN) + (size_t)l * NINP * DM, MP, NINP, DM};
            LAS float* rsl = (LAS float*)(F.lds + RING_BYTES);
#pragma unroll 1
            for (int half = 0; half < 2; ++half) {
                pg8::SplitOrder S; S.init(G, bid, half ? 768 : 0, half ? 832 : 768);
                fill_rstd(rsl, S, ssq + (size_t)(2 * l) * MPAD * 32);
                pg8::EpiIn E{Zb, ZAB, Gb, rsl, (float*)(ws + WS_SGQ)};
#ifndef NO_GIN
                for (int rep_ = 0; rep_ < REP_GIN; ++rep_)
                pg8::gemm_phase<pg8::EpiIn, pg8::SplitOrder, true, true>(F.lds + RING_OFF, g, S, E);
#endif
                if (half == 0) GRID_BARK(1);
            }
            T.X = XB + (size_t)MP * DM; T.Wt = g.Bt; T.N = NINP; T.K = DM; T.ssq_in = ssqs + (2 * l) * 4096;
            { const int late = 832 % G;
              if (G > late) { T.first = bid >= late ? bid - late : 1 << 30; T.stride = G - late; } }
            for (int rep_ = 0; rep_ < REP_THIN; ++rep_) thin_gemm<TH_IN>(F, T);
            T.first = F.vcu; T.stride = G;
        }
        {
            const int late = 832 % G, early = G - late;
            const bool fits = (late * 3 + early * 5 == 1152);
            int it0, step, cnt;
            if (fits) { if (bid >= late) { it0 = bid - late; step = early; cnt = 5; } else { it0 = 960 + bid; step = late; cnt = 3; } }
            else { it0 = bid; step = G; cnt = (1152 - bid + G - 1) / G; }
            for (int rep_ = 0; rep_ < REP_A; ++rep_)
            for (int j = 0; j < cnt; ++j) {
                const int it = it0 + j * step;
#ifndef NO_DPREP
                if (it < 512) dprep_item(F, L, it); else
#endif
#ifndef NO_SSM1
                if (it < 768) { ssm_pass1_task(F, L, (it - 512) * 8 + F.wave); __syncthreads(); } else
#endif
#ifndef NO_ATTN
                if (it < 896) attn_item(F, L, it - 768); else
#endif
#ifndef NO_SGATE
                sgate_item(F, L, it - 896);
#else
                {}
#endif
            }
        }
        GRID_BARK(2);
        for (int rep_ = 0; rep_ < REP_B; ++rep_) {
#ifndef NO_DSCAN
        if (bid < 8) { for (int r2_ = 0; r2_ < REP_SCAN; ++r2_) dscan_wg(F, L, bid);
#if PROBE_DET
            dscan_wg(F, L, bid, (WS_H - WS_OD) / 4);
#endif
#if PROBE_HS >= 0
            dscan_wg(F, L, bid, (WS_H - WS_OD) / 4, 1);
#endif
#if PROBE_ENDDLY
            for (int q_ = 0; q_ < PROBE_ENDDLY; ++q_) __builtin_amdgcn_s_sleep(127);
#endif
        }
        else
#endif
        for (int it = bid - 8; it < 480; it += G - 8) {
#ifndef NO_SAMPLE
            if (it >= 256) { for (int r2_ = 0; r2_ < REP_SAMP; ++r2_) sample_sub(F, L, it - 256); } else
#endif
#ifndef NO_SSM2
            { for (int r2_ = 0; r2_ < REP_BOTH; ++r2_) ssm_pass2_item(F, L, it); }
#else
            {}
#endif
        }
        }
        GRID_BARK(3);
        if (PROBE_BAR2) GRID_BAR();
#if PROBE_DET
        det_compare(F, L);
#endif
#ifndef NO_DPOST
        dpost_rows(F, L);
#endif
        GRID_BARK(4);
        {
            pg8::Gemm g{YC, (const bf16*)(ws + WS_WB) + (size_t)l * DM * DM, MP, DM, DM}; pg8::StaticOrder S; S.init(MP, DM, G, bid);
            pg8::EpiGate E{Gb, GS};
#ifndef NO_GBR
            for (int rep_ = 0; rep_ < REP_G3; ++rep_)
            pg8::gemm_phase<pg8::EpiGate, pg8::StaticOrder, true, true>(F.lds + RING_OFF, g, S, E);
#endif
            T.X = YC + (size_t)MP * DM; T.Wt = g.Bt; T.N = DM; T.K = DM;
            for (int rep_ = 0; rep_ < REP_THIN; ++rep_) thin_gemm<TH_BR>(F, T);
        }
        GRID_BARK(5);
        {
            pg8::Gemm g{GS, (const bf16*)(ws + WS_WO) + (size_t)l * DM * DM, MP, DM, DM}; pg8::StaticOrder S; S.init(MP, DM, G, bid);
            pg8::EpiRes E{l == 0 ? args.in[I_XP] : Xp, l == 0 ? args.in[I_XS] : Xs, Xp, Xs, XB, ssq + (size_t)(2 * l + 1) * MPAD * 32};
#ifndef NO_GRES
            if (REP_G3 > 1) { pg8::EpiRes E2 = E; E2.Xp = (float*)(ws + 1100 * MiB); E2.XB = (bf16*)(ws + 1170 * MiB); E2.ssq_out = (float*)(ws + 1210 * MiB);
                pg8::gemm_phase<pg8::EpiRes, pg8::StaticOrder, true, true>(F.lds + RING_OFF, g, S, E2); }
            pg8::gemm_phase<pg8::EpiRes, pg8::StaticOrder, true, true>(F.lds + RING_OFF, g, S, E);
#endif
            T.X = GS + (size_t)MP * DM; T.Wt = g.Bt; T.N = DM; T.K = DM; T.R = l == 0 ? args.in[I_XS] : Xs; T.ssq_out = ssqs + (2 * l + 1) * 4096;
            thin_gemm<TH_RES>(F, T);
        }
        GRID_BARK(6);
        {
            pg8::Gemm g{XB, (const bf16*)(ws + WS_W1) + (size_t)l * DFF * DM, MP, DFF, DM}; pg8::StaticOrder S; S.init(MP, DFF, G, bid);
            LAS float* rsl = (LAS float*)(F.lds + RING_BYTES);
            { pg8::StaticOrder S2; S2.init(MP, DFF, G, bid); fill_rstd(rsl, S2, ssq + (size_t)(2 * l + 1) * MPAD * 32); }
            pg8::EpiFf1 E{Hb, rsl};
#ifndef NO_GFF1
            for (int rep_ = 0; rep_ < REP_GFF1; ++rep_)
            pg8::gemm_phase<pg8::EpiFf1, pg8::StaticOrder, true, true>(F.lds + RING_OFF, g, S, E);
#endif
            T.X = XB + (size_t)MP * DM; T.Wt = g.Bt; T.N = DFF; T.K = DM; T.ssq_in = ssqs + (2 * l + 1) * 4096;
            for (int rep_ = 0; rep_ < REP_THIN; ++rep_) thin_gemm<TH_FF1>(F, T);
        }
        GRID_BARK(7);
        {
            pg8::Gemm g{Hb, (const bf16*)(ws + WS_W2) + (size_t)l * DM * DFF, MP, DM, DFF}; pg8::StaticOrder S; S.init(MP, DM, G, bid);
            pg8::EpiRes E{Xp, Xs, Xp, Xs, XB, ssq + (size_t)(2 * l + 2) * MPAD * 32};
#ifndef NO_GRES
            if (REP_G3 > 1) { pg8::EpiRes E2 = E; E2.Xp = (float*)(ws + 1100 * MiB); E2.XB = (bf16*)(ws + 1170 * MiB); E2.ssq_out = (float*)(ws + 1210 * MiB);
                pg8::gemm_phase<pg8::EpiRes, pg8::StaticOrder, true, true>(F.lds + RING_OFF, g, S, E2); }
            pg8::gemm_phase<pg8::EpiRes, pg8::StaticOrder, true, true>(F.lds + RING_OFF, g, S, E);
#endif
            T.X = Hb + (size_t)MP * DFF; T.Wt = g.Bt; T.N = DM; T.K = DFF; T.R = Xs; T.ssq_out = ssqs + (2 * l + 2) * 4096;
            thin_gemm<TH_RES>(F, T);
        }
        GRID_BARK(8);
    }
#if PROBE_DET
    if (bid == 0 && opaque_tid() == 0) {
        unsigned* C = (unsigned*)(args.ws + WS_CTL) + 1024;
        const unsigned cnt = __hip_atomic_load(C, __ATOMIC_RELAXED, __HIP_MEMORY_SCOPE_AGENT), early = __hip_atomic_load(C + 1, __ATOMIC_RELAXED, __HIP_MEMORY_SCOPE_AGENT), mask = __hip_atomic_load(C + 2, __ATOMIC_RELAXED, __HIP_MEMORY_SCOPE_AGENT);
        if (cnt) {
            const size_t offs[16] = {O_YP, O_YS, O_PK, O_PV, O_PSR, O_PSI, O_PD, O_PC, O_PCV, O_SK, O_SV, O_SSR, O_SSI, O_SD, O_SC, O_SCV};
            int idx;
            if (PROBE_DET == 1) { idx = 1; unsigned c = cnt; while (c > 1 && idx < 15) { c >>= 1; ++idx; } }
            else if (PROBE_DET == 2) idx = (int)((64u - early) >> 2);
            else idx = __builtin_popcount(mask) > 15 ? 15 : __builtin_popcount(mask);
            size_t o = O_YP; for (int i = 0; i < 16; ++i) o = (i == idx) ? offs[i] : o;
            ((float*)args.out)[o] = __builtin_nanf("");
        }
    }
#endif
}

extern "C" void kernel_launch(void* const* d_in, const int* in_sizes, int n_in, void* d_out, int out_size, void* d_ws, size_t ws_size, hipStream_t stream) {
    static int grid = 0;
    if (grid == 0) {
        if (n_in != 35 || out_size != (int)O_END || ws_size < WS_END) { fprintf(stderr, "kernel_launch: unexpected problem shape (n_in %d, out %d, ws %zu)\n", n_in, out_size, ws_size); grid = -1; return; }
        int dev = 0, cus = 0, per_cu = 0;
        if (hipGetDevice(&dev) != hipSuccess || hipDeviceGetAttribute(&cus, hipDeviceAttributeMultiprocessorCount, dev) != hipSuccess) { grid = -1; return; }
        if (hipFuncSetAttribute((const void*)hybrid_fwd, hipFuncAttributeMaxDynamicSharedMemorySize, LDS_BYTES) != hipSuccess) { grid = -1; return; }
        if (hipOccupancyMaxActiveBlocksPerMultiprocessor(&per_cu, (const void*)hybrid_fwd, NWAVES * 64, LDS_BYTES) != hipSuccess || per_cu < 1)
            fprintf(stderr, "kernel_launch: occupancy query reports %d workgroups per CU\n", per_cu);
        (void)hipGetLastError();
        grid = cus;
    }
    if (grid < 0) return;
    if (hipMemsetAsync((char*)d_ws + WS_CTL, 0, CTL_ZERO_BYTES, stream) != hipSuccess) return;
    Args a{};
    for (int i = 0; i < 35; ++i) a.in[i] = (const float*)d_in[i];
    a.out = (float*)d_out; a.ws = (unsigned char*)d_ws;
    hipLaunchKernelGGL(hybrid_fwd, dim3(grid), dim3(NWAVES * 64), LDS_BYTES, stream, a);
}
```

```cpp
#include <hip/hip_runtime.h>
#include <cstdio>
#include <cstdint>
#ifndef REP_P0
#define REP_P0 1
#endif
#ifndef REP_A
#define REP_A 1
#endif
#ifndef REP_B
#define REP_B 1
#endif
#ifndef REP_GIN
#define REP_GIN 1
#endif
#ifndef REP_GFF1
#define REP_GFF1 1
#endif
#ifndef REP_THIN
#define REP_THIN 1
#endif
#ifndef REP_BAR
#define REP_BAR 1
#endif
#ifndef REP_G3
#define REP_G3 1
#endif
#ifndef REP_DPREP
#define REP_DPREP 1
#endif
#ifndef REP_AOTH
#define REP_AOTH 1
#endif
#ifndef REP_SCAN
#define REP_SCAN 1
#endif
#ifndef REP_BOTH
#define REP_BOTH 1
#endif
#ifndef PG8_B_AUX
#define PG8_B_AUX 0
#endif
#ifndef REP_SAMP
#define REP_SAMP 1
#endif
#ifndef PROBE_MFMA2
#define PROBE_MFMA2 0
#endif
#ifndef PROBE_LDS2
#define PROBE_LDS2 0
#endif
#ifndef PROBE_LDLY
#define PROBE_LDLY 0
#endif
#ifndef PROBE_CDLY
#define PROBE_CDLY 0
#endif
#ifndef PROBE_BAR2
#define PROBE_BAR2 0
#endif
#ifndef PROBE_ODLY
#define PROBE_ODLY 0
#endif
#ifndef PROBE_GFRAG
#define PROBE_GFRAG 0
#endif
#ifndef PROBE_ENDDLY
#define PROBE_ENDDLY 0
#endif
#ifndef PROBE_VMCAP
#define PROBE_VMCAP 0
#endif
#ifndef PROBE_WT
#define PROBE_WT 0
#endif
#ifndef PROBE_DET
#define PROBE_DET 0
#endif
#ifndef PROBE_CK
#define PROBE_CK 0
#endif
#ifndef PROBE_CKMODE
#define PROBE_CKMODE 0
#endif
#ifndef PROBE_DRAIN
#define PROBE_DRAIN 0
#endif
#ifndef PROBE_BARMASK
#define PROBE_BARMASK 0
#endif
#ifndef PROBE_HS
#define PROBE_HS -1
#endif
#ifndef PROBE_V0
#define PROBE_V0 0
#endif
#ifndef PROBE_INJ_L
#define PROBE_INJ_L 0
#endif
#ifndef PROBE_INJ_K
#define PROBE_INJ_K 10
#endif
#ifndef PROBE_M0NOP
#define PROBE_M0NOP 0
#endif
#ifndef PROBE_WTE
#define PROBE_WTE 0
#endif
#ifndef PROBE_NTS
#define PROBE_NTS 0
#endif
namespace pg8 {
#define PG8_LAS __attribute__((address_space(3)))
typedef unsigned short bf16_t;
typedef short bf16x8 __attribute__((ext_vector_type(8)));
typedef float f32x4 __attribute__((ext_vector_type(4)));
typedef unsigned u32x4 __attribute__((ext_vector_type(4)));
constexpr int BM = 256, BK = 64, HALF = 128, HTB = HALF * BK * 2  , STAGE_BYTES = 8 * HTB, NXCD = 8, WGM = 8;

__host__ __device__ __forceinline__ int lds_byte(int r, int c) { const int st = (r >> 4) * 2 + (c >> 5), rr = r & 15, cc = c & 31, ob = rr * 64 + cc * 2; return st * 1024 + (ob ^ (((ob >> 9) & 1) << 5)); }
__host__ __device__ __forceinline__ void stage_rc(int b, int& R, int& C) { const int st = b / 1024, sb = b % 1024, swz = sb ^ (((sb >> 9) & 1) << 5); R = (st >> 1) * 16 + swz / 64; C = (st & 1) * 32 + (swz % 64) / 2; }
__host__ __device__ __forceinline__ int perm32(int rho) { const int n = rho >> 4, i = rho & 15; return 8 * (i >> 2) + 4 * n + (i & 3); }

struct Unit { int pm, pn, ui; };
struct Gemm { const bf16_t* A; const bf16_t* Bt; int M, N, K; };

struct StaticOrder {
    int nM, nN, nwg, G, c;
    __host__ __device__ __forceinline__ void init(int M, int N, int G_, int c_) { nM = M / BM; nN = N / BM; nwg = nM * nN; G = G_; c = c_; }
    __host__ __device__ __forceinline__ bool next(int i, Unit& u) const {
        const long L = (long)i * G + c; if (L >= nwg) return false;
        int wgid = (int)L; { const int q = nwg / NXCD, r = nwg % NXCD, xcd = wgid % NXCD, off = wgid / NXCD; wgid = (xcd < r ? xcd * (q + 1) : r * (q + 1) + (xcd - r) * q) + off; }
        const int nig = WGM * nN, gid = wgid / nig, fm = gid * WGM, gsz = (nM - fm) < WGM ? (nM - fm) : WGM;
        u.pm = fm + ((wgid % nig) % gsz); u.pn = (wgid % nig) / gsz; u.ui = i; return true;
    }
    __device__ __forceinline__ void a_ready(const Unit&) const {}
    __device__ __forceinline__ void done(const Unit&) const {}
};

struct SplitOrder {
    int G, c, L0, cnt;
    __host__ __device__ __forceinline__ void init(int G_, int c_, int L0_, int cnt_) { G = G_; c = c_; L0 = L0_; cnt = cnt_; }
    static __host__ __device__ __forceinline__ void map_grid(int L, int nM, int nN, int pn0, Unit& u) {
        const int nwg = nM * nN; int wgid = L; { const int q = nwg / NXCD, r = nwg % NXCD, xcd = wgid % NXCD, off = wgid / NXCD; wgid = (xcd < r ? xcd * (q + 1) : r * (q + 1) + (xcd - r) * q) + off; }
        const int nig = WGM * nN, gid = wgid / nig, fm = gid * WGM, gsz = (nM - fm) < WGM ? (nM - fm) : WGM;
        u.pm = fm + ((wgid % nig) % gsz); u.pn = pn0 + (wgid % nig) / gsz;
    }
    __host__ __device__ __forceinline__ bool next(int i, Unit& u) const {
        const int l = i * G + c; if (l >= cnt) return false;
        const int L = L0 + l;
        if (L < 576) map_grid(L, 32, 18, 0, u); else map_grid(L - 576, 32, 32, 18, u);
        u.ui = i; return true;
    }
    __device__ __forceinline__ void a_ready(const Unit&) const {}
    __device__ __forceinline__ void done(const Unit&) const {}
};
typedef float f32x2 __attribute__((ext_vector_type(2)));
typedef __bf16 bf16x2_t __attribute__((ext_vector_type(2)));
#if PROBE_NTS
#define PG8_ST16(p, v) __builtin_nontemporal_store((v), (p))
#else
#define PG8_ST16(p, v) (*(p) = (v))
#endif
__device__ __forceinline__ unsigned cvt_pk_bf16(float lo, float hi) { f32x2 v = {lo, hi}; bf16x2_t b = __builtin_convertvector(v, bf16x2_t); return __builtin_bit_cast(unsigned, b); }
__device__ __forceinline__ float bflo(unsigned w) { return __uint_as_float(w << 16); }
__device__ __forceinline__ float bfhi(unsigned w) { return __uint_as_float(w & 0xffff0000u); }
constexpr int MROWS = 8224;
constexpr float RMS_EPS = 1e-6f;

__device__ __forceinline__ float row_rstd(const float* P, int row) {
    const f32x4* p = (const f32x4*)(P + (size_t)row * 32); float s = 0.f;
#pragma unroll
    for (int i = 0; i < 8; ++i) { const f32x4 v = p[i]; s += (v[0] + v[1]) + (v[2] + v[3]); }
    return __builtin_amdgcn_rsqf(s * (1.0f / 2048.0f) + RMS_EPS);
}
struct EpiIn {
    static constexpr bool PERM = true, AFTER_DRAIN = false, HOOK = false;
    bf16_t* Z; float* ZAB; bf16_t* G; const PG8_LAS float* rsl;
    float* SGQ;
    static __device__ __forceinline__ float gelu_t(float x) { const float t = 1.5957691216057308f * (x + 0.044715f * x * x * x); return x * __builtin_amdgcn_rcpf(1.0f + __expf(-t)); }
    __device__ __forceinline__ void operator()(const f32x4 (&acc)[2][2][4][2], const Unit& u, int wr, int wc, int fr, int fq) const {
        const int row0 = u.pm * BM + wr * 64 + fr, colw = wc * 32 + 8 * fq;
        const bool isg = u.pn >= 5 && u.pn <= 8;
#pragma unroll
        for (int ai = 0; ai < 2; ++ai)
#pragma unroll
            for (int m = 0; m < 4; ++m) { const int row = row0 + ai * HALF + m * 16;
                const float rs = rsl[u.ui * BM + (row - u.pm * BM)];
                float sq = 0.f;
#pragma unroll
                for (int bj = 0; bj < 2; ++bj) { f32x4 v0 = acc[ai][bj][m][0] * rs, v1 = acc[ai][bj][m][1] * rs; const int col = colw + bj * HALF;
                    if (u.pn < 17) {
                        if (isg) {
#pragma unroll
                            for (int i = 0; i < 4; ++i) { v0[i] = gelu_t(v0[i]); v1[i] = gelu_t(v1[i]); }
                            sq += (v0[0] * v0[0] + v0[1] * v0[1]) + (v0[2] * v0[2] + v0[3] * v0[3]) + (v1[0] * v1[0] + v1[1] * v1[1]) + (v1[2] * v1[2] + v1[3] * v1[3]); }
                        u32x4 w; w.x = cvt_pk_bf16(v0[0], v0[1]); w.y = cvt_pk_bf16(v0[2], v0[3]); w.z = cvt_pk_bf16(v1[0], v1[1]); w.w = cvt_pk_bf16(v1[2], v1[3]);
                        PG8_ST16((u32x4*)(Z + (size_t)row * 4352 + u.pn * BM + col), w); }
                    else if (u.pn == 17) { if (col == 0) { *(f32x4*)(ZAB + (size_t)row * 8) = v0; *(f32x4*)(ZAB + (size_t)row * 8 + 4) = v1; } }
                    else { float s[8];
#pragma unroll
                        for (int i = 0; i < 4; ++i) { s[i] = fmaxf(__builtin_amdgcn_rcpf(1.0f + __expf(-v0[i])), 1e-18f); s[4 + i] = fmaxf(__builtin_amdgcn_rcpf(1.0f + __expf(-v1[i])), 1e-18f); }
                        u32x4 w; w.x = cvt_pk_bf16(s[0], s[1]); w.y = cvt_pk_bf16(s[2], s[3]); w.z = cvt_pk_bf16(s[4], s[5]); w.w = cvt_pk_bf16(s[6], s[7]);
                        PG8_ST16((u32x4*)(G + (size_t)row * 8192 + (u.pn - 18) * BM + col), w); } }
                if (u.pn == 7 || u.pn == 8) { sq += __shfl_xor(sq, 16); sq += __shfl_xor(sq, 32); if (fq == 0) SGQ[(size_t)row * 8 + (u.pn - 7) * 4 + wc] = sq; } }
    }
};
struct EpiFf1 {
    static constexpr bool PERM = true, AFTER_DRAIN = false, HOOK = false;
    bf16_t* H; const PG8_LAS float* rsl;
    __device__ __forceinline__ void operator()(const f32x4 (&acc)[2][2][4][2], const Unit& u, int wr, int wc, int fr, int fq) const {
        const int row0 = u.pm * BM + wr * 64 + fr, col0 = u.pn * BM + wc * 32 + 8 * fq;
#pragma unroll
        for (int ai = 0; ai < 2; ++ai)
#pragma unroll
            for (int m = 0; m < 4; ++m) { const int row = row0 + ai * HALF + m * 16;
                const float rs = rsl[u.ui * BM + (row - u.pm * BM)];
#pragma unroll
                for (int bj = 0; bj < 2; ++bj) { f32x4 v0 = acc[ai][bj][m][0] * rs, v1 = acc[ai][bj][m][1] * rs;
#pragma unroll
                    for (int i = 0; i < 4; ++i) { const float a = fmaxf(v0[i], 0.f), b = fmaxf(v1[i], 0.f); v0[i] = a * a; v1[i] = b * b; }
                    u32x4 w; w.x = cvt_pk_bf16(v0[0], v0[1]); w.y = cvt_pk_bf16(v0[2], v0[3]); w.z = cvt_pk_bf16(v1[0], v1[1]); w.w = cvt_pk_bf16(v1[2], v1[3]);
                    PG8_ST16((u32x4*)(H + (size_t)row * 8192 + col0 + bj * HALF), w); } }
    }
};
struct EpiRes {
    static constexpr bool PERM = true, AFTER_DRAIN = false, HOOK = false;
    const float* Rp; const float* Rs; float* Xp; float* Xs; bf16_t* XB; float* ssq_out;
    __device__ __forceinline__ void operator()(const f32x4 (&acc)[2][2][4][2], const Unit& u, int wr, int wc, int fr, int fq) const {
        const int row0 = u.pm * BM + wr * 64 + fr, col0 = u.pn * BM + wc * 32 + 8 * fq;
#pragma unroll
        for (int ai = 0; ai < 2; ++ai) {
            f32x4 res[4][2][2];
#pragma unroll
            for (int m = 0; m < 4; ++m) { const float* rp = Rp + (size_t)(row0 + ai * HALF + m * 16) * 2048 + col0;
#pragma unroll
                for (int bj = 0; bj < 2; ++bj) { res[m][bj][0] = *(const f32x4*)(rp + bj * HALF); res[m][bj][1] = *(const f32x4*)(rp + bj * HALF + 4); } }
#pragma unroll
            for (int m = 0; m < 4; ++m) { const int row = row0 + ai * HALF + m * 16; float* xp = Xp + (size_t)row * 2048 + col0; float sq = 0.f;
#pragma unroll
                for (int bj = 0; bj < 2; ++bj) {
                    const f32x4 v0 = acc[ai][bj][m][0] + res[m][bj][0], v1 = acc[ai][bj][m][1] + res[m][bj][1];
                    *(f32x4*)(xp + bj * HALF) = v0; *(f32x4*)(xp + bj * HALF + 4) = v1;
                    u32x4 w; w.x = cvt_pk_bf16(v0[0], v0[1]); w.y = cvt_pk_bf16(v0[2], v0[3]); w.z = cvt_pk_bf16(v1[0], v1[1]); w.w = cvt_pk_bf16(v1[2], v1[3]);
                    PG8_ST16((u32x4*)(XB + (size_t)row * 2048 + col0 + bj * HALF), w);
                    sq += (v0[0] * v0[0] + v0[1] * v0[1]) + (v0[2] * v0[2] + v0[3] * v0[3]) + (v1[0] * v1[0] + v1[1] * v1[1]) + (v1[2] * v1[2] + v1[3] * v1[3]); }
                sq += __shfl_xor(sq, 16); sq += __shfl_xor(sq, 32);
                if (fq == 0) ssq_out[(size_t)row * 32 + u.pn * 4 + wc] = sq; }
            asm volatile("" ::: "memory"); }
    }
};
struct EpiGate {
    static constexpr bool PERM = true, AFTER_DRAIN = false, HOOK = true;
    const bf16_t* G; bf16_t* GS;
    __device__ __forceinline__ void hook(f32x4 (&acc)[2][2][4][2], const Unit& u, int bidx, int wr, int wc, int fr, int fq) const {
        const bf16_t* gp0 = G + (size_t)(u.pm * BM + wr * 64 + fr) * 8192 + (size_t)(bidx - 1) * 2048 + u.pn * BM + wc * 32 + 8 * fq;
#pragma unroll
        for (int ai = 0; ai < 2; ++ai)
#pragma unroll
            for (int m = 0; m < 4; ++m)
#pragma unroll
                for (int bj = 0; bj < 2; ++bj) { const bf16_t* gp = gp0 + (size_t)(ai * HALF + m * 16) * 8192 + bj * HALF;
                    const u32x4 ga = *(const u32x4*)gp, gb = *(const u32x4*)(gp + 2048);
                    acc[ai][bj][m][0][0] *= bflo(ga.x) * __builtin_amdgcn_rcpf(bflo(gb.x)); acc[ai][bj][m][0][1] *= bfhi(ga.x) * __builtin_amdgcn_rcpf(bfhi(gb.x));
                    acc[ai][bj][m][0][2] *= bflo(ga.y) * __builtin_amdgcn_rcpf(bflo(gb.y)); acc[ai][bj][m][0][3] *= bfhi(ga.y) * __builtin_amdgcn_rcpf(bfhi(gb.y));
                    acc[ai][bj][m][1][0] *= bflo(ga.z) * __builtin_amdgcn_rcpf(bflo(gb.z)); acc[ai][bj][m][1][1] *= bfhi(ga.z) * __builtin_amdgcn_rcpf(bfhi(gb.z));
                    acc[ai][bj][m][1][2] *= bflo(ga.w) * __builtin_amdgcn_rcpf(bflo(gb.w)); acc[ai][bj][m][1][3] *= bfhi(ga.w) * __builtin_amdgcn_rcpf(bfhi(gb.w));
                    if (bj == 1 && m == 3) asm volatile("" ::: "memory"); }
        asm volatile("s_waitcnt vmcnt(0)" ::: "memory");
    }
    __device__ __forceinline__ void operator()(const f32x4 (&acc)[2][2][4][2], const Unit& u, int wr, int wc, int fr, int fq) const {
        const int row0 = u.pm * BM + wr * 64 + fr, col0 = u.pn * BM + wc * 32 + 8 * fq;
#pragma unroll
        for (int ai = 0; ai < 2; ++ai) { u32x4 g[4][2];
#pragma unroll
            for (int m = 0; m < 4; ++m)
#pragma unroll
                for (int bj = 0; bj < 2; ++bj) g[m][bj] = *(const u32x4*)(G + (size_t)(row0 + ai * HALF + m * 16) * 8192 + 3 * 2048 + col0 + bj * HALF);
#pragma unroll
            for (int m = 0; m < 4; ++m)
#pragma unroll
                for (int bj = 0; bj < 2; ++bj) { const f32x4 a0 = acc[ai][bj][m][0], a1 = acc[ai][bj][m][1]; const u32x4 gg = g[m][bj];
                    u32x4 w; w.x = cvt_pk_bf16(a0[0] * bflo(gg.x), a0[1] * bfhi(gg.x)); w.y = cvt_pk_bf16(a0[2] * bflo(gg.y), a0[3] * bfhi(gg.y));
                    w.z = cvt_pk_bf16(a1[0] * bflo(gg.z), a1[1] * bfhi(gg.z)); w.w = cvt_pk_bf16(a1[2] * bflo(gg.w), a1[3] * bfhi(gg.w));
                    PG8_ST16((u32x4*)(GS + (size_t)(row0 + ai * HALF + m * 16) * 2048 + col0 + bj * HALF), w); }
            asm volatile("" ::: "memory"); }
    }
};
template <class Epi, class Sched, bool ALIGN_EPI = false, bool SP2 = false>
__device__ __forceinline__ void gemm_phase(PG8_LAS unsigned char* lds, const Gemm g, const Sched& S, const Epi& E) {
    int tid_ = threadIdx.x; asm volatile("" : "+v"(tid_));
    const int tid = tid_, wid = __builtin_amdgcn_readfirstlane(tid >> 6), lane = tid & 63, wr = wid >> 2, wc = wid & 3, fr = lane & 15, fq = lane >> 4;
    const int K = g.K, nt = K / BK;
    unsigned voffA[2], voffB[2];
#pragma unroll
    for (int i = 0; i < 2; ++i) { int R, C; stage_rc(tid * 16 + i * 8192, R, C); const int Rb = Epi::PERM ? ((R & ~31) + perm32(R & 31)) : R;
        voffA[i] = (unsigned)(R * K + C) * 2u; voffB[i] = (unsigned)(Rb * K + C) * 2u; }
    const size_t kstep = (size_t)(BK * 2);
    const size_t hstep = (size_t)HALF * K * 2;
    const size_t tstep = 2 * hstep;
    const unsigned ldsw = (unsigned)wid * 1024u;
    const int aoff = lds_byte(wr * 64 + fr, fq * 8), boff = lds_byte(wc * 32 + fr, fq * 8);
#define PG8_SA(b, h) (((b) * 2 + (h)) * HTB)
#define PG8_SB(b, h) ((4 + (b) * 2 + (h)) * HTB)
#if PROBE_M0NOP
#define PG8_STAGE(bufoff, gbase, voff) do { _Pragma("unroll") for (int _i = 0; _i < 2; ++_i) { const unsigned la_ = (unsigned)(unsigned long)(lds + (bufoff) + ldsw + _i * 8192); const char* gb_ = (const char*)(gbase); \
        asm volatile("s_mov_b32 m0, %0\n\ts_nop 4\n\tglobal_load_lds_dwordx4 %1, %2" :: "s"(la_), "v"((voff)[_i]), "s"(gb_) : "memory", "m0"); } } while (0)
#define PG8_STAGEB(bufoff, gbase, voff) PG8_STAGE(bufoff, gbase, voff)
#else
#define PG8_STAGE(bufoff, gbase, voff) do { _Pragma("unroll") for (int _i = 0; _i < 2; ++_i) \
        __builtin_amdgcn_global_load_lds((const unsigned*)((const char*)(gbase) + (voff)[_i]), (PG8_LAS unsigned*)(lds + (bufoff) + ldsw + _i * 8192), 16, 0, 0); } while (0)
#define PG8_STAGEB(bufoff, gbase, voff) do { _Pragma("unroll") for (int _i = 0; _i < 2; ++_i) \
        __builtin_amdgcn_global_load_lds((const unsigned*)((const char*)(gbase) + (voff)[_i]), (PG8_LAS unsigned*)(lds + (bufoff) + ldsw + _i * 8192), 16, 0, PG8_B_AUX); } while (0)
#endif
#define PG8_LDA(dst, b, h) do { _Pragma("unroll") for (int m = 0; m < 4; ++m) _Pragma("unroll") for (int k = 0; k < 2; ++k) dst[m][k] = *(const PG8_LAS bf16x8*)(lds + PG8_SA(b, h) + aoff + m * 2048 + k * 1024); } while (0)
#define PG8_LDB(dst, b, h) do { _Pragma("unroll") for (int n = 0; n < 2; ++n) _Pragma("unroll") for (int k = 0; k < 2; ++k) dst[n][k] = *(const PG8_LAS bf16x8*)(lds + PG8_SB(b, h) + boff + n * 2048 + k * 1024); } while (0)
#define PG8_MMA(ai, bj, At, Bt) do { __builtin_amdgcn_s_setprio(1); _Pragma("unroll") for (int m = 0; m < 4; ++m) _Pragma("unroll") for (int n = 0; n < 2; ++n) _Pragma("unroll") for (int k = 0; k < 2; ++k) \
        acc[ai][bj][m][n] = __builtin_amdgcn_mfma_f32_16x16x32_bf16(Bt[n][k], At[m][k], acc[ai][bj][m][n], 0, 0, 0); __builtin_amdgcn_s_setprio(0); } while (0)
#if PROBE_V0
#define PG8_WAIT_V(n) asm volatile("s_waitcnt vmcnt(0)" ::: "memory")
#else
#define PG8_WAIT_V(n) asm volatile("s_waitcnt vmcnt(" #n ")" ::: "memory")
#endif
#define PG8_WAIT_L(n) asm volatile("s_waitcnt lgkmcnt(" #n ")" ::: "memory")
#define PG8_BAR __builtin_amdgcn_s_barrier()
#define PG8_SCHED __builtin_amdgcn_sched_barrier(0)
    Unit cur, nxt; int ui = 0;
    if (!S.next(0, cur)) return;
    f32x4 acc[2][2][4][2];
#pragma unroll
    for (int a = 0; a < 2; ++a)
#pragma unroll
        for (int b = 0; b < 2; ++b)
#pragma unroll
            for (int m = 0; m < 4; ++m)
#pragma unroll
                for (int n = 0; n < 2; ++n) acc[a][b][m][n] = (f32x4){0.f, 0.f, 0.f, 0.f};
    bf16x8 At[4][2], B0[2][2], B1[2][2];
    const char* cA = (const char*)g.A + (size_t)cur.pm * tstep; const char* cB = (const char*)g.Bt + (size_t)cur.pn * tstep;
    S.a_ready(cur);
    if constexpr (SP2) {
        PG8_STAGEB(PG8_SB(0, 0), cB, voffB); PG8_STAGEB(PG8_SB(0, 1), cB + hstep, voffB); PG8_STAGE(PG8_SA(0, 0), cA, voffA); PG8_STAGE(PG8_SA(0, 1), cA + hstep, voffA);
        if (wr == 1) PG8_BAR;
        PG8_WAIT_V(2); PG8_BAR;
        PG8_STAGEB(PG8_SB(1, 0), cB + kstep, voffB); PG8_STAGE(PG8_SA(1, 0), cA + kstep, voffA); PG8_STAGEB(PG8_SB(1, 1), cB + hstep + kstep, voffB);
        PG8_WAIT_V(6); PG8_BAR;
    } else {
        PG8_STAGEB(PG8_SB(0, 0), cB, voffB); PG8_STAGE(PG8_SA(0, 0), cA, voffA); PG8_STAGEB(PG8_SB(0, 1), cB + hstep, voffB); PG8_STAGE(PG8_SA(0, 1), cA + hstep, voffA);
        if (wr == 1) PG8_BAR;
        PG8_WAIT_V(4); PG8_BAR;
        PG8_STAGEB(PG8_SB(1, 0), cB + kstep, voffB); PG8_STAGE(PG8_SA(1, 0), cA + kstep, voffA); PG8_STAGEB(PG8_SB(1, 1), cB + hstep + kstep, voffB);
        PG8_WAIT_V(6); PG8_BAR;
    }
    for (;;) {
        const bool has_next = S.next(ui + 1, nxt);
        const char* nA = has_next ? (const char*)g.A + (size_t)nxt.pm * tstep : cA; const char* nB = has_next ? (const char*)g.Bt + (size_t)nxt.pn * tstep : cB;
        for (int t = 0; t < nt; t += 2) {
            const bool last = (t == nt - 2);
            const char* a1 = cA + (size_t)(t + 1) * kstep;
            const char* a2 = last ? nA : cA + (size_t)(t + 2) * kstep; const char* b2 = last ? nB : cB + (size_t)(t + 2) * kstep;
            const char* a3 = a2 + kstep; const char* b3 = b2 + kstep;
            if (last && has_next) S.a_ready(nxt);
            if constexpr (SP2) {
            PG8_LDB(B0, 0, 0); PG8_LDB(B1, 0, 1); PG8_SCHED; PG8_LDA(At, 0, 0); PG8_STAGE(PG8_SA(1, 1), a1 + hstep, voffA);
            PG8_WAIT_V(8); PG8_WAIT_L(0); PG8_BAR; PG8_MMA(0, 0, At, B0); PG8_MMA(0, 1, At, B1); PG8_BAR; PG8_SCHED;
            PG8_LDA(At, 0, 1); PG8_STAGEB(PG8_SB(0, 0), b2, voffB); PG8_STAGEB(PG8_SB(0, 1), b2 + hstep, voffB); PG8_STAGE(PG8_SA(0, 0), a2, voffA);
            PG8_WAIT_V(8); PG8_WAIT_L(0); PG8_BAR; PG8_MMA(1, 0, At, B0); PG8_MMA(1, 1, At, B1); PG8_BAR; PG8_SCHED;
            PG8_LDB(B0, 1, 0); PG8_LDB(B1, 1, 1); PG8_SCHED; PG8_LDA(At, 1, 0); PG8_STAGE(PG8_SA(0, 1), a2 + hstep, voffA);
            PG8_WAIT_V(8); PG8_WAIT_L(0); PG8_BAR; PG8_MMA(0, 0, At, B0); PG8_MMA(0, 1, At, B1); PG8_BAR; PG8_SCHED;
            PG8_LDA(At, 1, 1); PG8_STAGEB(PG8_SB(1, 0), b3, voffB); PG8_STAGEB(PG8_SB(1, 1), b3 + hstep, voffB); PG8_STAGE(PG8_SA(1, 0), a3, voffA);
            PG8_WAIT_V(8); PG8_WAIT_L(0); PG8_BAR; PG8_MMA(1, 0, At, B0); PG8_MMA(1, 1, At, B1); PG8_BAR; PG8_SCHED;
            } else {
            PG8_LDB(B0, 0, 0); PG8_SCHED; PG8_LDA(At, 0, 0); PG8_STAGE(PG8_SA(1, 1), a1 + hstep, voffA);
            PG8_WAIT_L(8); PG8_BAR; PG8_WAIT_L(0); PG8_MMA(0, 0, At, B0); PG8_BAR; PG8_SCHED;
            PG8_LDB(B1, 0, 1); PG8_STAGEB(PG8_SB(0, 0), b2, voffB);
            PG8_BAR; PG8_WAIT_L(0); PG8_MMA(0, 1, At, B1); PG8_BAR;
            PG8_LDA(At, 0, 1); PG8_STAGE(PG8_SA(0, 0), a2, voffA);
            PG8_BAR; PG8_WAIT_L(0); PG8_MMA(1, 0, At, B0); PG8_BAR; PG8_SCHED;
            PG8_STAGEB(PG8_SB(0, 1), b2 + hstep, voffB);
            PG8_WAIT_V(6); PG8_BAR; PG8_MMA(1, 1, At, B1); PG8_BAR;
            PG8_LDB(B0, 1, 0); PG8_SCHED; PG8_LDA(At, 1, 0); PG8_STAGE(PG8_SA(0, 1), a2 + hstep, voffA);
            PG8_WAIT_L(8); PG8_BAR; PG8_WAIT_L(0); PG8_MMA(0, 0, At, B0); PG8_BAR; PG8_SCHED;
            PG8_LDB(B1, 1, 1); PG8_STAGEB(PG8_SB(1, 0), b3, voffB);
            PG8_BAR; PG8_WAIT_L(0); PG8_MMA(0, 1, At, B1); PG8_BAR;
            PG8_LDA(At, 1, 1); PG8_STAGE(PG8_SA(1, 0), a3, voffA);
            PG8_BAR; PG8_WAIT_L(0); PG8_MMA(1, 0, At, B0); PG8_BAR; PG8_SCHED;
            PG8_STAGEB(PG8_SB(1, 1), b3 + hstep, voffB);
            PG8_WAIT_V(6); PG8_BAR; PG8_MMA(1, 1, At, B1); PG8_BAR;
            }
            if constexpr (Epi::HOOK) { if ((((t + 2) & 7) == 0) && !last) { E.hook(acc, cur, (t + 2) >> 3, wr, wc, fr, fq); PG8_SCHED; } }
        }
        if constexpr (ALIGN_EPI) { if (wr == 0) PG8_BAR; }
        if constexpr (!Epi::AFTER_DRAIN) { E(acc, cur, wr, wc, fr, fq); S.done(cur); }
        if (!has_next) break;
#pragma unroll
        for (int a = 0; a < 2; ++a)
#pragma unroll
            for (int b = 0; b < 2; ++b)
#pragma unroll
                for (int m = 0; m < 4; ++m)
#pragma unroll
                    for (int n = 0; n < 2; ++n) acc[a][b][m][n] = (f32x4){0.f, 0.f, 0.f, 0.f};
        cur = nxt; cA = nA; cB = nB; ++ui;
        if constexpr (ALIGN_EPI) { if (wr == 1) PG8_BAR; }
    }
    PG8_WAIT_V(0);
    if constexpr (!ALIGN_EPI) { if (wr == 0) PG8_BAR; }
    PG8_BAR;
    if constexpr (Epi::AFTER_DRAIN) { E.fused(acc, cur, wr, wc, fr, fq, lds, wid, lane); S.done(cur); }
#undef PG8_SA
#undef PG8_SB
#undef PG8_STAGE
#undef PG8_STAGEB
#undef PG8_LDA
#undef PG8_LDB
#undef PG8_MMA
#undef PG8_WAIT_V
#undef PG8_WAIT_L
#undef PG8_BAR
#undef PG8_SCHED
}
}
constexpr int NWAVES = 8;
constexpr int DM = 2048, SEQ = 4096, NB = 2, MP = NB * SEQ  , NS = 32  , MPAD = 8448, DEPTH = 4, DFF = 8192;
constexpr int NIN = 12552, NINP = 12800, ZW = 4352, GW = 8192, PASTLEN = 16384;
constexpr int ZC_Q = 0, ZC_K = 512, ZC_V = 640, ZC_SU = 768, ZC_GU = 1280, ZC_GV = 1792, ZC_DQ = 2304, ZC_DK = 2816, ZC_DV = 3328, ZC_DG = 3840;
constexpr float LOG2E = 1.4426950408889634f;

constexpr size_t MiB = 1u << 20;
constexpr size_t WS_CTL = 0, CTL_ZERO_BYTES = 1 * MiB;
constexpr size_t WS_ROPE = 1 * MiB;
constexpr size_t WS_ABAR = 3 * MiB;
constexpr size_t WS_A32 = WS_ABAR + 65536;
constexpr size_t WS_CFRAG = WS_ABAR + 131072;
constexpr size_t WS_BBAR = 4 * MiB;
constexpr size_t WS_WTRIL = 5 * MiB;
constexpr size_t WS_WG = 6 * MiB;
constexpr size_t WS_E = 8 * MiB;
constexpr size_t WS_ZAB = 12 * MiB;
constexpr size_t WS_GE = 13 * MiB;
constexpr size_t WS_WIN = 16 * MiB;
constexpr size_t WS_WB = 216 * MiB;
constexpr size_t WS_WO = 248 * MiB;
constexpr size_t WS_W1 = 280 * MiB;
constexpr size_t WS_W2 = 408 * MiB;
constexpr size_t WS_XB = 536 * MiB;
constexpr size_t WS_Z = 570 * MiB;
constexpr size_t WS_G = 642 * MiB;
constexpr size_t WS_YCAT = 774 * MiB;
constexpr size_t WS_GS = 808 * MiB;
constexpr size_t WS_H = 842 * MiB;
constexpr size_t WS_OD = 974 * MiB;
constexpr size_t WS_U0 = 990 * MiB;
constexpr size_t WS_WN = 1006 * MiB;
constexpr size_t WS_QG = 1014 * MiB;
constexpr size_t WS_QK = 1022 * MiB;
constexpr size_t WS_KE = 1026 * MiB;
constexpr size_t WS_SSQP = 1034 * MiB;
constexpr size_t WS_SSQS = 1046 * MiB;
constexpr size_t WS_SGQ = 1047 * MiB;
constexpr size_t WS_BFRAG = 1048 * MiB;
constexpr size_t WS_BU = 1049 * MiB;
constexpr size_t WS_END = 1113 * MiB;
constexpr int CW_TMO = 0;
constexpr int CW_QUEUE = 2048;
constexpr int CW_BAR = 4096;

constexpr size_t O_YP = 0, O_YS = 16777216, O_PK = O_YS + 65536, O_PV = O_PK + 131072, O_PSR = O_PV + 131072, O_PSI = O_PSR + 16384, O_PD = O_PSI + 16384,
                 O_PC = O_PD + 524288, O_PCV = O_PC + 36864, O_SK = O_PCV + 524288, O_SV = O_SK + 2097152, O_SSR = O_SV + 2097152, O_SSI = O_SSR + 262144,
                 O_SD = O_SSI + 262144, O_SC = O_SD + 8388608, O_SCV = O_SC + 589824, O_END = O_SCV + 65536;

constexpr int RING_OFF = 0, RING_BYTES = 131072;
constexpr int LDSCTL_OFF = 147456, MISC_OFF = LDSCTL_OFF + 320;
constexpr int LDS_BYTES = 148480;
static_assert(MISC_OFF + 128 <= LDS_BYTES, "LDS map");

#define GAS __attribute__((address_space(1)))
#define LAS __attribute__((address_space(3)))
typedef unsigned short bf16;
typedef unsigned v4u __attribute__((ext_vector_type(4)));
typedef float f32x4 __attribute__((ext_vector_type(4)));
typedef short bf16x8 __attribute__((ext_vector_type(8)));
typedef GAS unsigned gu32;
typedef GAS unsigned long long gu64;
#define RLX_AGENT __ATOMIC_RELAXED, __HIP_MEMORY_SCOPE_AGENT
#define LDS_WAIT() asm volatile("s_waitcnt lgkmcnt(0)" ::: "memory")
#define VM_WAIT() asm volatile("s_waitcnt vmcnt(0)" ::: "memory")
__device__ __forceinline__ unsigned long long rt() { return __builtin_amdgcn_s_memrealtime(); }
__device__ __forceinline__ unsigned f2bf(float f) { unsigned u = __builtin_bit_cast(unsigned, f); return (u + 0x7fffu + ((u >> 16) & 1u)) >> 16; }
__device__ __forceinline__ unsigned pk2(float lo, float hi) { return f2bf(lo) | (f2bf(hi) << 16); }

#define XB_TMO      128
#define XB_XCNT(j)  (256  + 64 * (j))
#define XB_XSUB(j)  (1280 + 64 * (j))
#define XB_XGEN(j)  (2304 + 64 * (j))
#define XB_TOP      3328
#define XB_TOPGEN   3392
#define XCD_BAR_WORDS 3456
#define XB_SPIN_CAP (1u << 18)

__device__ __forceinline__ unsigned xb_ld(unsigned* p)              { return __hip_atomic_load(p, __ATOMIC_RELAXED, __HIP_MEMORY_SCOPE_AGENT); }
__device__ __forceinline__ unsigned xb_add(unsigned* p, unsigned v) { return __hip_atomic_fetch_add(p, v, __ATOMIC_RELAXED, __HIP_MEMORY_SCOPE_AGENT); }
__device__ __forceinline__ unsigned xb_xcc_id() { return (unsigned)__builtin_amdgcn_s_getreg((3 << 11) | 20) & 0xFu; }
#define XB_SPIN(cond, bar) do { unsigned _sp = 0; while (cond) { __builtin_amdgcn_s_sleep(1); \
    if ((++_sp & 255u) == 0u) { if (xb_ld(&(bar)[XB_TMO])) break; if (_sp > XB_SPIN_CAP) { atomicAdd(&(bar)[XB_TMO], 1u); break; } } } } while (0)

struct XcdBarrier {
    unsigned* bar; unsigned x;
    volatile LAS unsigned* st;
};

__device__ __forceinline__ XcdBarrier xcd_barrier_post(unsigned* bar, volatile LAS unsigned* st) {
    XcdBarrier b; b.bar = bar; b.x = xb_xcc_id(); b.st = st;
    if (threadIdx.x == 0) (void)xb_add(&bar[XB_XCNT(b.x)], 1u);
    return b;
}
__device__ __forceinline__ void xcd_barrier_complete(unsigned* bar, unsigned x, unsigned& nloc, unsigned& nx) {
    const unsigned G = gridDim.x * gridDim.y * gridDim.z;
    unsigned sum, cnt, mine, sp = 0u;
    for (;;) {
        sum = 0u; cnt = 0u; mine = 0u;
#pragma unroll
        for (unsigned j = 0; j < 16; ++j) { const unsigned c = xb_ld(&bar[XB_XCNT(j)]); sum += c; cnt += (c > 0u) ? 1u : 0u; mine = (j == x) ? c : mine; }
        if (sum == G) break;
        __builtin_amdgcn_s_sleep(1);
        if ((++sp & 255u) == 0u) { if (xb_ld(&bar[XB_TMO])) break; if (sp > XB_SPIN_CAP) { atomicAdd(&bar[XB_TMO], 1u); break; } }
    }
    nloc = mine > 0u ? mine : 1u; nx = cnt > 0u ? cnt : 1u;
}

__device__ __forceinline__ void xcd_barrier(const XcdBarrier& b) {
    asm volatile("s_waitcnt vmcnt(0)" ::: "memory");
    __syncthreads();
    if (threadIdx.x == 0) {
        unsigned* bar = b.bar;
        __builtin_amdgcn_s_waitcnt(0);
        unsigned nloc = b.st[0], nx = b.st[1];
        if (nloc == 0u) { xcd_barrier_complete(bar, b.x, nloc, nx); b.st[0] = nloc; b.st[1] = nx; }
        const unsigned old = xb_add(&bar[XB_XSUB(b.x)], 1u);
        const unsigned gen = old / nloc;
        if (old + 1u == (gen + 1u) * nloc) {
            __builtin_amdgcn_fence(__ATOMIC_RELEASE, "agent");
            asm volatile("s_waitcnt vmcnt(0)" ::: "memory");
            const unsigned og = xb_add(&bar[XB_TOP], 1u);
            const unsigned tg = og / nx;
            if (og + 1u == (tg + 1u) * nx) xb_add(&bar[XB_TOPGEN], 1u);
            else XB_SPIN(xb_ld(&bar[XB_TOPGEN]) == tg, bar);
            __builtin_amdgcn_fence(__ATOMIC_ACQUIRE, "agent");
            xb_add(&bar[XB_XGEN(b.x)], 1u);
            asm volatile("s_waitcnt vmcnt(0)" ::: "memory");
        } else {
            XB_SPIN(xb_ld(&bar[XB_XGEN(b.x)]) == gen, bar);
            __builtin_amdgcn_fence(__ATOMIC_ACQUIRE, "agent");
            asm volatile("s_waitcnt vmcnt(0)" ::: "memory");
        }
    }
    __syncthreads();
}
typedef float f32x16 __attribute__((ext_vector_type(16)));
typedef float f32x2v __attribute__((ext_vector_type(2)));
typedef unsigned v2u __attribute__((ext_vector_type(2)));
#define DI __device__ __forceinline__
#define MFMA32(a, b, c) __builtin_amdgcn_mfma_f32_32x32x16_bf16((a), (b), (c), 0, 0, 0)
#define MFMA16(a, b, c) __builtin_amdgcn_mfma_f32_16x16x32_bf16((a), (b), (c), 0, 0, 0)
DI float bf2f(unsigned short h) { return __uint_as_float((unsigned)h << 16); }
DI float bflo(unsigned w) { return __uint_as_float(w << 16); }
DI float bfhi(unsigned w) { return __uint_as_float(w & 0xffff0000u); }
DI unsigned cvtpk(float lo, float hi) { return pg8::cvt_pk_bf16(lo, hi); }
DI unsigned short cvt1(float v) { return (unsigned short)(pg8::cvt_pk_bf16(v, 0.f) & 0xffffu); }
#define CR(k) (((k) & 3) + 8 * ((k) >> 2))
DI int crow(int reg, int h) { return (reg & 3) + 8 * (reg >> 2) + 4 * h; }
DI bf16x8 pack8(float a0, float a1, float a2, float a3, float a4, float a5, float a6, float a7) {
    v4u p; p.x = cvtpk(a0, a1); p.y = cvtpk(a2, a3); p.z = cvtpk(a4, a5); p.w = cvtpk(a6, a7); return __builtin_bit_cast(bf16x8, p); }
DI bf16x8 pack_step(const f32x16& x, int s) { return s == 0 ? pack8(x[0], x[1], x[2], x[3], x[4], x[5], x[6], x[7]) : pack8(x[8], x[9], x[10], x[11], x[12], x[13], x[14], x[15]); }
DI float wave_sum(float v) {
#pragma unroll
    for (int o = 1; o < 64; o <<= 1) v += __shfl_xor(v, o);
    return v;
}
DI float wave_max(float v) {
#pragma unroll
    for (int o = 1; o < 64; o <<= 1) v = fmaxf(v, __shfl_xor(v, o));
    return v;
}
DI float gelu_tanh(float x) {
    const float t = 1.5957691216057308f * (x + 0.044715f * x * x * x);
    return x * __builtin_amdgcn_rcpf(1.0f + __expf(-t));
}
DI float sigmoidf_(float x) { return __builtin_amdgcn_rcpf(1.0f + __expf(-x)); }
DI float siluf_(float x) { return x * __builtin_amdgcn_rcpf(1.0f + __expf(-x)); }
DI float softplusf_(float x) { const float e = __expf(-fabsf(x)); const float l = e < 1e-3f ? e * (1.f - 0.5f * e) : __logf(1.f + e); return fmaxf(x, 0.f) + l; }
DI int frag_off(int row, int k, int nks) { const int rt = row >> 5, r = row & 31, ks = k >> 4, w = k & 15, h = (w >> 2) & 1, j = ((w >> 3) << 2) | (w & 3); return (((rt * nks + ks) * 64) + r + 32 * h) * 8 + j; }

DI int opaque_tid() { int t = threadIdx.x; asm volatile("" : "+v"(t)); return t; }
struct Frame {
    LAS unsigned char* lds;
    volatile LAS unsigned* MISC;
    gu32* ctl;
    unsigned char* ws;
    const float* const* in;
    int tid, lane, wave, vcu, G;
};
struct Args { const float* in[35]; float* out; unsigned char* ws;
#if PROBE_CK
    int pass;
#endif
};
enum { I_XP = 0, I_XS, I_CK, I_CV, I_SSR, I_SSI, I_SD, I_SC, I_N1G, I_WIN, I_QNG, I_KNG, I_SINK, I_LAMR, I_LAMI, I_LOGDT, I_BRE, I_BIM, I_CRE, I_CIM, I_SSMD, I_GLUW, I_GLUB,
       I_SGNG, I_SGW, I_SGB, I_CONVW, I_ALOG, I_DTB, I_DNG, I_WBR, I_WOUT, I_N2G, I_WFF1, I_WFF2 };

template <int MODE>
DI void p0_transpose_item(const float* W, int K, int Nsrc, bf16* WT, const float* gain, LAS float* scr, int kb, int nb, int lane) {
    const int k0 = 64 * kb, n0 = 32 * nb;
    const int nd = n0 + (lane & 31);
    const int ns = MODE == 1 ? (nd < 4360 ? nd : (nd < 4608 ? -1 : nd - 248)) : nd;
    float tv[32];
#pragma unroll
    for (int i = 0; i < 32; ++i) { const int kk = 2 * i + (lane >> 5); tv[i] = ns >= 0 ? W[(size_t)(k0 + kk) * Nsrc + ns] : 0.f; }
#pragma unroll
    for (int i = 0; i < 32; ++i) { const int kk = 2 * i + (lane >> 5); float v = tv[i]; if (gain) v *= gain[k0 + kk]; scr[kk * 33 + (lane & 31)] = v; }
    LDS_WAIT(); asm volatile("" ::: "memory");
    const int c = lane & 7;
#pragma unroll
    for (int j = 0; j < 4; ++j) { const int n = (lane >> 3) + 8 * j; const LAS float* s = scr + (8 * c) * 33 + n;
        v4u o; o.x = cvtpk(s[0 * 33], s[1 * 33]); o.y = cvtpk(s[2 * 33], s[3 * 33]); o.z = cvtpk(s[4 * 33], s[5 * 33]); o.w = cvtpk(s[6 * 33], s[7 * 33]);
        *(GAS v4u*)(WT + (size_t)(n0 + n) * K + k0 + 8 * c) = o; }
    LDS_WAIT(); asm volatile("" ::: "memory");
}

DI void p0_prologue(Frame& F, const Args& A) {
    LAS float* scr = (LAS float*)(F.lds + RING_OFF + F.wave * 16384);
    const int gw = F.vcu * NWAVES + F.wave, NGW = F.G * NWAVES, lane = F.lane;
    unsigned char* ws = F.ws;
    constexpr int IT_IN = 32 * 400, IT_SQ = 32 * 64, IT_W1 = 32 * 256, IT_W2 = 128 * 64, IT_GLU = 8 * 16, IT_L = IT_IN + 2 * IT_SQ + IT_W1 + IT_W2 + IT_GLU;
    for (int it = gw; it < DEPTH * IT_L; it += NGW) {
        const int l = it / IT_L; int r = it % IT_L;
        if (r < IT_IN) { p0_transpose_item<1>(A.in[I_WIN] + (size_t)l * DM * NIN, DM, NIN, (bf16*)(ws + WS_WIN) + (size_t)l * NINP * DM, A.in[I_N1G] + l * DM, scr, r / 400, r % 400, lane); continue; } r -= IT_IN;
        if (r < IT_SQ) { p0_transpose_item<0>(A.in[I_WBR] + (size_t)l * DM * DM, DM, DM, (bf16*)(ws + WS_WB) + (size_t)l * DM * DM, nullptr, scr, r / 64, r % 64, lane); continue; } r -= IT_SQ;
        if (r < IT_SQ) { p0_transpose_item<0>(A.in[I_WOUT] + (size_t)l * DM * DM, DM, DM, (bf16*)(ws + WS_WO) + (size_t)l * DM * DM, nullptr, scr, r / 64, r % 64, lane); continue; } r -= IT_SQ;
        if (r < IT_W1) { p0_transpose_item<0>(A.in[I_WFF1] + (size_t)l * DM * DFF, DM, DFF, (bf16*)(ws + WS_W1) + (size_t)l * DFF * DM, A.in[I_N2G] + l * DM, scr, r / 256, r % 256, lane); continue; } r -= IT_W1;
        if (r < IT_W2) { p0_transpose_item<0>(A.in[I_WFF2] + (size_t)l * DFF * DM, DFF, DM, (bf16*)(ws + WS_W2) + (size_t)l * DM * DFF, nullptr, scr, r / 64, r % 64, lane); continue; } r -= IT_W2;
        p0_transpose_item<0>(A.in[I_GLUW] + (size_t)l * 512 * 512, 512, 512, (bf16*)(ws + WS_WG) + (size_t)l * 512 * 512, nullptr, scr, r / 16, r % 16, lane);
    }
    float* ssq0 = (float*)(ws + WS_SSQP);
    for (int m = gw; m < MPAD; m += NGW) {
        GAS v4u* o16 = (GAS v4u*)((bf16*)(ws + WS_XB) + (size_t)m * DM) + lane;
        if (m < pg8::MROWS) {
            const float* xrow = m < MP ? A.in[I_XP] + (size_t)m * DM : A.in[I_XS] + (size_t)(m - MP) * DM;
            const GAS f32x4* xr = (const GAS f32x4*)xrow + 2 * lane;
            float s = 0.f;
#pragma unroll
            for (int j = 0; j < 4; ++j) { const f32x4 a = xr[128 * j], b = xr[128 * j + 1];
                s += (a.x * a.x + a.y * a.y) + (a.z * a.z + a.w * a.w) + (b.x * b.x + b.y * b.y) + (b.z * b.z + b.w * b.w);
                v4u o; o.x = cvtpk(a.x, a.y); o.y = cvtpk(a.z, a.w); o.z = cvtpk(b.x, b.y); o.w = cvtpk(b.z, b.w); o16[64 * j] = o; }
            s = wave_sum(s);
            if (m < MP) { if (lane < 32) ssq0[(size_t)m * 32 + lane] = lane == 0 ? s : 0.f; }
            else { float* sq = (float*)(ws + WS_SSQS) + (m - MP) * 128; sq[lane] = lane == 0 ? s : 0.f; sq[64 + lane] = 0.f; }
        } else {
#pragma unroll
            for (int j = 0; j < 4; ++j) o16[64 * j] = (v4u){0u, 0u, 0u, 0u};
            if (lane < 32) ssq0[(size_t)m * 32 + lane] = 0.f;
        }
    }
    const int gt = gw * 64 + lane, NGT = NGW * 64;
    {
        float* ct = (float*)(ws + WS_ROPE); float* st = ct + 4097 * 32;
        for (int e = gt; e < 4097 * 32; e += NGT) { const int p = e >> 5, i = e & 31; const double pos = p < 4096 ? (double)p : (double)PASTLEN;
            const float invf = powf(10000.0f, -(float)i / 32.0f); const float angf = (float)pos * invf;
            const double ang = (double)angf; const double n = rint(ang * 0.15915494309189535); const double r = ang - n * 6.283185307179586;
            ct[e] = cosf((float)r); st[e] = sinf((float)r); }
    }
    {
        f32x2v* abar = (f32x2v*)(ws + WS_ABAR); f32x2v* a32 = (f32x2v*)(ws + WS_A32); f32x2v* bbar = (f32x2v*)(ws + WS_BBAR);
        for (int e = gt; e < DEPTH * 32 * 64; e += NGT) { const int lg = e >> 6;
            const float lr = A.in[I_LAMR][e], li = A.in[I_LAMI][e], dt = expf(A.in[I_LOGDT][lg]);
            const float mag = expf(lr * dt), ar = mag * cosf(li * dt), ai = mag * sinf(li * dt);
            abar[e] = (f32x2v){ar, ai};
            const float m32 = expf(lr * dt * 32.f); a32[e] = (f32x2v){m32 * cosf(li * dt * 32.f), m32 * sinf(li * dt * 32.f)};
            const float nr = ar - 1.f, ni = ai, den = 1.f / (lr * lr + li * li); const float qr = (nr * lr + ni * li) * den, qi = (ni * lr - nr * li) * den;
            for (int c = 0; c < 16; ++c) { const float br = A.in[I_BRE][(size_t)e * 16 + c], bi = A.in[I_BIM][(size_t)e * 16 + c]; bbar[(size_t)e * 16 + c] = (f32x2v){qr * br - qi * bi, qr * bi + qi * br}; }
        }
        bf16* bfr = (bf16*)(ws + WS_BFRAG);
        for (int e = gt; e < DEPTH * 32 * 4 * 64 * 8; e += NGT) { const int j = e & 7, ln = (e >> 3) & 63, tile = (e >> 9) & 3, lg = e >> 11;
            const int pst = 32 * (tile >> 1) + (ln & 31), c = 8 * (ln >> 5) + j; const size_t src = ((size_t)lg * 64 + pst) * 16 + c;
            const float lr = A.in[I_LAMR][lg * 64 + pst], li = A.in[I_LAMI][lg * 64 + pst], dt = expf(A.in[I_LOGDT][lg]);
            const float mag = expf(lr * dt), ar = mag * cosf(li * dt), ai = mag * sinf(li * dt);
            const float nr = ar - 1.f, ni = ai, den = 1.f / (lr * lr + li * li); const float qr = (nr * lr + ni * li) * den, qi = (ni * lr - nr * li) * den;
            const float br = A.in[I_BRE][src], bi = A.in[I_BIM][src];
            bfr[e] = cvt1((tile & 1) ? qr * bi + qi * br : qr * br - qi * bi); }
        bf16* cf = (bf16*)(ws + WS_CFRAG);
        for (int e = gt; e < DEPTH * 32 * 4 * 64 * 8; e += NGT) { const int j = e & 7, ln = (e >> 3) & 63, kb = (e >> 9) & 3, lg = e >> 11;
            const int k = 32 * kb + 8 * (ln >> 4) + j, c = ln & 15, p = k >> 1;
            const float v = (k & 1) ? -A.in[I_CIM][((size_t)lg * 16 + c) * 64 + p] : A.in[I_CRE][((size_t)lg * 16 + c) * 64 + p];
            cf[e] = cvt1(v); }
    }
    {
        bf16* wt = (bf16*)(ws + WS_WTRIL);
        for (int e = gt; e < DEPTH * 4 * 128 * 128; e += NGT) { const int s = e & 127, t = (e >> 7) & 127; wt[e] = s <= t ? cvt1(A.in[I_SGW][e]) : (bf16)0; }
    }
}

#if PROBE_CK
DI void p0_xonly(Frame& F, const Args& A) {
    const int gw = F.vcu * NWAVES + F.wave, NGW = F.G * NWAVES, lane = opaque_tid() & 63;
    unsigned char* ws = F.ws;
    float* ssq0 = (float*)(ws + WS_SSQP);
    for (int m = gw; m < MPAD; m += NGW) {
        GAS v4u* o16 = (GAS v4u*)((bf16*)(ws + WS_XB) + (size_t)m * DM) + lane;
        if (m < pg8::MROWS) {
            const float* xrow = m < MP ? A.in[I_XP] + (size_t)m * DM : A.in[I_XS] + (size_t)(m - MP) * DM;
            const GAS f32x4* xr = (const GAS f32x4*)xrow + 2 * lane;
            float s = 0.f;
#pragma unroll
            for (int j = 0; j < 4; ++j) { const f32x4 a = xr[128 * j], b = xr[128 * j + 1];
                s += (a.x * a.x + a.y * a.y) + (a.z * a.z + a.w * a.w) + (b.x * b.x + b.y * b.y) + (b.z * b.z + b.w * b.w);
                v4u o; o.x = cvtpk(a.x, a.y); o.y = cvtpk(a.z, a.w); o.z = cvtpk(b.x, b.y); o.w = cvtpk(b.z, b.w); o16[64 * j] = o; }
            s = wave_sum(s);
            if (m < MP) { if (lane < 32) ssq0[(size_t)m * 32 + lane] = lane == 0 ? s : 0.f; }
            else { float* sq = (float*)(ws + WS_SSQS) + (m - MP) * 128; sq[lane] = lane == 0 ? s : 0.f; sq[64 + lane] = 0.f; }
        } else {
#pragma unroll
            for (int j = 0; j < 4; ++j) o16[64 * j] = (v4u){0u, 0u, 0u, 0u};
            if (lane < 32) ssq0[(size_t)m * 32 + lane] = 0.f;
        }
    }
}
#endif
struct Lyr {
    int l;
    const bf16* Z; const float* ZAB; bf16* YC;
    const float* cosT; const float* sinT;
    const Args* A; float* out; unsigned char* ws;
};

DI void attn_item(Frame& F, const Lyr& L, int item) {
    const int b = item >> 6, kvh = (item >> 5) & 1, blk = item & 31, tid = opaque_tid(), l = L.l;
    LAS bf16* Ks = (LAS bf16*)(F.lds); LAS bf16* VT = (LAS bf16*)(F.lds + 36864);
    {
        const int kap = tid & 255, tk = blk * 128 - 128 + kap;
        if (tid < 256) {
            if (tk >= 0) {
                const GAS v4u* src = (const GAS v4u*)(L.Z + (size_t)(b * SEQ + tk) * ZW + ZC_K + kvh * 64);
                float x[64]; float ss = 0.f;
#pragma unroll
                for (int i = 0; i < 8; ++i) { const v4u w = src[i]; x[8 * i] = bflo(w.x); x[8 * i + 1] = bfhi(w.x); x[8 * i + 2] = bflo(w.y); x[8 * i + 3] = bfhi(w.y); x[8 * i + 4] = bflo(w.z); x[8 * i + 5] = bfhi(w.z); x[8 * i + 6] = bflo(w.w); x[8 * i + 7] = bfhi(w.w); }
#pragma unroll
                for (int i = 0; i < 64; ++i) ss += x[i] * x[i];
                const float rs = __builtin_amdgcn_rsqf(ss * (1.f / 64.f) + pg8::RMS_EPS);
                const float* kg = L.A->in[I_KNG] + l * 64;
                const bool wr = blk == 31 && kap >= 128;
                GAS float* pk = (GAS float*)(L.out + O_PK + ((size_t)((l * NB + b) * 128 + (kap - 128)) * 2 + kvh) * 64);
                const GAS f32x4* ct = (const GAS f32x4*)(L.cosT + tk * 32); const GAS f32x4* st4 = (const GAS f32x4*)(L.sinT + tk * 32);
#pragma unroll
                for (int i4 = 0; i4 < 8; ++i4) { const f32x4 c = ct[i4], s = st4[i4]; float lo[4], hi[4];
#pragma unroll
                    for (int q = 0; q < 4; ++q) { const int i = 4 * i4 + q; const float x1 = x[i] * rs * kg[i], x2 = x[i + 32] * rs * kg[i + 32]; lo[q] = x1 * c[q] - x2 * s[q]; hi[q] = x2 * c[q] + x1 * s[q]; }
                    *(LAS v2u*)(Ks + kap * 72 + 4 * i4) = (v2u){cvtpk(lo[0], lo[1]), cvtpk(lo[2], lo[3])}; *(LAS v2u*)(Ks + kap * 72 + 32 + 4 * i4) = (v2u){cvtpk(hi[0], hi[1]), cvtpk(hi[2], hi[3])};
                    if (wr) { *(GAS f32x4*)(pk + 4 * i4) = (f32x4){lo[0], lo[1], lo[2], lo[3]}; *(GAS f32x4*)(pk + 32 + 4 * i4) = (f32x4){hi[0], hi[1], hi[2], hi[3]}; }
                    }
            } else {
#pragma unroll
                for (int i = 0; i < 8; ++i) *(LAS v4u*)(Ks + kap * 72 + 8 * i) = (v4u){0u, 0u, 0u, 0u};
            }
        } else {
            if (tk >= 0) {
                const GAS v4u* src = (const GAS v4u*)(L.Z + (size_t)(b * SEQ + tk) * ZW + ZC_V + kvh * 64);
#pragma unroll
                for (int i = 0; i < 8; ++i) { const v4u w = src[i]; const unsigned ww[4] = {w.x, w.y, w.z, w.w};
#pragma unroll
                    for (int q = 0; q < 4; ++q) { VT[(8 * i + 2 * q) * 264 + kap] = (bf16)(ww[q] & 0xffffu); VT[(8 * i + 2 * q + 1) * 264 + kap] = (bf16)(ww[q] >> 16); }
                    if (blk == 31 && kap >= 128) { GAS f32x4* pv = (GAS f32x4*)(L.out + O_PV + ((size_t)((l * NB + b) * 128 + (kap - 128)) * 2 + kvh) * 64) + 2 * i;
                        pv[0] = (f32x4){bflo(w.x), bfhi(w.x), bflo(w.y), bfhi(w.y)}; pv[1] = (f32x4){bflo(w.z), bfhi(w.z), bflo(w.w), bfhi(w.w)}; } }
            } else {
#pragma unroll
                for (int d = 0; d < 64; ++d) VT[d * 264 + kap] = (bf16)0;
            }
        }
    }
    __syncthreads();
    const int w = F.wave, lane = opaque_tid() & 63, r = lane & 31, h = lane >> 5, g = w >> 1, head = kvh * 4 + g;
    const float sinkl = L.A->in[I_SINK][l * 8 + head] * LOG2E;
    const float* qg = L.A->in[I_QNG] + l * 64;
#pragma unroll 1
    for (int sub = 0; sub < 2; ++sub) {
        const int q0 = (w & 1) * 64 + sub * 32, tq = blk * 128 + q0 + r;
        bf16x8 qf[4];
        {
            const GAS v4u* src = (const GAS v4u*)(L.Z + (size_t)(b * SEQ + tq) * ZW + ZC_Q + head * 64 + 8 * h);
            float x[4][8]; float ss = 0.f;
#pragma unroll
            for (int ks = 0; ks < 4; ++ks) { const v4u wv = src[2 * ks]; x[ks][0] = bflo(wv.x); x[ks][1] = bfhi(wv.x); x[ks][2] = bflo(wv.y); x[ks][3] = bfhi(wv.y); x[ks][4] = bflo(wv.z); x[ks][5] = bfhi(wv.z); x[ks][6] = bflo(wv.w); x[ks][7] = bfhi(wv.w);
#pragma unroll
                for (int j = 0; j < 8; ++j) ss += x[ks][j] * x[ks][j]; }
            ss += __shfl_xor(ss, 32);
            const float rs = __builtin_amdgcn_rsqf(ss * (1.f / 64.f) + pg8::RMS_EPS) ;
            const float sc = 0.125f * LOG2E;
            float o[4][8];
#pragma unroll
            for (int kp = 0; kp < 2; ++kp)
#pragma unroll
                for (int j = 0; j < 8; ++j) { const int i = 16 * kp + 8 * h + j; const float c = L.cosT[tq * 32 + i], s = L.sinT[tq * 32 + i];
                    const float x1 = x[kp][j] * rs * qg[i], x2 = x[kp + 2][j] * rs * qg[i + 32];
                    o[kp][j] = (x1 * c - x2 * s) * sc; o[kp + 2][j] = (x2 * c + x1 * s) * sc; }
#pragma unroll
            for (int ks = 0; ks < 4; ++ks) qf[ks] = pack8(o[ks][0], o[ks][1], o[ks][2], o[ks][3], o[ks][4], o[ks][5], o[ks][6], o[ks][7]);
        }
        f32x16 st[5];
#pragma unroll
        for (int kt = 0; kt < 5; ++kt) {
#pragma unroll
            for (int i = 0; i < 16; ++i) st[kt][i] = 0.f;
#pragma unroll
            for (int ks = 0; ks < 4; ++ks) { const bf16x8 a = *(const LAS bf16x8*)(Ks + (q0 + 32 * kt + r) * 72 + 16 * ks + 8 * h); st[kt] = MFMA32(a, qf[ks], st[kt]); }
        }
        float mx = sinkl; const int rlo = r + 1 - 4 * h, kmin = 128 - q0 - 4 * h;
#pragma unroll
        for (int kt = 0; kt < 5; ++kt)
#pragma unroll
            for (int i = 0; i < 16; ++i) { const int kk = 32 * kt + CR(i);
                const bool ok = (kk >= rlo) && (kk <= rlo + 127) && (blk > 0 || kk >= kmin);
                st[kt][i] = ok ? st[kt][i] : -INFINITY; mx = fmaxf(mx, st[kt][i]); }
        mx = fmaxf(mx, __shfl_xor(mx, 32));
        float sum = 0.f;
#pragma unroll
        for (int kt = 0; kt < 5; ++kt)
#pragma unroll
            for (int i = 0; i < 16; ++i) { const float p = __builtin_amdgcn_exp2f(st[kt][i] - mx); st[kt][i] = p; sum += p; }
        sum += __shfl_xor(sum, 32);
        const float inv = __builtin_amdgcn_rcpf(sum + __builtin_amdgcn_exp2f(sinkl - mx));
#pragma unroll
        for (int kt = 0; kt < 5; ++kt) st[kt] = st[kt] * inv;
        f32x16 o2[2];
#pragma unroll
        for (int dt = 0; dt < 2; ++dt) {
#pragma unroll
            for (int i = 0; i < 16; ++i) o2[dt][i] = 0.f; }
#pragma unroll
        for (int kt = 0; kt < 5; ++kt)
#pragma unroll
            for (int s = 0; s < 2; ++s) { const bf16x8 pa = pack_step(st[kt], s);
#pragma unroll
                for (int dt = 0; dt < 2; ++dt) { const LAS bf16* vp = VT + (dt * 32 + r) * 264 + q0 + 32 * kt + 16 * s + 4 * h;
                    const v2u lo = *(const LAS v2u*)vp, hi = *(const LAS v2u*)(vp + 8); const v4u bb = {lo.x, lo.y, hi.x, hi.y};
                    o2[dt] = MFMA32(pa, __builtin_bit_cast(bf16x8, bb), o2[dt]); } }
        GAS bf16* yo = (GAS bf16*)L.YC + (size_t)(b * SEQ + blk * 128 + q0 + 4 * h) * DM + head * 64 + r;
#pragma unroll
        for (int i = 0; i < 16; ++i) {
#pragma unroll
            for (int dt = 0; dt < 2; ++dt) yo[CR(i) * DM + dt * 32] = cvt1(o2[dt][i]); }
    }
    __syncthreads();
}
DI void sgate_item(Frame& F, const Lyr& L, int item) {
    const int b = item >> 7, n = (item >> 2) & 31, g = item & 3, tid = opaque_tid(), l = L.l;
    LAS bf16* VT = (LAS bf16*)(F.lds);
    const int t = tid >> 2, qd = tid & 3, m0 = b * SEQ + n * 128;
    {
        const GAS f32x4* sp = (const GAS f32x4*)((const float*)(L.ws + WS_SGQ) + (size_t)(m0 + t) * 8); const f32x4 s0 = sp[0], s1 = sp[1];
        const float ss = ((s0[0] + s0[1]) + (s0[2] + s0[3])) + ((s1[0] + s1[1]) + (s1[2] + s1[3]));
        const float rs = __builtin_amdgcn_rsqf(ss * (1.f / 512.f) + pg8::RMS_EPS);
        const GAS v4u* sg = (const GAS v4u*)(L.Z + (size_t)(m0 + t) * ZW + ZC_GV + g * 128 + qd * 32);
        const float* gn = L.A->in[I_SGNG] + l * 512 + g * 128 + qd * 32;
#pragma unroll
        for (int i = 0; i < 4; ++i) { const v4u w = sg[i]; const unsigned ww[4] = {w.x, w.y, w.z, w.w};
#pragma unroll
            for (int q = 0; q < 4; ++q) { const int hc = qd * 32 + 8 * i + 2 * q; const float a = bflo(ww[q]) * rs * gn[8 * i + 2 * q], c = bfhi(ww[q]) * rs * gn[8 * i + 2 * q + 1];
                VT[hc * 136 + t] = cvt1(a); VT[(hc + 1) * 136 + t] = cvt1(c);
                if (n == 31) { float* pc = L.out + O_PCV + ((size_t)(l * NB + b) * 128 + t) * 512 + g * 128 + hc; pc[0] = a; pc[1] = c; } } }
    }
    __syncthreads();
    const int w = F.wave, lane = opaque_tid() & 63, r = lane & 31, h = lane >> 5, tt = w >> 1;
    const bf16* Wt = (const bf16*)(L.ws + WS_WTRIL) + (size_t)(l * 4 + g) * 16384;
    f32x16 acc[2];
#pragma unroll
    for (int i = 0; i < 2; ++i)
#pragma unroll
        for (int k = 0; k < 16; ++k) acc[i][k] = 0.f;
    bf16x8 af[8];
#pragma unroll
    for (int ks = 0; ks < 8; ++ks) af[ks] = *(const GAS bf16x8*)(Wt + (tt * 32 + r) * 128 + 16 * ks + 8 * h);
#pragma unroll
    for (int ks = 0; ks < 8; ++ks) if (ks < 2 * (tt + 1)) {
#pragma unroll
        for (int i = 0; i < 2; ++i) { const int ht = 2 * (w & 1) + i; const bf16x8 bq = *(const LAS bf16x8*)(VT + (ht * 32 + r) * 136 + 16 * ks + 8 * h); acc[i] = MFMA32(af[ks], bq, acc[i]); }
    }
    const float* bias = L.A->in[I_SGB] + (l * 4 + g) * 128;
#pragma unroll
    for (int i = 0; i < 2; ++i) { const int hc = (2 * (w & 1) + i) * 32 + r;
        const GAS bf16* zu = (const GAS bf16*)L.Z + (size_t)(m0 + tt * 32 + 4 * h) * ZW + ZC_GU + g * 128 + hc; GAS bf16* yo = (GAS bf16*)L.YC + (size_t)(m0 + tt * 32 + 4 * h) * DM + 1024 + g * 128 + hc;
        const float* bs = bias + tt * 32 + 4 * h;
#pragma unroll
        for (int k = 0; k < 16; ++k) { const float u = bf2f(zu[CR(k) * ZW]); yo[CR(k) * DM] = cvt1(u * (acc[i][k] + bs[CR(k)])); } }
    __syncthreads();
}

DI void ssm_pass1_task(Frame& F, const Lyr& L, int task) {
    const int b = task >> 10, sb = (task >> 5) & 31, g = task & 31, lane = opaque_tid() & 63, p = lane, r = lane & 31, hh = lane >> 5, l = L.l, w = F.wave;
    LAS unsigned* Sw = (LAS unsigned*)(F.lds + w * 8704);
    const int e = (l * 32 + g) * 64 + p;
    const f32x2v a = ((const f32x2v*)(L.ws + WS_ABAR))[e];
    const GAS bf16x8* bfp = (const GAS bf16x8*)((const bf16*)(L.ws + WS_BFRAG) + (size_t)(l * 32 + g) * 2048) + lane;
    bf16x8 Bf[4];
#pragma unroll
    for (int t = 0; t < 4; ++t) Bf[t] = bfp[t * 64];
    const GAS bf16x8* up = (const GAS bf16x8*)(L.Z + (size_t)(b * SEQ + sb * 128 + r) * ZW + ZC_SU + g * 16 + 8 * hh);
    bf16x8 ub[4];
#pragma unroll
    for (int j = 0; j < 4; ++j) ub[j] = up[(size_t)j * 32 * ZW / 8];
    float sr = 0.f, si = 0.f;
    f32x16 zero;
#pragma unroll
    for (int k = 0; k < 16; ++k) zero[k] = 0.f;
#pragma unroll 1
    for (int j = 0; j < 4; ++j) {
        const bf16x8 uj = j == 0 ? ub[0] : j == 1 ? ub[1] : j == 2 ? ub[2] : ub[3];
#pragma unroll
        for (int q = 0; q < 2; ++q) { const f32x16 re = MFMA32(uj, Bf[2 * q], zero), im = MFMA32(uj, Bf[2 * q + 1], zero);
#pragma unroll
            for (int k = 0; k < 16; ++k) Sw[(CR(k) + 4 * hh) * 68 + 32 * q + r] = cvtpk(re[k], im[k]); }
        LDS_WAIT(); asm volatile("" ::: "memory");
        unsigned wv[32];
#pragma unroll
        for (int t = 0; t < 32; ++t) wv[t] = Sw[t * 68 + p];
        {
            GAS unsigned* bu = (GAS unsigned*)(L.ws + WS_BU) + ((size_t)(b * 32 + g) * 128 + sb * 4 + j) * 2048 + p;
#pragma unroll
            for (int t = 0; t < 32; ++t) bu[t * 64] = wv[t]; }
#pragma unroll
        for (int t = 0; t < 32; ++t) { const float nr = a.x * sr - a.y * si + bflo(wv[t]), ni = a.x * si + a.y * sr + bfhi(wv[t]); sr = nr; si = ni; }
        ((f32x2v*)(L.ws + WS_E))[((size_t)(b * 32 + g) * 128 + sb * 4 + j) * 64 + p] = (f32x2v){sr, si};
        LDS_WAIT(); asm volatile("" ::: "memory");
    }
}
constexpr int DP_KF = 0, DP_VF = 32768, DP_QB = 65536, DP_KB = 82944, DP_AM = 100352, DP_GC = 116736, DP_BETA = DP_GC + 256, DP_EG = DP_GC + 512, DP_KEX = DP_GC + 768;
DI void dprep_item(Frame& F, const Lyr& L, int item) {
    const int b = item >> 8, h = (item >> 6) & 3, n = item & 63, l = L.l; int tid = opaque_tid();
    LAS float* Kf = (LAS float*)(F.lds + DP_KF); LAS float* Vf = (LAS float*)(F.lds + DP_VF);
    LAS bf16* Qb = (LAS bf16*)(F.lds + DP_QB); LAS bf16* Kb = (LAS bf16*)(F.lds + DP_KB);
    LAS float* Am = (LAS float*)(F.lds + DP_AM);
    LAS float* gcs = (LAS float*)(F.lds + DP_GC); LAS float* betas = (LAS float*)(F.lds + DP_BETA); LAS float* egs = (LAS float*)(F.lds + DP_EG); LAS float* kex = (LAS float*)(F.lds + DP_KEX);
    const int m0 = b * SEQ + n * 64;
    {
        const int t = tid >> 3, sub = tid & 7, tg = n * 64 + t;
#pragma unroll 1
        for (int wh = 0; wh < 3; ++wh) {
            const int ch0 = wh * 512 + h * 128 + sub * 16;
            const float* cw = L.A->in[I_CONVW] + (size_t)l * 4 * 1536 + ch0;
            float y[16];
#pragma unroll
            for (int c = 0; c < 16; ++c) y[c] = 0.f;
#pragma unroll
            for (int i = 0; i < 4; ++i) {
                if (tg - 3 + i >= 0) {
                    const GAS v4u* src = (const GAS v4u*)(L.Z + (size_t)(m0 + t - 3 + i) * ZW + ZC_DQ + ch0); const v4u a0 = src[0], a1 = src[1];
                    const unsigned ww[8] = {a0.x, a0.y, a0.z, a0.w, a1.x, a1.y, a1.z, a1.w};
#pragma unroll
                    for (int q = 0; q < 8; ++q) { y[2 * q] += cw[i * 1536 + 2 * q] * bflo(ww[q]); y[2 * q + 1] += cw[i * 1536 + 2 * q + 1] * bfhi(ww[q]); }
                    if (i == 3 && n == 63 && t >= 61) { float* pc = L.out + O_PC + ((size_t)(l * NB + b) * 3 + (t - 61)) * 1536 + ch0;
#pragma unroll
                        for (int q = 0; q < 8; ++q) { pc[2 * q] = bflo(ww[q]); pc[2 * q + 1] = bfhi(ww[q]); } }
                }
            }
            float ss = 0.f;
#pragma unroll
            for (int c = 0; c < 16; ++c) { y[c] = siluf_(y[c]); ss += y[c] * y[c]; }
            ss += __shfl_xor(ss, 1); ss += __shfl_xor(ss, 2); ss += __shfl_xor(ss, 4);
            const float rn = wh == 0 ? __builtin_amdgcn_rsqf(ss + pg8::RMS_EPS) * 0.08838834764831845f : (wh == 1 ? __builtin_amdgcn_rsqf(ss + pg8::RMS_EPS) : 1.0f);
            LAS bf16* bdst = (wh == 0 ? Qb : Kb) + t * 136 + sub * 16; LAS float* fdst = (wh == 1 ? Kf : Vf) + t * 128 + sub * 16;
#pragma unroll
            for (int c = 0; c < 16; c += 2) { const float v0 = y[c] * rn, v1 = y[c + 1] * rn;
                if (wh < 2) *(LAS unsigned*)(bdst + c) = cvtpk(v0, v1);
                if (wh > 0) { fdst[c] = v0; fdst[c + 1] = v1; } }
        }
    }
    tid = opaque_tid();
    if (tid < 64) {
        const int t = tid; const float* zab = L.ZAB + (size_t)(m0 + t) * 8;
        const float gg = -__expf(L.A->in[I_ALOG][l * 4 + h]) * softplusf_(zab[h] + L.A->in[I_DTB][l * 4 + h]);
        float c = gg;
#pragma unroll
        for (int o = 1; o < 64; o <<= 1) { const float v = __shfl_up(c, o); if (t >= o) c += v; }
        const float clast = __shfl(c, 63);
        gcs[t] = c; betas[t] = sigmoidf_(zab[4 + h]); egs[t] = __expf(c); kex[t] = __expf(clast - c);
        if (t == 63) ((float*)(L.ws + WS_GE))[item] = __expf(c);
    }
    __syncthreads();
    {
        const int w = F.wave, lane = opaque_tid() & 63, r = lane & 31, hh = lane >> 5, which = w >> 2, tt = (w >> 1) & 1, st = w & 1;
        f32x16 acc;
#pragma unroll
        for (int k = 0; k < 16; ++k) acc[k] = 0.f;
        const LAS bf16* Ap = (which ? Qb : Kb) + (tt * 32 + r) * 136 + 8 * hh; const LAS bf16* Bp = Kb + (st * 32 + r) * 136 + 8 * hh;
#pragma unroll
        for (int ks = 0; ks < 8; ++ks) acc = MFMA32(*(const LAS bf16x8*)(Ap + 16 * ks), *(const LAS bf16x8*)(Bp + 16 * ks), acc);
        bf16* QKo = (bf16*)(L.ws + WS_QK) + (size_t)item * 4096;
        const int s = st * 32 + r; const float gs = gcs[s];
        const int tb = tt * 32 + 4 * hh; const LAS float* gct = gcs + tb; const LAS float* bet = betas + tb; LAS float* Amp = Am + tb * 64 + s; bf16* qko = QKo + frag_off(tb, s, 4);
#pragma unroll
        for (int k = 0; k < 16; ++k) { const int t = tb + CR(k); const float dec = __expf(gct[CR(k)] - gs);
            if (which == 0) Amp[CR(k) * 64] = t > s ? bet[CR(k)] * acc[k] * dec : 0.f;
            else qko[CR(k) * 8] = cvt1(t >= s ? acc[k] * dec : 0.f); }
    }
    __syncthreads();
    tid = opaque_tid();
    {
        const int u = tid & 255;
        if (tid < 256) { const int t = u >> 2, d0 = (u & 3) * 32; bf16* QG = (bf16*)(L.ws + WS_QG) + (size_t)item * 8192; const float e = egs[t];
#pragma unroll 2
          for (int d = 0; d < 32; d += 4) { const int dk = d0 + d;
              const v2u o = {cvtpk(bf2f(Qb[t * 136 + dk]) * e, bf2f(Qb[t * 136 + dk + 1]) * e), cvtpk(bf2f(Qb[t * 136 + dk + 2]) * e, bf2f(Qb[t * 136 + dk + 3]) * e)};
              *(GAS v2u*)(QG + frag_off(t, dk, 8)) = o; } }
        else { const int dk = u >> 1, s0 = (u & 1) * 32; bf16* KE = (bf16*)(L.ws + WS_KE) + (size_t)item * 8192;
#pragma unroll 2
          for (int s = 0; s < 32; s += 4) { const int tk = s0 + s;
              const v2u o = {cvtpk(Kf[tk * 128 + dk] * kex[tk], Kf[(tk + 1) * 128 + dk] * kex[tk + 1]), cvtpk(Kf[(tk + 2) * 128 + dk] * kex[tk + 2], Kf[(tk + 3) * 128 + dk] * kex[tk + 3])};
              *(GAS v2u*)(KE + frag_off(dk, tk, 4)) = o; } }
    }
    __syncthreads();
    tid = opaque_tid();
    if (tid < 256) {
        const int c = tid; const bool isw = c >= 128; LAS float* X = isw ? Kf + (c - 128) : Vf + c;
        unsigned* U0 = (unsigned*)(L.ws + WS_U0) + (size_t)item * 4096 + ((c & 127) >> 5) * 1024 + (c & 31); bf16* WN = (bf16*)(L.ws + WS_WN) + (size_t)item * 8192;
#pragma unroll 1
        for (int tb = 0; tb < 4; ++tb) {
            float a[16];
#pragma unroll
            for (int i = 0; i < 16; ++i) { const int t = tb * 16 + i; a[i] = betas[t] * (isw ? egs[t] : 1.0f) * X[t * 128]; }
#pragma unroll 1
            for (int sb = 0; sb < tb; ++sb) {
                float xs[16];
#pragma unroll
                for (int j = 0; j < 16; ++j) xs[j] = X[(sb * 16 + j) * 128];
#pragma unroll
                for (int i = 0; i < 16; ++i) { const LAS f32x4* ar = (const LAS f32x4*)(Am + (tb * 16 + i) * 64 + sb * 16);
#pragma unroll
                    for (int j4 = 0; j4 < 4; ++j4) { const f32x4 av = ar[j4]; a[i] -= av.x * xs[4 * j4]; a[i] -= av.y * xs[4 * j4 + 1]; a[i] -= av.z * xs[4 * j4 + 2]; a[i] -= av.w * xs[4 * j4 + 3]; }
                    if ((i & 3) == 3) asm volatile("" ::: "memory"); }
            }
#pragma unroll
            for (int i = 1; i < 16; ++i) { const LAS float* ar = Am + (tb * 16 + i) * 64 + tb * 16;
#pragma unroll
                for (int j = 0; j < i; ++j) a[i] -= ar[j] * a[j];
                if ((i & 3) == 3) asm volatile("" ::: "memory"); }
#pragma unroll
            for (int i = 0; i < 16; ++i) { const int t = tb * 16 + i; X[t * 128] = a[i];
                if (!isw) { if ((i & 1) == 0) U0[(((tb >> 1) * 8 + (((i & 3) >> 1) | ((2 * (tb & 1) + (i >> 3)) << 1))) * 64) + ((i >> 2) & 1) * 32] = cvtpk(a[i], a[i + 1 < 16 ? i + 1 : 15]); } else WN[frag_off(t, c - 128, 8)] = cvt1(-a[i]); }
        }
    }
    __syncthreads();
}
constexpr int SC_BUF = 57344, SC_WN = 0, SC_QG = 16384, SC_QK = 32768, SC_KE = 40960;
struct ScanRegs { v4u a[14]; };
DI void dscan_issue(ScanRegs& R, const unsigned char* ws, size_t item, int lw, int lane) {
    const GAS v4u* wn = (const GAS v4u*)(ws + WS_WN + item * 16384) + lane; const GAS v4u* qg = (const GAS v4u*)(ws + WS_QG + item * 16384) + lane;
    const GAS v4u* qk = (const GAS v4u*)(ws + WS_QK + item * 8192) + lane;  const GAS v4u* ke = (const GAS v4u*)(ws + WS_KE + item * 16384) + lane;
#pragma unroll
    for (int i = 0; i < 4; ++i) { const int f = lw + 4 * i; R.a[i] = wn[f * 64]; R.a[4 + i] = qg[f * 64]; R.a[8 + i] = ke[f * 64]; }
#pragma unroll
    for (int i = 0; i < 2; ++i) R.a[12 + i] = qk[(lw + 4 * i) * 64];
}
DI void dscan_store_a(const ScanRegs& R, LAS unsigned char* buf, int lw, int lane) {
    LAS v4u* b = (LAS v4u*)buf + lane;
#pragma unroll
    for (int i = 0; i < 4; ++i) { const int f = lw + 4 * i; b[(SC_WN / 16) + f * 64] = R.a[i]; b[(SC_QG / 16) + f * 64] = R.a[4 + i]; b[(SC_KE / 16) + f * 64] = R.a[8 + i]; }
#pragma unroll
    for (int i = 0; i < 2; ++i) b[(SC_QK / 16) + (lw + 4 * i) * 64] = R.a[12 + i];
}
#define SC_RD(off) (*(const LAS bf16x8*)(buf + (off)))
#define SC_SB() __builtin_amdgcn_sched_barrier(0)
DI void dscan_chunk(f32x16 (&S)[4], unsigned (&Uw)[16], unsigned (&Unw)[16], float& gen, const LAS unsigned char* buf, const GAS unsigned* U1, const GAS float* GE, GAS unsigned* od, int n) {
    f32x16 U[2];
#pragma unroll
    for (int rt = 0; rt < 2; ++rt)
#pragma unroll
        for (int kp = 0; kp < 8; ++kp) { U[rt][2 * kp] = bflo(Uw[rt * 8 + kp]); U[rt][2 * kp + 1] = bfhi(Uw[rt * 8 + kp]); }
    const float ge = gen;
    f32x16 O[2];
    bf16x8 fa[4], fb[4];
    fa[0] = SC_RD(SC_WN); fa[1] = SC_RD(SC_QG); fa[2] = SC_RD(SC_WN + 8 * 1024); fa[3] = SC_RD(SC_QG + 8 * 1024);
    const bool more = n + 1 < 64;
    f32x16 zero;
#pragma unroll
    for (int k = 0; k < 16; ++k) zero[k] = 0.f;
    bf16x8 qa[2], qb[2];
#pragma unroll
    for (int ks = 0; ks < 8; ++ks) {
        bf16x8 (&cur)[4] = (ks & 1) ? fb : fa; bf16x8 (&nxt)[4] = (ks & 1) ? fa : fb;
        if (ks < 7) { nxt[0] = SC_RD(SC_WN + (ks + 1) * 1024); nxt[1] = SC_RD(SC_QG + (ks + 1) * 1024); nxt[2] = SC_RD(SC_WN + (8 + ks + 1) * 1024); nxt[3] = SC_RD(SC_QG + (8 + ks + 1) * 1024); }
        else { qa[0] = SC_RD(SC_QK); qa[1] = SC_RD(SC_QK + 4 * 1024); }
        SC_SB();
        const bf16x8 sb = pack_step(S[ks >> 1], ks & 1);
        U[0] = MFMA32(cur[0], sb, U[0]); O[0] = MFMA32(cur[1], sb, ks == 0 ? zero : O[0]); U[1] = MFMA32(cur[2], sb, U[1]); O[1] = MFMA32(cur[3], sb, ks == 0 ? zero : O[1]);
        if (more) { if (ks == 0) gen = GE[n + 1];
#pragma unroll
            for (int j = 0; j < 2; ++j) Unw[(ks >> 2) * 8 + 2 * (ks & 3) + j] = U1[((ks >> 2) * 8 + 2 * (ks & 3) + j) * 64]; }
        if (ks & 1) S[ks >> 1] = S[ks >> 1] * ge;
        SC_SB();
    }
    bf16x8 Ub[4];
#pragma unroll
    for (int rt = 0; rt < 2; ++rt) { Ub[2 * rt] = pack_step(U[rt], 0); Ub[2 * rt + 1] = pack_step(U[rt], 1); }
#pragma unroll
    for (int ks = 0; ks < 4; ++ks) {
        bf16x8 (&cur)[2] = (ks & 1) ? qb : qa; bf16x8 (&nxt)[2] = (ks & 1) ? qa : qb;
        if (ks < 3) { nxt[0] = SC_RD(SC_QK + (ks + 1) * 1024); nxt[1] = SC_RD(SC_QK + (4 + ks + 1) * 1024); }
        else {
#pragma unroll
            for (int d = 0; d < 4; ++d) fa[d] = SC_RD(SC_KE + (d * 4) * 1024); }
        SC_SB();
        O[0] = MFMA32(cur[0], Ub[ks], O[0]); O[1] = MFMA32(cur[1], Ub[ks], O[1]);
        SC_SB();
    }
#pragma unroll
    for (int ks = 0; ks < 4; ++ks) {
        bf16x8 (&cur)[4] = (ks & 1) ? fb : fa; bf16x8 (&nxt)[4] = (ks & 1) ? fa : fb;
        if (ks < 3) {
#pragma unroll
            for (int d = 0; d < 4; ++d) nxt[d] = SC_RD(SC_KE + (d * 4 + ks + 1) * 1024); }
        SC_SB();
#pragma unroll
        for (int d = 0; d < 4; ++d) S[d] = MFMA32(cur[d], Ub[ks], S[d]);
#pragma unroll
        for (int j = 0; j < 4; ++j) od[((ks >> 1) * 8 + 4 * (ks & 1) + j) * 64] = cvtpk(O[ks >> 1][8 * (ks & 1) + 2 * j], O[ks >> 1][8 * (ks & 1) + 2 * j + 1]);
        SC_SB();
    }
}
DI void dscan_wg(Frame& F, const Lyr& L, int bh, size_t od_extra = 0, int hs_ = 0) {
    const int b = bh >> 2, h = bh & 3, w = F.wave, lane = opaque_tid() & 63, r = lane & 31, hh = lane >> 5, dv0 = (w & 3) * 32, l = L.l;
    const bool loader = w >= 4; const int lw = w - 4;
    const size_t item0 = (size_t)bh * 64;
    if (loader) {
        ScanRegs R0, R1, R2, R3;
        dscan_issue(R0, L.ws, item0, lw, lane);
        asm volatile("s_waitcnt vmcnt(0)" ::: "memory");
        dscan_store_a(R0, F.lds, lw, lane);
        asm volatile("s_waitcnt lgkmcnt(0)" ::: "memory");
        dscan_issue(R1, L.ws, item0 + 1, lw, lane);
        dscan_issue(R2, L.ws, item0 + 2, lw, lane);
        dscan_issue(R3, L.ws, item0 + 3, lw, lane);
#define SC_TRIP(RS, RN, BUFOFF, NEXT) \
            __builtin_amdgcn_s_barrier(); asm volatile("" ::: "memory"); \
            asm volatile("s_waitcnt vmcnt(28)" ::: "memory"); \
            dscan_store_a(RS, F.lds + (BUFOFF), lw, lane); \
            asm volatile("s_waitcnt lgkmcnt(0)" ::: "memory"); \
            dscan_issue(RN, L.ws, item0 + ((NEXT) < 64 ? (NEXT) : 63), lw, lane);
#pragma unroll 1
        for (int n = 0; n < 64; n += 4) {
            SC_TRIP(R1, R0, SC_BUF, n + 4)
            SC_TRIP(R2, R1, 0, n + 5)
            SC_TRIP(R3, R2, SC_BUF, n + 6)
            SC_TRIP(R0, R3, 0, n + 7)
        }
#undef SC_TRIP
        asm volatile("s_waitcnt vmcnt(0)" ::: "memory");
    } else {
        f32x16 S[4]; unsigned UA[16], UB[16];
#pragma unroll
        for (int d = 0; d < 4; ++d)
#pragma unroll
            for (int k = 0; k < 16; ++k) S[d][k] = 0.f;
        const int uoff = (4 * hh) * 128 + dv0 + r, sl = w & 3;
        GAS unsigned* ODp = (GAS unsigned*)(L.ws + WS_OD) + (item0 * 4 + sl) * 1024 + lane;
        const GAS unsigned* U0 = (const GAS unsigned*)((const unsigned*)(L.ws + WS_U0) + item0 * 4096) + sl * 1024 + lane;
        const GAS float* GE = (const GAS float*)(L.ws + WS_GE) + item0;
        float gen = GE[0];
#pragma unroll
        for (int rt = 0; rt < 2; ++rt)
#pragma unroll
            for (int kp = 0; kp < 8; ++kp) UA[rt * 8 + kp] = U0[(rt * 8 + kp) * 64];
#pragma unroll 1
        for (int n = 0; n < 64; n += 2) {
            __builtin_amdgcn_s_barrier(); asm volatile("" ::: "memory");
            dscan_chunk(S, UA, UB, gen, F.lds + lane * 16, U0 + (size_t)(n + 1) * 4096, GE, ODp + (size_t)n * 4096, n);
            __builtin_amdgcn_s_barrier(); asm volatile("" ::: "memory");
            dscan_chunk(S, UB, UA, gen, F.lds + SC_BUF + lane * 16, U0 + (size_t)(n + 2) * 4096, GE, ODp + (size_t)(n + 1) * 4096, n + 1);
        }
        GAS float* PD = (GAS float*)(L.out + O_PD + ((size_t)(l * NB + b) * 4 + h) * 16384);
#pragma unroll
        for (int d = 0; d < 4; ++d)
#pragma unroll
            for (int k = 0; k < 16; ++k) (PD + (d * 32 + CR(k)) * 128)[uoff] = S[d][k];
    }
    __syncthreads();
}

DI void ssm_pass2_item(Frame& F, const Lyr& L, int item) {
    const int b = item >> 7, blk = item & 127, w = F.wave, lane = opaque_tid() & 63, l = L.l;
    LAS bf16* Sw = (LAS bf16*)(F.lds + w * 8704); LAS bf16* Y = (LAS bf16*)(F.lds + 69632);
    const int m0 = b * SEQ + blk * 32;
#pragma unroll 1
    for (int gi = 0; gi < 4; ++gi) {
        const int g = 4 * w + gi, p = lane, e = (l * 32 + g) * 64 + p;
        const f32x2v a = ((const f32x2v*)(L.ws + WS_ABAR))[e], a32 = ((const f32x2v*)(L.ws + WS_A32))[e];
        float sr = 0.f, si = 0.f; unsigned wv[32];
        const GAS f32x2v* E = (const GAS f32x2v*)(L.ws + WS_E) + (size_t)(b * 32 + g) * 128 * 64 + p;
        {
            float t2r = a32.x * a32.x - a32.y * a32.y, t2i = 2.f * a32.x * a32.y; const float a128r = t2r * t2r - t2i * t2i, a128i = 2.f * t2r * t2i;
            const int sbn = blk >> 2, jn = blk & 3;
            const GAS unsigned* bu = (const GAS unsigned*)(L.ws + WS_BU) + ((size_t)(b * 32 + g) * 128 + blk) * 2048 + p;
            f32x2v evs[31];
#pragma unroll
            for (int i = 0; i < 31; ++i) evs[i] = E[(4 * (i < sbn ? i : 0) + 3) * 64];
            const f32x2v evl = E[(jn > 0 ? blk - 1 : 0) * 64];
#pragma unroll
            for (int t = 0; t < 16; ++t) wv[t] = bu[t * 64];
#pragma unroll
            for (int i = 0; i < 31; ++i) if (i < sbn) { const float nr = a128r * sr - a128i * si + evs[i].x, ni = a128r * si + a128i * sr + evs[i].y; sr = nr; si = ni; }
            if (jn > 0) { const f32x2v ev = evl;
                for (int j = 0; j < jn; ++j) { const float nr = a32.x * sr - a32.y * si, ni = a32.x * si + a32.y * sr; sr = nr; si = ni; }
                sr += ev.x; si += ev.y; }
        }
        const bf16* zrow = L.Z + (size_t)m0 * ZW + ZC_SU + g * 16;
        const int r16 = lane & 15, q4 = lane >> 4;
        const GAS bf16x8* Cf = (const GAS bf16x8*)((const bf16*)(L.ws + WS_CFRAG) + (size_t)(l * 32 + g) * 2048) + lane;
        bf16x8 cbv[4]; unsigned short uz[8];
#pragma unroll
        for (int kb = 0; kb < 4; ++kb) cbv[kb] = Cf[kb * 64];
        const float dsk = L.A->in[I_SSMD][l * 512 + g * 16 + r16];
#pragma unroll
        for (int rt = 0; rt < 2; ++rt)
#pragma unroll
            for (int k = 0; k < 4; ++k) uz[rt * 4 + k] = zrow[(size_t)(rt * 16 + 4 * q4 + k) * ZW + r16];
        {
            const GAS unsigned* bu2 = (const GAS unsigned*)(L.ws + WS_BU) + ((size_t)(b * 32 + g) * 128 + blk) * 2048 + p;
#pragma unroll
            for (int t = 16; t < 32; ++t) wv[t] = bu2[t * 64];
#pragma unroll
            for (int t = 0; t < 32; ++t) { const float nr = a.x * sr - a.y * si + bflo(wv[t]), ni = a.x * si + a.y * sr + bfhi(wv[t]); sr = nr; si = ni;
                *(LAS unsigned*)(Sw + t * 136 + 2 * p) = cvtpk(sr, si); }
        }
        if (blk == 127) { L.out[O_PSR + (size_t)((l * NB + b) * 32 + g) * 64 + p] = sr; L.out[O_PSI + (size_t)((l * NB + b) * 32 + g) * 64 + p] = si; }
        LDS_WAIT(); asm volatile("" ::: "memory");
        f32x4 yy[2] = {{0.f, 0.f, 0.f, 0.f}, {0.f, 0.f, 0.f, 0.f}};
#pragma unroll
        for (int kb = 0; kb < 4; ++kb) { const bf16x8 cb = cbv[kb];
#pragma unroll
            for (int rt = 0; rt < 2; ++rt) yy[rt] = MFMA16(*(const LAS bf16x8*)(Sw + (rt * 16 + r16) * 136 + 32 * kb + 8 * q4), cb, yy[rt]); }
#pragma unroll
        for (int rt = 0; rt < 2; ++rt)
#pragma unroll
            for (int k = 0; k < 4; ++k) { const int t = rt * 16 + 4 * q4 + k; const float u = bf2f(uz[rt * 4 + k]);
                Y[t * 520 + g * 16 + r16] = cvt1(gelu_tanh(yy[rt][k] + dsk * u)); }
        LDS_WAIT(); asm volatile("" ::: "memory");
    }
    {
        const int r = lane & 31, hh = lane >> 5;
        const bf16* Wg = (const bf16*)(L.ws + WS_WG) + (size_t)l * 262144;
        bf16x8 wq[16][2];
#pragma unroll
        for (int j = 0; j < 8; ++j)
#pragma unroll
            for (int ct = 0; ct < 2; ++ct) wq[j][ct] = *(const GAS bf16x8*)(Wg + (size_t)(64 * w + 32 * ct + r) * 512 + 16 * j + 8 * hh);
        __syncthreads();
        f32x16 acc[2];
#pragma unroll
        for (int ct = 0; ct < 2; ++ct)
#pragma unroll
            for (int k = 0; k < 16; ++k) acc[ct][k] = 0.f;
#pragma unroll
        for (int ks = 0; ks < 32; ++ks) {
            if ((ks & 7) == 0 && ks + 8 < 32) {
#pragma unroll
                for (int j = 0; j < 8; ++j)
#pragma unroll
                    for (int ct = 0; ct < 2; ++ct) wq[(ks + 8 + j) & 15][ct] = *(const GAS bf16x8*)(Wg + (size_t)(64 * w + 32 * ct + r) * 512 + 16 * (ks + 8 + j) + 8 * hh); }
            const bf16x8 a = *(const LAS bf16x8*)(Y + r * 520 + 16 * ks + 8 * hh);
#pragma unroll
            for (int ct = 0; ct < 2; ++ct) acc[ct] = MFMA32(a, wq[ks & 15][ct], acc[ct]); }
#pragma unroll
        for (int ct = 0; ct < 2; ++ct) { const int nn = 64 * w + 32 * ct + r; const float bg = L.A->in[I_GLUB][l * 512 + nn];
            const LAS bf16* Yp = Y + (4 * hh) * 520 + nn; GAS bf16* yo = (GAS bf16*)L.YC + (size_t)(m0 + 4 * hh) * DM + 512 + nn;
#pragma unroll
            for (int k = 0; k < 16; ++k) { const float y = bf2f(Yp[CR(k) * 520]); yo[CR(k) * DM] = cvt1(y * sigmoidf_(acc[ct][k] + bg)); } }
    }
    __syncthreads();
}

DI void dpost_rows(Frame& F, const Lyr& L) {
    const int gw = F.vcu * NWAVES + F.wave, NGW = F.G * NWAVES, lane = opaque_tid() & 63, l = L.l;
    const unsigned* OD = (const unsigned*)(L.ws + WS_OD);
    const float g0 = L.A->in[I_DNG][l * 128 + 2 * lane], g1 = L.A->in[I_DNG][l * 128 + 2 * lane + 1];
    for (int rw0 = gw * 4; rw0 < MP * 4; rw0 += NGW * 4) {
        f32x2v o[4]; unsigned zg[4];
#pragma unroll
        for (int j = 0; j < 4; ++j) { const int m = (rw0 + j) >> 2, h = (rw0 + j) & 3;
            { const int tp = m & 4095, t = tp & 63, tt = t & 31, kk = (tt & 3) | ((tt >> 3) << 2);
              const v2u ow = *(const GAS v2u*)(OD + (((((size_t)((m >> 12) * 4 + h) * 64 + (tp >> 6)) * 4 + (lane >> 4)) * 2 + (t >> 5)) * 8 + (kk >> 1)) * 64 + ((tt >> 2) & 1) * 32 + 2 * (lane & 15));
              o[j] = (kk & 1) ? (f32x2v){bfhi(ow.x), bfhi(ow.y)} : (f32x2v){bflo(ow.x), bflo(ow.y)}; }
            zg[j] = *(const GAS unsigned*)(L.Z + (size_t)m * ZW + ZC_DG + h * 128 + 2 * lane); }
#pragma unroll
        for (int j = 0; j < 4; ++j) { const int m = (rw0 + j) >> 2, h = (rw0 + j) & 3;
            const float ss = wave_sum(o[j].x * o[j].x + o[j].y * o[j].y);
            const float rs = __builtin_amdgcn_rsqf(ss * (1.f / 128.f) + pg8::RMS_EPS);
            *(GAS unsigned*)(L.YC + (size_t)m * DM + 1536 + h * 128 + 2 * lane) = cvtpk(o[j].x * rs * g0 * siluf_(bflo(zg[j])), o[j].y * rs * g1 * siluf_(bfhi(zg[j]))); }
    }
}
DI float block_sum(LAS float* red, float v, int tid, int grp_waves) {
    v = wave_sum(v);
    __syncthreads();
    if ((tid & 63) == 0) red[tid >> 6] = v;
    __syncthreads();
    const int w = tid >> 6, g0 = (w / grp_waves) * grp_waves; float s = 0.f;
    for (int i = 0; i < grp_waves; ++i) s += red[g0 + i];
    return s;
}
DI void sample_attn(Frame& F, const Lyr& L, int b) {
    const int tid = opaque_tid(), lane = tid & 63, w = F.wave, l = L.l, row = MP + b;
    const bf16* zrow = L.Z + (size_t)row * ZW; bf16* yrow = L.YC + (size_t)row * DM; const Args& A = *L.A;
    LAS float* fl = (LAS float*)F.lds; LAS float* q_l = fl; LAS float* k_l = fl + 512; LAS float* v_l = fl + 640; LAS float* sc_l = fl + 768;
    const float* cosr = L.cosT + 4096 * 32; const float* sinr = L.sinT + 4096 * 32;
    {
        const int d = lane, i = d & 31;
        { const float x = bf2f(zrow[ZC_Q + tid]); const float ss = wave_sum(x * x); const float xn = x * __builtin_amdgcn_rsqf(ss * (1.f / 64.f) + pg8::RMS_EPS) * A.in[I_QNG][l * 64 + d];
          const float pr = __shfl_xor(xn, 32); const float c = cosr[i], s = sinr[i]; q_l[tid] = (d < 32 ? xn * c - pr * s : xn * c + pr * s) * 0.125f; }
        if (w < 2) { const float x = bf2f(zrow[ZC_K + tid]); const float ss = wave_sum(x * x); const float xn = x * __builtin_amdgcn_rsqf(ss * (1.f / 64.f) + pg8::RMS_EPS) * A.in[I_KNG][l * 64 + d];
          const float pr = __shfl_xor(xn, 32); const float c = cosr[i], s = sinr[i]; k_l[tid] = d < 32 ? xn * c - pr * s : xn * c + pr * s; }
        else if (w < 4) v_l[tid - 128] = bf2f(zrow[ZC_V + tid - 128]);
    }
    __syncthreads();
    const float* ck = A.in[I_CK] + (size_t)(l * NS + b) * 16384; const float* cv = A.in[I_CV] + (size_t)(l * NS + b) * 16384;
    {
        GAS f32x4* ok = (GAS f32x4*)(L.out + O_SK + (size_t)(l * NS + b) * 16384); GAS f32x4* ov = (GAS f32x4*)(L.out + O_SV + (size_t)(l * NS + b) * 16384);
#pragma unroll
        for (int k = 0; k < 8; ++k) { const int idx = tid + 512 * k, i = idx >> 5, c4 = idx & 31;
            ok[idx] = i < 127 ? ((const GAS f32x4*)ck)[idx + 32] : *(const LAS f32x4*)(k_l + 4 * c4);
            ov[idx] = i < 127 ? ((const GAS f32x4*)cv)[idx + 32] : *(const LAS f32x4*)(v_l + 4 * c4); }
    }
    const int head = w, kvh = head >> 2;
    {
        float sc[2];
#pragma unroll
        for (int jj = 0; jj < 2; ++jj) { const int j = lane + 64 * jj; float acc = 0.f;
            if (j < 127) { const GAS f32x4* kp = (const GAS f32x4*)(ck + (size_t)(j + 1) * 128 + kvh * 64);
#pragma unroll
                for (int d4 = 0; d4 < 16; ++d4) { const f32x4 kv = kp[d4]; const f32x4 qv = *(const LAS f32x4*)(q_l + head * 64 + 4 * d4); acc += (kv.x * qv.x + kv.y * qv.y) + (kv.z * qv.z + kv.w * qv.w); } }
            else {
#pragma unroll
                for (int d4 = 0; d4 < 16; ++d4) { const f32x4 kv = *(const LAS f32x4*)(k_l + kvh * 64 + 4 * d4); const f32x4 qv = *(const LAS f32x4*)(q_l + head * 64 + 4 * d4); acc += (kv.x * qv.x + kv.y * qv.y) + (kv.z * qv.z + kv.w * qv.w); } }
            sc[jj] = acc; }
        const float sink = A.in[I_SINK][l * 8 + head];
        const float mx = fmaxf(wave_max(fmaxf(sc[0], sc[1])), sink);
        const float p0 = __expf(sc[0] - mx), p1 = __expf(sc[1] - mx);
        const float inv = 1.f / (wave_sum(p0 + p1) + __expf(sink - mx));
        sc_l[head * 128 + lane] = p0 * inv; sc_l[head * 128 + lane + 64] = p1 * inv;
        LDS_WAIT(); asm volatile("" ::: "memory");
    }
    {
        const int d4 = (lane & 15) * 4, ks = lane >> 4; f32x4 o = {0.f, 0.f, 0.f, 0.f};
        const int jend = ks == 3 ? 31 : 32;
#pragma unroll 8
        for (int jj = 0; jj < jend; ++jj) { const int j = 32 * ks + jj; const float p = sc_l[head * 128 + j]; const f32x4 v = *(const GAS f32x4*)(cv + (size_t)(j + 1) * 128 + kvh * 64 + d4); o += v * p; }
        if (ks == 3) { const float p = sc_l[head * 128 + 127]; o += *(const LAS f32x4*)(v_l + kvh * 64 + d4) * p; }
#pragma unroll
        for (int e = 0; e < 4; ++e) { o[e] += __shfl_xor(o[e], 16); o[e] += __shfl_xor(o[e], 32); }
        if (ks == 0) *(GAS v2u*)(yrow + head * 64 + d4) = (v2u){cvtpk(o[0], o[1]), cvtpk(o[2], o[3])};
    }
    __syncthreads();
}
DI void sample_ssm(Frame& F, const Lyr& L, int b) {
    const int tid = opaque_tid(), l = L.l, row = MP + b;
    const bf16* zrow = L.Z + (size_t)row * ZW; bf16* yrow = L.YC + (size_t)row * DM; const Args& A = *L.A;
    LAS float* fl = (LAS float*)F.lds; LAS float* s_l = fl; LAS float* y_l = fl + 4096; LAS float* part = fl + 4608;
#pragma unroll 1
    for (int k = 0; k < 4; ++k) { const int idx = tid + 512 * k, g = idx >> 6, e = l * 2048 + idx;
        const f32x2v a = ((const f32x2v*)(L.ws + WS_ABAR))[e];
        const float s0r = A.in[I_SSR][(size_t)(l * NS + b) * 2048 + idx], s0i = A.in[I_SSI][(size_t)(l * NS + b) * 2048 + idx];
        float br = 0.f, bi = 0.f; const GAS f32x4* bbp = (const GAS f32x4*)((const f32x2v*)(L.ws + WS_BBAR) + (size_t)e * 16);
        const GAS v4u* up = (const GAS v4u*)(zrow + ZC_SU + g * 16); const v4u u0 = up[0], u1 = up[1]; const unsigned ww[8] = {u0.x, u0.y, u0.z, u0.w, u1.x, u1.y, u1.z, u1.w};
#pragma unroll
        for (int c = 0; c < 8; ++c) { const f32x4 bv = bbp[c]; const float x0 = bflo(ww[c]), x1 = bfhi(ww[c]); br += bv.x * x0 + bv.z * x1; bi += bv.y * x0 + bv.w * x1; }
        const float sr = a.x * s0r - a.y * s0i + br, si = a.x * s0i + a.y * s0r + bi;
        L.out[O_SSR + (size_t)(l * NS + b) * 2048 + idx] = sr; L.out[O_SSI + (size_t)(l * NS + b) * 2048 + idx] = si;
        s_l[2 * idx] = sr; s_l[2 * idx + 1] = si; }
    __syncthreads();
    {
        const int g = tid >> 4, c = tid & 15; const GAS f32x4* cr = (const GAS f32x4*)(A.in[I_CRE] + ((size_t)(l * 32 + g) * 16 + c) * 64); const GAS f32x4* ci = (const GAS f32x4*)(A.in[I_CIM] + ((size_t)(l * 32 + g) * 16 + c) * 64);
        float acc = 0.f;
#pragma unroll
        for (int p4 = 0; p4 < 16; ++p4) { const f32x4 a = cr[p4], bq = ci[p4]; const LAS f32x4* sp = (const LAS f32x4*)(s_l + 2 * (g * 64 + 4 * p4)); const f32x4 s0 = sp[0], s1 = sp[1];
            acc += (a.x * s0.x - bq.x * s0.y) + (a.y * s0.z - bq.y * s0.w) + (a.z * s1.x - bq.z * s1.y) + (a.w * s1.z - bq.w * s1.w); }
        acc += A.in[I_SSMD][l * 512 + tid] * bf2f(zrow[ZC_SU + tid]);
        y_l[tid] = gelu_tanh(acc);
    }
    __syncthreads();
    {
        const int n4 = (tid & 127) * 4, ks = tid >> 7; const GAS f32x4* gw = (const GAS f32x4*)(A.in[I_GLUW] + (size_t)l * 262144 + (size_t)(ks * 128) * 512 + n4); f32x4 acc = {0.f, 0.f, 0.f, 0.f};
#pragma unroll 16
        for (int k = 0; k < 128; ++k) acc += gw[k * 128] * y_l[ks * 128 + k];
        *(LAS f32x4*)(part + ks * 512 + n4) = acc;
    }
    __syncthreads();
    { const float acc = A.in[I_GLUB][l * 512 + tid] + (part[tid] + part[512 + tid]) + (part[1024 + tid] + part[1536 + tid]); yrow[512 + tid] = cvt1(y_l[tid] * sigmoidf_(acc)); }
    __syncthreads();
}
DI void sample_sgate(Frame& F, const Lyr& L, int b) {
    const int tid = opaque_tid(), l = L.l, row = MP + b;
    const bf16* zrow = L.Z + (size_t)row * ZW; bf16* yrow = L.YC + (size_t)row * DM; const Args& A = *L.A;
    LAS float* red = (LAS float*)F.lds;
    const float u = bf2f(zrow[ZC_GU + tid]), v = bf2f(zrow[ZC_GV + tid]);
    const float ss = block_sum(red, v * v, tid, 8);
    const float vn = v * __builtin_amdgcn_rsqf(ss * (1.f / 512.f) + pg8::RMS_EPS) * A.in[I_SGNG][l * 512 + tid];
    L.out[O_SCV + (size_t)(l * NS + b) * 512 + tid] = vn;
    const int g = tid >> 7;
    yrow[1024 + tid] = cvt1(u * (A.in[I_SGW][(size_t)(l * 4 + g) * 16384] * vn + A.in[I_SGB][(l * 4 + g) * 128]));
    __syncthreads();
}
DI void sample_delta(Frame& F, const Lyr& L, int b, int h) {
    const int tid = opaque_tid(), l = L.l, row = MP + b;
    const bf16* zrow = L.Z + (size_t)row * ZW; const float* zab = L.ZAB + (size_t)row * 8; bf16* yrow = L.YC + (size_t)row * DM; const Args& A = *L.A;
    LAS float* fl = (LAS float*)F.lds; LAS float* red = fl; LAS float* q_l = fl + 16; LAS float* k_l = fl + 144; LAS float* v_l = fl + 272; LAS float* U_l = fl + 400; LAS float* part = fl + 528;
    float y = 0.f;
    if (tid < 384) { const int wh = tid >> 7, d = tid & 127, ch = wh * 512 + h * 128 + d; const float x = bf2f(zrow[ZC_DQ + ch]);
        const float* sc0 = A.in[I_SC] + (size_t)(l * NS + b) * 3 * 1536 + ch; const float* cw = A.in[I_CONVW] + (size_t)l * 4 * 1536 + ch;
        const float b0 = sc0[0], b1 = sc0[1536], b2 = sc0[3072];
        y = siluf_(cw[0] * b0 + cw[1536] * b1 + cw[3072] * b2 + cw[4608] * x);
        float* oc = L.out + O_SC + (size_t)(l * NS + b) * 3 * 1536 + ch; oc[0] = b1; oc[1536] = b2; oc[3072] = x; }
    const float ssq = block_sum(red, y * y, tid, 2);
    if (tid < 128) q_l[tid] = y * __builtin_amdgcn_rsqf(ssq + pg8::RMS_EPS) * 0.08838834764831845f;
    else if (tid < 256) k_l[tid - 128] = y * __builtin_amdgcn_rsqf(ssq + pg8::RMS_EPS);
    else if (tid < 384) v_l[tid - 256] = y;
    const float gg = -__expf(A.in[I_ALOG][l * 4 + h]) * softplusf_(zab[h] + A.in[I_DTB][l * 4 + h]);
    const float eg = __expf(gg), beta = sigmoidf_(zab[4 + h]);
    __syncthreads();
    const int dks = tid >> 5, dv4 = (tid & 31) * 4;
    const GAS f32x4* S0 = (const GAS f32x4*)(A.in[I_SD] + ((size_t)(l * NS + b) * 4 + h) * 16384 + (size_t)(dks * 8) * 128 + dv4);
    f32x4 s[8]; f32x4 ks = {0.f, 0.f, 0.f, 0.f};
#pragma unroll
    for (int i = 0; i < 8; ++i) s[i] = S0[i * 32];
#pragma unroll
    for (int i = 0; i < 8; ++i) ks += s[i] * k_l[dks * 8 + i];
    *(LAS f32x4*)(part + dks * 128 + dv4) = ks;
    __syncthreads();
    if (tid < 128) { float t = 0.f;
#pragma unroll
        for (int i = 0; i < 16; ++i) t += part[i * 128 + tid];
        U_l[tid] = beta * (v_l[tid] - eg * t); }
    __syncthreads();
    {
        const f32x4 U = *(const LAS f32x4*)(U_l + dv4); f32x4 o = {0.f, 0.f, 0.f, 0.f};
        GAS f32x4* S1 = (GAS f32x4*)(L.out + O_SD + ((size_t)(l * NS + b) * 4 + h) * 16384 + (size_t)(dks * 8) * 128 + dv4);
#pragma unroll
        for (int i = 0; i < 8; ++i) { const f32x4 sn = s[i] * eg + U * k_l[dks * 8 + i]; S1[i * 32] = sn; o += sn * q_l[dks * 8 + i]; }
        *(LAS f32x4*)(part + dks * 128 + dv4) = o;
    }
    __syncthreads();
    float o = 0.f;
    if (tid < 128) {
#pragma unroll
        for (int i = 0; i < 16; ++i) o += part[i * 128 + tid]; }
    const float so = block_sum(red, o * o, tid, 2);
    if (tid < 128) yrow[1536 + h * 128 + tid] = cvt1(o * __builtin_amdgcn_rsqf(so * (1.f / 128.f) + pg8::RMS_EPS) * A.in[I_DNG][l * 128 + tid] * siluf_(bf2f(zrow[ZC_DG + h * 128 + tid])));
    __syncthreads();
}
DI void sample_sub(Frame& F, const Lyr& L, int it) {
    const int part = it >> 5, b = it & 31;
    if (part < 4) sample_delta(F, L, b, part);
    else if (part == 4) sample_attn(F, L, b);
    else if (part == 5) sample_ssm(F, L, b);
    else sample_sgate(F, L, b);
}
enum { TH_IN = 0, TH_BR = 1, TH_RES = 2, TH_FF1 = 3 };
struct ThinArgs {
    const bf16* X; const bf16* Wt; int N, K;
    int first, stride;
    bf16* Z; float* ZAB; bf16* G; bf16* GS; bf16* H; bf16* XB;
    const float* R; float* Xs;
    const float* ssq_in; float* ssq_out;
};
template <int MODE>
DI void thin_gemm(Frame& F, const ThinArgs& T) {
    constexpr int NC = (MODE == TH_BR || MODE == TH_RES) ? 1 : 2;
    const int tid = opaque_tid(), lane = tid & 63, w = F.wave, r16 = lane & 15, q4 = lane >> 4;
    LAS float* red = (LAS float*)F.lds;
    LAS float* sqs = (LAS float*)(F.lds + 32768);
    LAS float* rsl = (LAS float*)(F.lds + 32768 + 4096);
    const int ncg = T.N / (16 * NC), K = T.K, kw = K / 8, nst = kw / 32;
    if (T.first >= ncg) return;
    if (MODE == TH_IN || MODE == TH_FF1) {
        const int row = tid >> 4, part = tid & 15; const f32x4 v = *(const GAS f32x4*)(T.ssq_in + row * 128 + part * 8), v2 = *(const GAS f32x4*)(T.ssq_in + row * 128 + part * 8 + 4);
        float s = ((v[0] + v[1]) + (v[2] + v[3])) + ((v2[0] + v2[1]) + (v2[2] + v2[3]));
        s += __shfl_xor(s, 1); s += __shfl_xor(s, 2); s += __shfl_xor(s, 4); s += __shfl_xor(s, 8);
        if (part == 0) rsl[row] = __builtin_amdgcn_rsqf(s * (1.0f / 2048.0f) + pg8::RMS_EPS);
        __syncthreads();
    }
    for (int cg = T.first; cg < ncg; cg += T.stride) {
        if (MODE == TH_IN && cg >= 137 && cg < 144) continue;
        const GAS bf16x8* wp0 = (const GAS bf16x8*)(T.Wt + (size_t)(cg * 16 * NC + r16) * K + w * kw + 8 * q4);
        const GAS bf16x8* wp1 = (const GAS bf16x8*)(T.Wt + (size_t)(cg * 16 * NC + (NC == 2 ? 16 : 0) + r16) * K + w * kw + 8 * q4);
        const GAS bf16x8* x0 = (const GAS bf16x8*)(T.X + (size_t)r16 * K + w * kw + 8 * q4);
        const GAS bf16x8* x1 = (const GAS bf16x8*)(T.X + (size_t)(16 + r16) * K + w * kw + 8 * q4);
        f32x4 a00 = {0.f, 0.f, 0.f, 0.f}, a01 = a00, a10 = a00, a11 = a00;
#pragma unroll 8
        for (int s = 0; s < nst; ++s) { const bf16x8 w0 = wp0[4 * s], xa = x0[4 * s], xb = x1[4 * s];
            a00 = MFMA16(w0, xa, a00); a01 = MFMA16(w0, xb, a01);
            if (NC == 2) { const bf16x8 w1 = wp1[4 * s]; a10 = MFMA16(w1, xa, a10); a11 = MFMA16(w1, xb, a11); } }
        LAS f32x4* rw = (LAS f32x4*)red + (w * 4) * 64 + lane;
        rw[0] = a00; rw[64] = a01; if (NC == 2) { rw[128] = a10; rw[192] = a11; }
        __syncthreads();
#pragma unroll
        for (int o = 0; o < NC; ++o) {
            const int e = tid + 512 * o, t = e >> 8, ln = (e >> 2) & 63, reg = e & 3, i = 16 * (t & 1) + (ln & 15), c = cg * 16 * NC + 16 * (t >> 1) + 4 * (ln >> 4) + reg;
            float v = 0.f;
            if (MODE == TH_BR) {
#pragma unroll
                for (int b = 0; b < 4; ++b) { const float g = bf2f(T.G[(size_t)i * 8192 + b * 2048 + c]);
                    v += g * (red[(((2 * b) * 4 + t) * 64 + ln) * 4 + reg] + red[(((2 * b + 1) * 4 + t) * 64 + ln) * 4 + reg]); }
            } else {
#pragma unroll
                for (int ww = 0; ww < 8; ++ww) v += red[((ww * 4 + t) * 64 + ln) * 4 + reg];
            }
            if (MODE == TH_IN) { const float z = v * rsl[i];
                if (c < 4352) T.Z[(size_t)i * ZW + c] = cvt1((c >= 1280 && c < 2304) ? gelu_tanh(z) : z);
                else if (c < 4360) T.ZAB[i * 8 + (c - 4352)] = z;
                else if (c >= 4608) T.G[(size_t)i * 8192 + (c - 4608)] = cvt1(fmaxf(sigmoidf_(z), 1e-18f)); }
            else if (MODE == TH_BR) T.GS[(size_t)i * DM + c] = cvt1(v);
            else if (MODE == TH_FF1) { const float a = fmaxf(v * rsl[i], 0.f); T.H[(size_t)i * DFF + c] = cvt1(a * a); }
            else { const float x = T.R[i * DM + c] + v; T.Xs[i * DM + c] = x; T.XB[(size_t)i * DM + c] = cvt1(x); sqs[e] = x * x; }
        }
        __syncthreads();
        if (MODE == TH_RES) { if (tid < 32) { const int rh = tid >> 4, rr = tid & 15; float s = 0.f;
#pragma unroll
                for (int ch = 0; ch < NC; ++ch)
#pragma unroll
                    for (int q = 0; q < 4; ++q)
#pragma unroll
                        for (int g = 0; g < 4; ++g) s += sqs[(2 * ch + rh) * 256 + (q * 16 + rr) * 4 + g];
                T.ssq_out[tid * 128 + cg] = s; } }
    }
    __syncthreads();
}
template <class Ord> DI void fill_rstd(LAS float* rsl, const Ord& S2, const float* P) {
    LAS int* pmv = (LAS int*)(rsl + 2048);
    const int t = opaque_tid();
    if (t < 8) { pg8::Unit u_; pmv[t] = S2.next(t, u_) ? u_.pm : -1; }
    __syncthreads();
#pragma unroll
    for (int pass = 0; pass < 2; ++pass) {
        f32x4 v[2][8]; int pm[2];
#pragma unroll
        for (int j = 0; j < 2; ++j) { const int idx = t + 512 * (2 * pass + j); pm[j] = pmv[idx >> 8];
            const GAS f32x4* p = (const GAS f32x4*)(P + (size_t)((pm[j] < 0 ? 0 : pm[j]) * 256 + (idx & 255)) * 32);
#pragma unroll
            for (int i = 0; i < 8; ++i) v[j][i] = p[i]; }
#pragma unroll
        for (int j = 0; j < 2; ++j) { const int idx = t + 512 * (2 * pass + j); float s = 0.f;
#pragma unroll
            for (int i = 0; i < 8; ++i) s += (v[j][i][0] + v[j][i][1]) + (v[j][i][2] + v[j][i][3]);
            if (pm[j] >= 0) rsl[idx] = __builtin_amdgcn_rsqf(s * (1.0f / 2048.0f) + pg8::RMS_EPS); }
    }
    __syncthreads();
}
__global__ void __launch_bounds__(NWAVES * 64, 2) hybrid_fwd(Args args) {
    extern __shared__ __attribute__((aligned(16))) unsigned char lds[];
    Frame F;
    F.lds = (LAS unsigned char*)lds;
    F.MISC = (volatile LAS unsigned*)(F.lds + MISC_OFF);
    F.tid = threadIdx.x; F.lane = F.tid & 63; F.wave = __builtin_amdgcn_readfirstlane(F.tid >> 6);
    F.G = gridDim.x; { const int bx = blockIdx.x; F.vcu = (F.G % 8 == 0) ? (bx % 8) * (F.G / 8) + bx / 8 : bx; }
    F.ws = args.ws; F.ctl = (gu32*)(args.ws + WS_CTL);
    for (int u = F.tid; u < (LDS_BYTES - LDSCTL_OFF) / 4; u += NWAVES * 64) ((LAS unsigned*)(F.lds + LDSCTL_OFF))[u] = 0u;
    __syncthreads();
    XcdBarrier bar = xcd_barrier_post((unsigned*)(F.ctl + CW_BAR), F.MISC + 8);
    unsigned char* ws = args.ws;
#define GRID_BARK(k) do { GRID_BAR(); if ((PROBE_BARMASK >> (k)) & 1) GRID_BAR(); } while (0)
#define GRID_BAR() do { for (int brep_ = 0; brep_ < REP_BAR; ++brep_) { XcdBarrier b2_ = bar; asm volatile("" : "+s"(b2_.bar), "+s"(b2_.x)); xcd_barrier(b2_); } } while (0)
    const int bid = blockIdx.x, G = F.G;

#ifndef NO_P0
    for (int rep_ = 0; rep_ < REP_P0; ++rep_) { p0_prologue(F, args); if (rep_ + 1 < REP_P0) GRID_BAR(); }
#endif
    GRID_BARK(0);

#pragma unroll 1
    for (int l = 0; l < DEPTH; ++l) {
        { GAS unsigned char* wsg_ = (GAS unsigned char*)args.ws; asm volatile("" : "+s"(wsg_)); ws = (unsigned char*)wsg_; }
        float* ssq = (float*)(ws + WS_SSQP);
        bf16* XB = (bf16*)(ws + WS_XB); bf16* Zb = (bf16*)(ws + WS_Z); bf16* Gb = (bf16*)(ws + WS_G); bf16* YC = (bf16*)(ws + WS_YCAT); bf16* GS = (bf16*)(ws + WS_GS); bf16* Hb = (bf16*)(ws + WS_H);
        float* ZAB = (float*)(ws + WS_ZAB);
        float* outp; { GAS float* og_ = (GAS float*)args.out; asm volatile("" : "+s"(og_)); outp = (float*)og_; }
        float* Xp = outp + O_YP; float* Xs = outp + O_YS;
        Lyr L; L.l = l; L.Z = Zb; L.ZAB = ZAB; L.YC = YC; L.cosT = (const float*)(ws + WS_ROPE); L.sinT = L.cosT + 4097 * 32; L.A = &args; L.out = outp; L.ws = ws;
        float* ssqs = (float*)(ws + WS_SSQS);
        ThinArgs T{}; T.Z = Zb + (size_t)MP * ZW; T.ZAB = ZAB + (size_t)MP * 8; T.G = Gb + (size_t)MP * GW; T.GS = GS + (size_t)MP * DM; T.H = Hb + (size_t)MP * DFF; T.XB = XB + (size_t)MP * DM; T.Xs = Xs; T.first = F.vcu; T.stride = G;
        {
            pg8::Gemm g{XB, (const bf16*)(ws + WS_WIN) + (size_t)l * NINP * DM, MP, NINP, DM};
            LAS float* rsl = (LAS float*)(F.lds + RING_BYTES);
#pragma unroll 1
            for (int half = 0; half < 2; ++half) {
                pg8::SplitOrder S; S.init(G, bid, half ? 768 : 0, half ? 832 : 768);
                fill_rstd(rsl, S, ssq + (size_t)(2 * l) * MPAD * 32);
                pg8::EpiIn E{Zb, ZAB, Gb, rsl, (float*)(ws + WS_SGQ)};
#ifndef NO_GIN
                for (int rep_ = 0; rep_ < REP_GIN; ++rep_)
                pg8::gemm_phase<pg8::EpiIn, pg8::SplitOrder, true, true>(F.lds + RING_OFF, g, S, E);
#endif
                if (half == 0) GRID_BARK(1);
            }
            T.X = XB + (size_t)MP * DM; T.Wt = g.Bt; T.N = NINP; T.K = DM; T.ssq_in = ssqs + (2 * l) * 4096;
            { const int late = 832 % G;
              if (G > late) { T.first = bid >= late ? bid - late : 1 << 30; T.stride = G - late; } }
            for (int rep_ = 0; rep_ < REP_THIN; ++rep_) thin_gemm<TH_IN>(F, T);
            T.first = F.vcu; T.stride = G;
        }
        {
            const int late = 832 % G, early = G - late;
            int it0, step, lim;
            if (late > 0 && late < 768 && early > 0) { if (bid >= late) { it0 = bid - late; step = early; lim = 768 - late; } else { it0 = 768 - late + bid; step = G; lim = 768; } }
            else { it0 = bid; step = G; lim = 768; }
            for (int rep_ = 0; rep_ < REP_A; ++rep_)
            for (int it = it0; it < lim; it += step) {
#ifndef NO_DPREP
                if (it < 512) dprep_item(F, L, it); else
#endif
#ifndef NO_SSM1
                { ssm_pass1_task(F, L, (it - 512) * 8 + F.wave); __syncthreads(); }
#else
                {}
#endif
            }
        }
        GRID_BARK(2);
        for (int rep_ = 0; rep_ < REP_B; ++rep_) {
#ifndef NO_DSCAN
        if (bid < 8) { for (int r2_ = 0; r2_ < REP_SCAN; ++r2_) dscan_wg(F, L, bid);
#if PROBE_DET
            dscan_wg(F, L, bid, (WS_H - WS_OD) / 4);
#endif
#if PROBE_HS >= 0
            dscan_wg(F, L, bid, (WS_H - WS_OD) / 4, 1);
#endif
#if PROBE_ENDDLY
            for (int q_ = 0; q_ < PROBE_ENDDLY; ++q_) __builtin_amdgcn_s_sleep(127);
#endif
        }
        else
#endif
        for (int it = bid - 8; it < 864; ) {
#ifndef NO_SSM2
            if (it < 256) { for (int r2_ = 0; r2_ < REP_BOTH; ++r2_) ssm_pass2_item(F, L, it); } else
#endif
#ifndef NO_ATTN
            if (it < 384) { if (it >= 256) attn_item(F, L, it - 256); } else
#endif
#ifndef NO_SAMPLE
            if (it < 608) { if (it >= 384) for (int r2_ = 0; r2_ < REP_SAMP; ++r2_) sample_sub(F, L, it - 384); } else
#endif
#ifndef NO_SGATE
            { if (it >= 608) sgate_item(F, L, it - 608); }
#else
            {}
#endif
            __syncthreads();
            if (opaque_tid() == 0) F.MISC[16] = __hip_atomic_fetch_add(F.ctl + CW_QUEUE + 64 * l + 16, 1u, __ATOMIC_RELAXED, __HIP_MEMORY_SCOPE_AGENT);
            __syncthreads();
            it = (G - 8) + (int)F.MISC[16];
        }
        }
        GRID_BARK(3);
        if (PROBE_BAR2) GRID_BAR();
#if PROBE_DET
        det_compare(F, L);
#endif
#ifndef NO_DPOST
        dpost_rows(F, L);
#endif
        GRID_BARK(4);
        {
            pg8::Gemm g{YC, (const bf16*)(ws + WS_WB) + (size_t)l * DM * DM, MP, DM, DM}; pg8::StaticOrder S; S.init(MP, DM, G, bid);
            pg8::EpiGate E{Gb, GS};
#ifndef NO_GBR
            for (int rep_ = 0; rep_ < REP_G3; ++rep_)
            pg8::gemm_phase<pg8::EpiGate, pg8::StaticOrder, true, true>(F.lds + RING_OFF, g, S, E);
#endif
            T.X = YC + (size_t)MP * DM; T.Wt = g.Bt; T.N = DM; T.K = DM;
            for (int rep_ = 0; rep_ < REP_THIN; ++rep_) thin_gemm<TH_BR>(F, T);
        }
        GRID_BARK(5);
        {
            pg8::Gemm g{GS, (const bf16*)(ws + WS_WO) + (size_t)l * DM * DM, MP, DM, DM}; pg8::StaticOrder S; S.init(MP, DM, G, bid);
            pg8::EpiRes E{l == 0 ? args.in[I_XP] : Xp, l == 0 ? args.in[I_XS] : Xs, Xp, Xs, XB, ssq + (size_t)(2 * l + 1) * MPAD * 32};
#ifndef NO_GRES
            if (REP_G3 > 1) { pg8::EpiRes E2 = E; E2.Xp = (float*)(ws + 1100 * MiB); E2.XB = (bf16*)(ws + 1170 * MiB); E2.ssq_out = (float*)(ws + 1210 * MiB);
                pg8::gemm_phase<pg8::EpiRes, pg8::StaticOrder, true, true>(F.lds + RING_OFF, g, S, E2); }
            pg8::gemm_phase<pg8::EpiRes, pg8::StaticOrder, true, true>(F.lds + RING_OFF, g, S, E);
#endif
            T.X = GS + (size_t)MP * DM; T.Wt = g.Bt; T.N = DM; T.K = DM; T.R = l == 0 ? args.in[I_XS] : Xs; T.ssq_out = ssqs + (2 * l + 1) * 4096;
            thin_gemm<TH_RES>(F, T);
        }
        GRID_BARK(6);
        {
            pg8::Gemm g{XB, (const bf16*)(ws + WS_W1) + (size_t)l * DFF * DM, MP, DFF, DM}; pg8::StaticOrder S; S.init(MP, DFF, G, bid);
            LAS float* rsl = (LAS float*)(F.lds + RING_BYTES);
            { pg8::StaticOrder S2; S2.init(MP, DFF, G, bid); fill_rstd(rsl, S2, ssq + (size_t)(2 * l + 1) * MPAD * 32); }
            pg8::EpiFf1 E{Hb, rsl};
#ifndef NO_GFF1
            for (int rep_ = 0; rep_ < REP_GFF1; ++rep_)
            pg8::gemm_phase<pg8::EpiFf1, pg8::StaticOrder, true, true>(F.lds + RING_OFF, g, S, E);
#endif
            T.X = XB + (size_t)MP * DM; T.Wt = g.Bt; T.N = DFF; T.K = DM; T.ssq_in = ssqs + (2 * l + 1) * 4096;
            for (int rep_ = 0; rep_ < REP_THIN; ++rep_) thin_gemm<TH_FF1>(F, T);
        }
        GRID_BARK(7);
        {
            pg8::Gemm g{Hb, (const bf16*)(ws + WS_W2) + (size_t)l * DM * DFF, MP, DM, DFF}; pg8::StaticOrder S; S.init(MP, DM, G, bid);
            pg8::EpiRes E{Xp, Xs, Xp, Xs, XB, ssq + (size_t)(2 * l + 2) * MPAD * 32};
#ifndef NO_GRES
            if (REP_G3 > 1) { pg8::EpiRes E2 = E; E2.Xp = (float*)(ws + 1100 * MiB); E2.XB = (bf16*)(ws + 1170 * MiB); E2.ssq_out = (float*)(ws + 1210 * MiB);
                pg8::gemm_phase<pg8::EpiRes, pg8::StaticOrder, true, true>(F.lds + RING_OFF, g, S, E2); }
            pg8::gemm_phase<pg8::EpiRes, pg8::StaticOrder, true, true>(F.lds + RING_OFF, g, S, E);
#endif
            T.X = Hb + (size_t)MP * DFF; T.Wt = g.Bt; T.N = DM; T.K = DFF; T.R = Xs; T.ssq_out = ssqs + (2 * l + 2) * 4096;
            thin_gemm<TH_RES>(F, T);
        }
        GRID_BARK(8);
    }
#if PROBE_DET
    if (bid == 0 && opaque_tid() == 0) {
        unsigned* C = (unsigned*)(args.ws + WS_CTL) + 1024;
        const unsigned cnt = __hip_atomic_load(C, __ATOMIC_RELAXED, __HIP_MEMORY_SCOPE_AGENT), early = __hip_atomic_load(C + 1, __ATOMIC_RELAXED, __HIP_MEMORY_SCOPE_AGENT), mask = __hip_atomic_load(C + 2, __ATOMIC_RELAXED, __HIP_MEMORY_SCOPE_AGENT);
        if (cnt) {
            const size_t offs[16] = {O_YP, O_YS, O_PK, O_PV, O_PSR, O_PSI, O_PD, O_PC, O_PCV, O_SK, O_SV, O_SSR, O_SSI, O_SD, O_SC, O_SCV};
            int idx;
            if (PROBE_DET == 1) { idx = 1; unsigned c = cnt; while (c > 1 && idx < 15) { c >>= 1; ++idx; } }
            else if (PROBE_DET == 2) idx = (int)((64u - early) >> 2);
            else idx = __builtin_popcount(mask) > 15 ? 15 : __builtin_popcount(mask);
            size_t o = O_YP; for (int i = 0; i < 16; ++i) o = (i == idx) ? offs[i] : o;
            ((float*)args.out)[o] = __builtin_nanf("");
        }
    }
#endif
}

extern "C" void kernel_launch(void* const* d_in, const int* in_sizes, int n_in, void* d_out, int out_size, void* d_ws, size_t ws_size, hipStream_t stream) {
    static int grid = 0;
    if (grid == 0) {
        if (n_in != 35 || out_size != (int)O_END || ws_size < WS_END) { fprintf(stderr, "kernel_launch: unexpected problem shape (n_in %d, out %d, ws %zu)\n", n_in, out_size, ws_size); grid = -1; return; }
        int dev = 0, cus = 0, per_cu = 0;
        if (hipGetDevice(&dev) != hipSuccess || hipDeviceGetAttribute(&cus, hipDeviceAttributeMultiprocessorCount, dev) != hipSuccess) { grid = -1; return; }
        if (hipFuncSetAttribute((const void*)hybrid_fwd, hipFuncAttributeMaxDynamicSharedMemorySize, LDS_BYTES) != hipSuccess) { grid = -1; return; }
        if (hipOccupancyMaxActiveBlocksPerMultiprocessor(&per_cu, (const void*)hybrid_fwd, NWAVES * 64, LDS_BYTES) != hipSuccess || per_cu < 1)
            fprintf(stderr, "kernel_launch: occupancy query reports %d workgroups per CU\n", per_cu);
        (void)hipGetLastError();
        grid = cus;
    }
    if (grid < 0) return;
    if (hipMemsetAsync((char*)d_ws + WS_CTL, 0, CTL_ZERO_BYTES, stream) != hipSuccess) return;
    Args a{};
    for (int i = 0; i < 35; ++i) a.in[i] = (const float*)d_in[i];
    a.out = (float*)d_out; a.ws = (unsigned char*)d_ws;
    hipLaunchKernelGGL(hybrid_fwd, dim3(grid), dim3(NWAVES * 64), LDS_BYTES, stream, a);
}
```

```cpp
#include <hip/hip_runtime.h>
#include <cstdio>
#include <cstdint>
#ifndef REP_P0
#define REP_P0 1
#endif
#ifndef REP_A
#define REP_A 1
#endif
#ifndef REP_B
#define REP_B 1
#endif
#ifndef REP_GIN
#define REP_GIN 1
#endif
#ifndef REP_GFF1
#define REP_GFF1 1
#endif
#ifndef REP_THIN
#define REP_THIN 1
#endif
#ifndef REP_BAR
#define REP_BAR 1
#endif
#ifndef REP_G3
#define REP_G3 1
#endif
#ifndef REP_DPREP
#define REP_DPREP 1
#endif
#ifndef REP_AOTH
#define REP_AOTH 1
#endif
#ifndef REP_SCAN
#define REP_SCAN 1
#endif
#ifndef REP_BOTH
#define REP_BOTH 1
#endif
#ifndef PG8_B_AUX
#define PG8_B_AUX 0
#endif
#ifndef REP_SAMP
#define REP_SAMP 1
#endif
#ifndef PROBE_MFMA2
#define PROBE_MFMA2 0
#endif
#ifndef PROBE_LDS2
#define PROBE_LDS2 0
#endif
#ifndef PROBE_LDLY
#define PROBE_LDLY 0
#endif
#ifndef PROBE_CDLY
#define PROBE_CDLY 0
#endif
#ifndef PROBE_BAR2
#define PROBE_BAR2 0
#endif
#ifndef PROBE_ODLY
#define PROBE_ODLY 0
#endif
#ifndef PROBE_GFRAG
#define PROBE_GFRAG 0
#endif
#ifndef PROBE_ENDDLY
#define PROBE_ENDDLY 0
#endif
#ifndef PROBE_VMCAP
#define PROBE_VMCAP 0
#endif
#ifndef PROBE_WT
#define PROBE_WT 0
#endif
#ifndef PROBE_DET
#define PROBE_DET 0
#endif
#ifndef PROBE_CK
#define PROBE_CK 0
#endif
#ifndef PROBE_CKMODE
#define PROBE_CKMODE 0
#endif
#ifndef PROBE_DRAIN
#define PROBE_DRAIN 0
#endif
#ifndef PROBE_BARMASK
#define PROBE_BARMASK 0
#endif
#ifndef PROBE_HS
#define PROBE_HS -1
#endif
#ifndef PROBE_V0
#define PROBE_V0 0
#endif
#ifndef PROBE_INJ_L
#define PROBE_INJ_L 0
#endif
#ifndef PROBE_INJ_K
#define PROBE_INJ_K 10
#endif
#ifndef PROBE_M0NOP
#define PROBE_M0NOP 0
#endif
#ifndef PROBE_WTE
#define PROBE_WTE 0
#endif
#ifndef PROBE_NTS
#define PROBE_NTS 0
#endif
namespace pg8 {
#define PG8_LAS __attribute__((address_space(3)))
typedef unsigned short bf16_t;
typedef short bf16x8 __attribute__((ext_vector_type(8)));
typedef float f32x4 __attribute__((ext_vector_type(4)));
typedef unsigned u32x4 __attribute__((ext_vector_type(4)));
constexpr int BM = 256, BK = 64, HALF = 128, HTB = HALF * BK * 2  , STAGE_BYTES = 8 * HTB, NXCD = 8, WGM = 8;

__host__ __device__ __forceinline__ int lds_byte(int r, int c) { const int st = (r >> 4) * 2 + (c >> 5), rr = r & 15, cc = c & 31, ob = rr * 64 + cc * 2; return st * 1024 + (ob ^ (((ob >> 9) & 1) << 5)); }
__host__ __device__ __forceinline__ void stage_rc(int b, int& R, int& C) { const int st = b / 1024, sb = b % 1024, swz = sb ^ (((sb >> 9) & 1) << 5); R = (st >> 1) * 16 + swz / 64; C = (st & 1) * 32 + (swz % 64) / 2; }
__host__ __device__ __forceinline__ int perm32(int rho) { const int n = rho >> 4, i = rho & 15; return 8 * (i >> 2) + 4 * n + (i & 3); }

struct Unit { int pm, pn, ui; };
struct Gemm { const bf16_t* A; const bf16_t* Bt; int M, N, K; };

struct StaticOrder {
    int nM, nN, nwg, G, c;
    __host__ __device__ __forceinline__ void init(int M, int N, int G_, int c_) { nM = M / BM; nN = N / BM; nwg = nM * nN; G = G_; c = c_; }
    __host__ __device__ __forceinline__ bool next(int i, Unit& u) const {
        const long L = (long)i * G + c; if (L >= nwg) return false;
        int wgid = (int)L; { const int q = nwg / NXCD, r = nwg % NXCD, xcd = wgid % NXCD, off = wgid / NXCD; wgid = (xcd < r ? xcd * (q + 1) : r * (q + 1) + (xcd - r) * q) + off; }
        const int nig = WGM * nN, gid = wgid / nig, fm = gid * WGM, gsz = (nM - fm) < WGM ? (nM - fm) : WGM;
        u.pm = fm + ((wgid % nig) % gsz); u.pn = (wgid % nig) / gsz; u.ui = i; return true;
    }
    __device__ __forceinline__ void a_ready(const Unit&) const {}
    __device__ __forceinline__ void done(const Unit&) const {}
};

struct SplitOrder {
    int G, c, L0, cnt;
    __host__ __device__ __forceinline__ void init(int G_, int c_, int L0_, int cnt_) { G = G_; c = c_; L0 = L0_; cnt = cnt_; }
    static __host__ __device__ __forceinline__ void map_grid(int L, int nM, int nN, int pn0, Unit& u) {
        const int nwg = nM * nN; int wgid = L; { const int q = nwg / NXCD, r = nwg % NXCD, xcd = wgid % NXCD, off = wgid / NXCD; wgid = (xcd < r ? xcd * (q + 1) : r * (q + 1) + (xcd - r) * q) + off; }
        const int nig = WGM * nN, gid = wgid / nig, fm = gid * WGM, gsz = (nM - fm) < WGM ? (nM - fm) : WGM;
        u.pm = fm + ((wgid % nig) % gsz); u.pn = pn0 + (wgid % nig) / gsz;
    }
    __host__ __device__ __forceinline__ bool next(int i, Unit& u) const {
        const int l = i * G + c; if (l >= cnt) return false;
        const int L = L0 + l;
        if (L < 576) map_grid(L, 32, 18, 0, u); else map_grid(L - 576, 32, 32, 18, u);
        u.ui = i; return true;
    }
    __device__ __forceinline__ void a_ready(const Unit&) const {}
    __device__ __forceinline__ void done(const Unit&) const {}
};
typedef float f32x2 __attribute__((ext_vector_type(2)));
typedef __bf16 bf16x2_t __attribute__((ext_vector_type(2)));
#if PROBE_NTS
#define PG8_ST16(p, v) __builtin_nontemporal_store((v), (p))
#else
#define PG8_ST16(p, v) (*(p) = (v))
#endif
__device__ __forceinline__ unsigned cvt_pk_bf16(float lo, float hi) { f32x2 v = {lo, hi}; bf16x2_t b = __builtin_convertvector(v, bf16x2_t); return __builtin_bit_cast(unsigned, b); }
__device__ __forceinline__ float bflo(unsigned w) { return __uint_as_float(w << 16); }
__device__ __forceinline__ float bfhi(unsigned w) { return __uint_as_float(w & 0xffff0000u); }
constexpr int MROWS = 8224;
constexpr float RMS_EPS = 1e-6f;

__device__ __forceinline__ float row_rstd(const float* P, int row) {
    const f32x4* p = (const f32x4*)(P + (size_t)row * 32); float s = 0.f;
#pragma unroll
    for (int i = 0; i < 8; ++i) { const f32x4 v = p[i]; s += (v[0] + v[1]) + (v[2] + v[3]); }
    return __builtin_amdgcn_rsqf(s * (1.0f / 2048.0f) + RMS_EPS);
}
struct EpiIn {
    static constexpr bool PERM = true, AFTER_DRAIN = false, HOOK = false;
    bf16_t* Z; float* ZAB; bf16_t* G; const PG8_LAS float* rsl;
    float* SGQ;
    static __device__ __forceinline__ float gelu_t(float x) { const float t = 1.5957691216057308f * (x + 0.044715f * x * x * x); return x * __builtin_amdgcn_rcpf(1.0f + __expf(-t)); }
    __device__ __forceinline__ void operator()(const f32x4 (&acc)[2][2][4][2], const Unit& u, int wr, int wc, int fr, int fq) const {
        const int row0 = u.pm * BM + wr * 64 + fr, colw = wc * 32 + 8 * fq;
        const bool isg = u.pn >= 5 && u.pn <= 8;
#pragma unroll
        for (int ai = 0; ai < 2; ++ai)
#pragma unroll
            for (int m = 0; m < 4; ++m) { const int row = row0 + ai * HALF + m * 16;
                const float rs = rsl[u.ui * BM + (row - u.pm * BM)];
                float sq = 0.f;
#pragma unroll
                for (int bj = 0; bj < 2; ++bj) { f32x4 v0 = acc[ai][bj][m][0] * rs, v1 = acc[ai][bj][m][1] * rs; const int col = colw + bj * HALF;
                    if (u.pn < 17) {
                        if (isg) {
#pragma unroll
                            for (int i = 0; i < 4; ++i) { v0[i] = gelu_t(v0[i]); v1[i] = gelu_t(v1[i]); }
                            sq += (v0[0] * v0[0] + v0[1] * v0[1]) + (v0[2] * v0[2] + v0[3] * v0[3]) + (v1[0] * v1[0] + v1[1] * v1[1]) + (v1[2] * v1[2] + v1[3] * v1[3]); }
                        u32x4 w; w.x = cvt_pk_bf16(v0[0], v0[1]); w.y = cvt_pk_bf16(v0[2], v0[3]); w.z = cvt_pk_bf16(v1[0], v1[1]); w.w = cvt_pk_bf16(v1[2], v1[3]);
                        PG8_ST16((u32x4*)(Z + (size_t)row * 4352 + u.pn * BM + col), w); }
                    else if (u.pn == 17) { if (col == 0) { *(f32x4*)(ZAB + (size_t)row * 8) = v0; *(f32x4*)(ZAB + (size_t)row * 8 + 4) = v1; } }
                    else { float s[8];
#pragma unroll
                        for (int i = 0; i < 4; ++i) { s[i] = fmaxf(__builtin_amdgcn_rcpf(1.0f + __expf(-v0[i])), 1e-18f); s[4 + i] = fmaxf(__builtin_amdgcn_rcpf(1.0f + __expf(-v1[i])), 1e-18f); }
                        u32x4 w; w.x = cvt_pk_bf16(s[0], s[1]); w.y = cvt_pk_bf16(s[2], s[3]); w.z = cvt_pk_bf16(s[4], s[5]); w.w = cvt_pk_bf16(s[6], s[7]);
                        PG8_ST16((u32x4*)(G + (size_t)row * 8192 + (u.pn - 18) * BM + col), w); } }
                if (u.pn == 7 || u.pn == 8) { sq += __shfl_xor(sq, 16); sq += __shfl_xor(sq, 32); if (fq == 0) SGQ[(size_t)row * 8 + (u.pn - 7) * 4 + wc] = sq; } }
    }
};
struct EpiFf1 {
    static constexpr bool PERM = true, AFTER_DRAIN = false, HOOK = false;
    bf16_t* H; const PG8_LAS float* rsl;
    __device__ __forceinline__ void operator()(const f32x4 (&acc)[2][2][4][2], const Unit& u, int wr, int wc, int fr, int fq) const {
        const int row0 = u.pm * BM + wr * 64 + fr, col0 = u.pn * BM + wc * 32 + 8 * fq;
#pragma unroll
        for (int ai = 0; ai < 2; ++ai)
#pragma unroll
            for (int m = 0; m < 4; ++m) { const int row = row0 + ai * HALF + m * 16;
                const float rs = rsl[u.ui * BM + (row - u.pm * BM)];
#pragma unroll
                for (int bj = 0; bj < 2; ++bj) { f32x4 v0 = acc[ai][bj][m][0] * rs, v1 = acc[ai][bj][m][1] * rs;
#pragma unroll
                    for (int i = 0; i < 4; ++i) { const float a = fmaxf(v0[i], 0.f), b = fmaxf(v1[i], 0.f); v0[i] = a * a; v1[i] = b * b; }
                    u32x4 w; w.x = cvt_pk_bf16(v0[0], v0[1]); w.y = cvt_pk_bf16(v0[2], v0[3]); w.z = cvt_pk_bf16(v1[0], v1[1]); w.w = cvt_pk_bf16(v1[2], v1[3]);
                    PG8_ST16((u32x4*)(H + (size_t)row * 8192 + col0 + bj * HALF), w); } }
    }
};
struct EpiRes {
    static constexpr bool PERM = true, AFTER_DRAIN = false, HOOK = false;
    const float* Rp; const float* Rs; float* Xp; float* Xs; bf16_t* XB; float* ssq_out;
    __device__ __forceinline__ void operator()(const f32x4 (&acc)[2][2][4][2], const Unit& u, int wr, int wc, int fr, int fq) const {
        const int row0 = u.pm * BM + wr * 64 + fr, col0 = u.pn * BM + wc * 32 + 8 * fq;
#pragma unroll
        for (int ai = 0; ai < 2; ++ai) {
            f32x4 res[4][2][2];
#pragma unroll
            for (int m = 0; m < 4; ++m) { const float* rp = Rp + (size_t)(row0 + ai * HALF + m * 16) * 2048 + col0;
#pragma unroll
                for (int bj = 0; bj < 2; ++bj) { res[m][bj][0] = *(const f32x4*)(rp + bj * HALF); res[m][bj][1] = *(const f32x4*)(rp + bj * HALF + 4); } }
#pragma unroll
            for (int m = 0; m < 4; ++m) { const int row = row0 + ai * HALF + m * 16; float* xp = Xp + (size_t)row * 2048 + col0; float sq = 0.f;
#pragma unroll
                for (int bj = 0; bj < 2; ++bj) {
                    const f32x4 v0 = acc[ai][bj][m][0] + res[m][bj][0], v1 = acc[ai][bj][m][1] + res[m][bj][1];
                    *(f32x4*)(xp + bj * HALF) = v0; *(f32x4*)(xp + bj * HALF + 4) = v1;
                    u32x4 w; w.x = cvt_pk_bf16(v0[0], v0[1]); w.y = cvt_pk_bf16(v0[2], v0[3]); w.z = cvt_pk_bf16(v1[0], v1[1]); w.w = cvt_pk_bf16(v1[2], v1[3]);
                    PG8_ST16((u32x4*)(XB + (size_t)row * 2048 + col0 + bj * HALF), w);
                    sq += (v0[0] * v0[0] + v0[1] * v0[1]) + (v0[2] * v0[2] + v0[3] * v0[3]) + (v1[0] * v1[0] + v1[1] * v1[1]) + (v1[2] * v1[2] + v1[3] * v1[3]); }
                sq += __shfl_xor(sq, 16); sq += __shfl_xor(sq, 32);
                if (fq == 0) ssq_out[(size_t)row * 32 + u.pn * 4 + wc] = sq; }
            asm volatile("" ::: "memory"); }
    }
};
struct EpiGate {
    static constexpr bool PERM = true, AFTER_DRAIN = false, HOOK = true;
    const bf16_t* G; bf16_t* GS;
    __device__ __forceinline__ void hook(f32x4 (&acc)[2][2][4][2], const Unit& u, int bidx, int wr, int wc, int fr, int fq) const {
        const bf16_t* gp0 = G + (size_t)(u.pm * BM + wr * 64 + fr) * 8192 + (size_t)(bidx - 1) * 2048 + u.pn * BM + wc * 32 + 8 * fq;
#pragma unroll
        for (int ai = 0; ai < 2; ++ai)
#pragma unroll
            for (int m = 0; m < 4; ++m)
#pragma unroll
                for (int bj = 0; bj < 2; ++bj) { const bf16_t* gp = gp0 + (size_t)(ai * HALF + m * 16) * 8192 + bj * HALF;
                    const u32x4 ga = *(const u32x4*)gp, gb = *(const u32x4*)(gp + 2048);
                    acc[ai][bj][m][0][0] *= bflo(ga.x) * __builtin_amdgcn_rcpf(bflo(gb.x)); acc[ai][bj][m][0][1] *= bfhi(ga.x) * __builtin_amdgcn_rcpf(bfhi(gb.x));
                    acc[ai][bj][m][0][2] *= bflo(ga.y) * __builtin_amdgcn_rcpf(bflo(gb.y)); acc[ai][bj][m][0][3] *= bfhi(ga.y) * __builtin_amdgcn_rcpf(bfhi(gb.y));
                    acc[ai][bj][m][1][0] *= bflo(ga.z) * __builtin_amdgcn_rcpf(bflo(gb.z)); acc[ai][bj][m][1][1] *= bfhi(ga.z) * __builtin_amdgcn_rcpf(bfhi(gb.z));
                    acc[ai][bj][m][1][2] *= bflo(ga.w) * __builtin_amdgcn_rcpf(bflo(gb.w)); acc[ai][bj][m][1][3] *= bfhi(ga.w) * __builtin_amdgcn_rcpf(bfhi(gb.w));
                    if (bj == 1 && m == 3) asm volatile("" ::: "memory"); }
        asm volatile("s_waitcnt vmcnt(0)" ::: "memory");
    }
    __device__ __forceinline__ void operator()(const f32x4 (&acc)[2][2][4][2], const Unit& u, int wr, int wc, int fr, int fq) const {
        const int row0 = u.pm * BM + wr * 64 + fr, col0 = u.pn * BM + wc * 32 + 8 * fq;
#pragma unroll
        for (int ai = 0; ai < 2; ++ai) { u32x4 g[4][2];
#pragma unroll
            for (int m = 0; m < 4; ++m)
#pragma unroll
                for (int bj = 0; bj < 2; ++bj) g[m][bj] = *(const u32x4*)(G + (size_t)(row0 + ai * HALF + m * 16) * 8192 + 3 * 2048 + col0 + bj * HALF);
#pragma unroll
            for (int m = 0; m < 4; ++m)
#pragma unroll
                for (int bj = 0; bj < 2; ++bj) { const f32x4 a0 = acc[ai][bj][m][0], a1 = acc[ai][bj][m][1]; const u32x4 gg = g[m][bj];
                    u32x4 w; w.x = cvt_pk_bf16(a0[0] * bflo(gg.x), a0[1] * bfhi(gg.x)); w.y = cvt_pk_bf16(a0[2] * bflo(gg.y), a0[3] * bfhi(gg.y));
                    w.z = cvt_pk_bf16(a1[0] * bflo(gg.z), a1[1] * bfhi(gg.z)); w.w = cvt_pk_bf16(a1[2] * bflo(gg.w), a1[3] * bfhi(gg.w));
                    PG8_ST16((u32x4*)(GS + (size_t)(row0 + ai * HALF + m * 16) * 2048 + col0 + bj * HALF), w); }
            asm volatile("" ::: "memory"); }
    }
};
template <class Epi, class Sched, bool ALIGN_EPI = false, bool SP2 = false>
__device__ __forceinline__ void gemm_phase(PG8_LAS unsigned char* lds, const Gemm g, const Sched& S, const Epi& E) {
    int tid_ = threadIdx.x; asm volatile("" : "+v"(tid_));
    const int tid = tid_, wid = __builtin_amdgcn_readfirstlane(tid >> 6), lane = tid & 63, wr = wid >> 2, wc = wid & 3, fr = lane & 15, fq = lane >> 4;
    const int K = g.K, nt = K / BK;
    unsigned voffA[2], voffB[2];
#pragma unroll
    for (int i = 0; i < 2; ++i) { int R, C; stage_rc(tid * 16 + i * 8192, R, C); const int Rb = Epi::PERM ? ((R & ~31) + perm32(R & 31)) : R;
        voffA[i] = (unsigned)(R * K + C) * 2u; voffB[i] = (unsigned)(Rb * K + C) * 2u; }
    const size_t kstep = (size_t)(BK * 2);
    const size_t hstep = (size_t)HALF * K * 2;
    const size_t tstep = 2 * hstep;
    const unsigned ldsw = (unsigned)wid * 1024u;
    const int aoff = lds_byte(wr * 64 + fr, fq * 8), boff = lds_byte(wc * 32 + fr, fq * 8);
#define PG8_SA(b, h) (((b) * 2 + (h)) * HTB)
#define PG8_SB(b, h) ((4 + (b) * 2 + (h)) * HTB)
#if PROBE_M0NOP
#define PG8_STAGE(bufoff, gbase, voff) do { _Pragma("unroll") for (int _i = 0; _i < 2; ++_i) { const unsigned la_ = (unsigned)(unsigned long)(lds + (bufoff) + ldsw + _i * 8192); const char* gb_ = (const char*)(gbase); \
        asm volatile("s_mov_b32 m0, %0\n\ts_nop 4\n\tglobal_load_lds_dwordx4 %1, %2" :: "s"(la_), "v"((voff)[_i]), "s"(gb_) : "memory", "m0"); } } while (0)
#define PG8_STAGEB(bufoff, gbase, voff) PG8_STAGE(bufoff, gbase, voff)
#else
#define PG8_STAGE(bufoff, gbase, voff) do { _Pragma("unroll") for (int _i = 0; _i < 2; ++_i) \
        __builtin_amdgcn_global_load_lds((const unsigned*)((const char*)(gbase) + (voff)[_i]), (PG8_LAS unsigned*)(lds + (bufoff) + ldsw + _i * 8192), 16, 0, 0); } while (0)
#define PG8_STAGEB(bufoff, gbase, voff) do { _Pragma("unroll") for (int _i = 0; _i < 2; ++_i) \
        __builtin_amdgcn_global_load_lds((const unsigned*)((const char*)(gbase) + (voff)[_i]), (PG8_LAS unsigned*)(lds + (bufoff) + ldsw + _i * 8192), 16, 0, PG8_B_AUX); } while (0)
#endif
#define PG8_LDA(dst, b, h) do { _Pragma("unroll") for (int m = 0; m < 4; ++m) _Pragma("unroll") for (int k = 0; k < 2; ++k) dst[m][k] = *(const PG8_LAS bf16x8*)(lds + PG8_SA(b, h) + aoff + m * 2048 + k * 1024); } while (0)
#define PG8_LDB(dst, b, h) do { _Pragma("unroll") for (int n = 0; n < 2; ++n) _Pragma("unroll") for (int k = 0; k < 2; ++k) dst[n][k] = *(const PG8_LAS bf16x8*)(lds + PG8_SB(b, h) + boff + n * 2048 + k * 1024); } while (0)
#define PG8_MMA(ai, bj, At, Bt) do { __builtin_amdgcn_s_setprio(1); _Pragma("unroll") for (int m = 0; m < 4; ++m) _Pragma("unroll") for (int n = 0; n < 2; ++n) _Pragma("unroll") for (int k = 0; k < 2; ++k) \
        acc[ai][bj][m][n] = __builtin_amdgcn_mfma_f32_16x16x32_bf16(Bt[n][k], At[m][k], acc[ai][bj][m][n], 0, 0, 0); __builtin_amdgcn_s_setprio(0); } while (0)
#if PROBE_V0
#define PG8_WAIT_V(n) asm volatile("s_waitcnt vmcnt(0)" ::: "memory")
#else
#define PG8_WAIT_V(n) asm volatile("s_waitcnt vmcnt(" #n ")" ::: "memory")
#endif
#define PG8_WAIT_L(n) asm volatile("s_waitcnt lgkmcnt(" #n ")" ::: "memory")
#define PG8_BAR __builtin_amdgcn_s_barrier()
#define PG8_SCHED __builtin_amdgcn_sched_barrier(0)
    Unit cur, nxt; int ui = 0;
    if (!S.next(0, cur)) return;
    f32x4 acc[2][2][4][2];
#pragma unroll
    for (int a = 0; a < 2; ++a)
#pragma unroll
        for (int b = 0; b < 2; ++b)
#pragma unroll
            for (int m = 0; m < 4; ++m)
#pragma unroll
                for (int n = 0; n < 2; ++n) acc[a][b][m][n] = (f32x4){0.f, 0.f, 0.f, 0.f};
    bf16x8 At[4][2], B0[2][2], B1[2][2];
    const char* cA = (const char*)g.A + (size_t)cur.pm * tstep; const char* cB = (const char*)g.Bt + (size_t)cur.pn * tstep;
    S.a_ready(cur);
    if constexpr (SP2) {
        PG8_STAGEB(PG8_SB(0, 0), cB, voffB); PG8_STAGEB(PG8_SB(0, 1), cB + hstep, voffB); PG8_STAGE(PG8_SA(0, 0), cA, voffA); PG8_STAGE(PG8_SA(0, 1), cA + hstep, voffA);
        if (wr == 1) PG8_BAR;
        PG8_WAIT_V(2); PG8_BAR;
        PG8_STAGEB(PG8_SB(1, 0), cB + kstep, voffB); PG8_STAGE(PG8_SA(1, 0), cA + kstep, voffA); PG8_STAGEB(PG8_SB(1, 1), cB + hstep + kstep, voffB);
        PG8_WAIT_V(6); PG8_BAR;
    } else {
        PG8_STAGEB(PG8_SB(0, 0), cB, voffB); PG8_STAGE(PG8_SA(0, 0), cA, voffA); PG8_STAGEB(PG8_SB(0, 1), cB + hstep, voffB); PG8_STAGE(PG8_SA(0, 1), cA + hstep, voffA);
        if (wr == 1) PG8_BAR;
        PG8_WAIT_V(4); PG8_BAR;
        PG8_STAGEB(PG8_SB(1, 0), cB + kstep, voffB); PG8_STAGE(PG8_SA(1, 0), cA + kstep, voffA); PG8_STAGEB(PG8_SB(1, 1), cB + hstep + kstep, voffB);
        PG8_WAIT_V(6); PG8_BAR;
    }
    for (;;) {
        const bool has_next = S.next(ui + 1, nxt);
        const char* nA = has_next ? (const char*)g.A + (size_t)nxt.pm * tstep : cA; const char* nB = has_next ? (const char*)g.Bt + (size_t)nxt.pn * tstep : cB;
        for (int t = 0; t < nt; t += 2) {
            const bool last = (t == nt - 2);
            const char* a1 = cA + (size_t)(t + 1) * kstep;
            const char* a2 = last ? nA : cA + (size_t)(t + 2) * kstep; const char* b2 = last ? nB : cB + (size_t)(t + 2) * kstep;
            const char* a3 = a2 + kstep; const char* b3 = b2 + kstep;
            if (last && has_next) S.a_ready(nxt);
            if constexpr (SP2) {
            PG8_LDB(B0, 0, 0); PG8_LDB(B1, 0, 1); PG8_SCHED; PG8_LDA(At, 0, 0); PG8_STAGE(PG8_SA(1, 1), a1 + hstep, voffA);
            PG8_WAIT_V(8); PG8_WAIT_L(0); PG8_BAR; PG8_MMA(0, 0, At, B0); PG8_MMA(0, 1, At, B1); PG8_BAR; PG8_SCHED;
            PG8_LDA(At, 0, 1); PG8_STAGEB(PG8_SB(0, 0), b2, voffB); PG8_STAGEB(PG8_SB(0, 1), b2 + hstep, voffB); PG8_STAGE(PG8_SA(0, 0), a2, voffA);
            PG8_WAIT_V(8); PG8_WAIT_L(0); PG8_BAR; PG8_MMA(1, 0, At, B0); PG8_MMA(1, 1, At, B1); PG8_BAR; PG8_SCHED;
            PG8_LDB(B0, 1, 0); PG8_LDB(B1, 1, 1); PG8_SCHED; PG8_LDA(At, 1, 0); PG8_STAGE(PG8_SA(0, 1), a2 + hstep, voffA);
            PG8_WAIT_V(8); PG8_WAIT_L(0); PG8_BAR; PG8_MMA(0, 0, At, B0); PG8_MMA(0, 1, At, B1); PG8_BAR; PG8_SCHED;
            PG8_LDA(At, 1, 1); PG8_STAGEB(PG8_SB(1, 0), b3, voffB); PG8_STAGEB(PG8_SB(1, 1), b3 + hstep, voffB); PG8_STAGE(PG8_SA(1, 0), a3, voffA);
            PG8_WAIT_V(8); PG8_WAIT_L(0); PG8_BAR; PG8_MMA(1, 0, At, B0); PG8_MMA(1, 1, At, B1); PG8_BAR; PG8_SCHED;
            } else {
            PG8_LDB(B0, 0, 0); PG8_SCHED; PG8_LDA(At, 0, 0); PG8_STAGE(PG8_SA(1, 1), a1 + hstep, voffA);
            PG8_WAIT_L(8); PG8_BAR; PG8_WAIT_L(0); PG8_MMA(0, 0, At, B0); PG8_BAR; PG8_SCHED;
            PG8_LDB(B1, 0, 1); PG8_STAGEB(PG8_SB(0, 0), b2, voffB);
            PG8_BAR; PG8_WAIT_L(0); PG8_MMA(0, 1, At, B1); PG8_BAR;
            PG8_LDA(At, 0, 1); PG8_STAGE(PG8_SA(0, 0), a2, voffA);
            PG8_BAR; PG8_WAIT_L(0); PG8_MMA(1, 0, At, B0); PG8_BAR; PG8_SCHED;
            PG8_STAGEB(PG8_SB(0, 1), b2 + hstep, voffB);
            PG8_WAIT_V(6); PG8_BAR; PG8_MMA(1, 1, At, B1); PG8_BAR;
            PG8_LDB(B0, 1, 0); PG8_SCHED; PG8_LDA(At, 1, 0); PG8_STAGE(PG8_SA(0, 1), a2 + hstep, voffA);
            PG8_WAIT_L(8); PG8_BAR; PG8_WAIT_L(0); PG8_MMA(0, 0, At, B0); PG8_BAR; PG8_SCHED;
            PG8_LDB(B1, 1, 1); PG8_STAGEB(PG8_SB(1, 0), b3, voffB);
            PG8_BAR; PG8_WAIT_L(0); PG8_MMA(0, 1, At, B1); PG8_BAR;
            PG8_LDA(At, 1, 1); PG8_STAGE(PG8_SA(1, 0), a3, voffA);
            PG8_BAR; PG8_WAIT_L(0); PG8_MMA(1, 0, At, B0); PG8_BAR; PG8_SCHED;
            PG8_STAGEB(PG8_SB(1, 1), b3 + hstep, voffB);
            PG8_WAIT_V(6); PG8_BAR; PG8_MMA(1, 1, At, B1); PG8_BAR;
            }
            if constexpr (Epi::HOOK) { if ((((t + 2) & 7) == 0) && !last) { E.hook(acc, cur, (t + 2) >> 3, wr, wc, fr, fq); PG8_SCHED; } }
        }
        if constexpr (ALIGN_EPI) { if (wr == 0) PG8_BAR; }
        if constexpr (!Epi::AFTER_DRAIN) { E(acc, cur, wr, wc, fr, fq); S.done(cur); }
        if (!has_next) break;
#pragma unroll
        for (int a = 0; a < 2; ++a)
#pragma unroll
            for (int b = 0; b < 2; ++b)
#pragma unroll
                for (int m = 0; m < 4; ++m)
#pragma unroll
                    for (int n = 0; n < 2; ++n) acc[a][b][m][n] = (f32x4){0.f, 0.f, 0.f, 0.f};
        cur = nxt; cA = nA; cB = nB; ++ui;
        if constexpr (ALIGN_EPI) { if (wr == 1) PG8_BAR; }
    }
    PG8_WAIT_V(0);
    if constexpr (!ALIGN_EPI) { if (wr == 0) PG8_BAR; }
    PG8_BAR;
    if constexpr (Epi::AFTER_DRAIN) { E.fused(acc, cur, wr, wc, fr, fq, lds, wid, lane); S.done(cur); }
#undef PG8_SA
#undef PG8_SB
#undef PG8_STAGE
#undef PG8_STAGEB
#undef PG8_LDA
#undef PG8_LDB
#undef PG8_MMA
#undef PG8_WAIT_V
#undef PG8_WAIT_L
#undef PG8_BAR
#undef PG8_SCHED
}
}
constexpr int NWAVES = 8;
constexpr int DM = 2048, SEQ = 4096, NB = 2, MP = NB * SEQ  , NS = 32  , MPAD = 8448, DEPTH = 4, DFF = 8192;
constexpr int NIN = 12552, NINP = 12800, ZW = 4352, GW = 8192, PASTLEN = 16384;
constexpr int ZC_Q = 0, ZC_K = 512, ZC_V = 640, ZC_SU = 768, ZC_GU = 1280, ZC_GV = 1792, ZC_DQ = 2304, ZC_DK = 2816, ZC_DV = 3328, ZC_DG = 3840;
constexpr float LOG2E = 1.4426950408889634f;

constexpr size_t MiB = 1u << 20;
constexpr size_t WS_CTL = 0, CTL_ZERO_BYTES = 1 * MiB;
constexpr size_t WS_ROPE = 1 * MiB;
constexpr size_t WS_ABAR = 3 * MiB;
constexpr size_t WS_A32 = WS_ABAR + 65536;
constexpr size_t WS_CFRAG = WS_ABAR + 131072;
constexpr size_t WS_BBAR = 4 * MiB;
constexpr size_t WS_WTRIL = 5 * MiB;
constexpr size_t WS_WG = 6 * MiB;
constexpr size_t WS_E = 8 * MiB;
constexpr size_t WS_ZAB = 12 * MiB;
constexpr size_t WS_GE = 13 * MiB;
constexpr size_t WS_WIN = 16 * MiB;
constexpr size_t WS_WB = 216 * MiB;
constexpr size_t WS_WO = 248 * MiB;
constexpr size_t WS_W1 = 280 * MiB;
constexpr size_t WS_W2 = 408 * MiB;
constexpr size_t WS_XB = 536 * MiB;
constexpr size_t WS_Z = 570 * MiB;
constexpr size_t WS_G = 642 * MiB;
constexpr size_t WS_YCAT = 774 * MiB;
constexpr size_t WS_GS = 808 * MiB;
constexpr size_t WS_H = 842 * MiB;
constexpr size_t WS_OD = 974 * MiB;
constexpr size_t WS_U0 = 990 * MiB;
constexpr size_t WS_WN = 1006 * MiB;
constexpr size_t WS_QG = 1014 * MiB;
constexpr size_t WS_QK = 1022 * MiB;
constexpr size_t WS_KE = 1026 * MiB;
constexpr size_t WS_SSQP = 1034 * MiB;
constexpr size_t WS_SSQS = 1046 * MiB;
constexpr size_t WS_SGQ = 1047 * MiB;
constexpr size_t WS_BFRAG = 1048 * MiB;
constexpr size_t WS_BU = 1049 * MiB;
constexpr size_t WS_END = 1113 * MiB;
constexpr int CW_TMO = 0;
constexpr int CW_QUEUE = 2048;
constexpr int CW_BAR = 4096;

constexpr size_t O_YP = 0, O_YS = 16777216, O_PK = O_YS + 65536, O_PV = O_PK + 131072, O_PSR = O_PV + 131072, O_PSI = O_PSR + 16384, O_PD = O_PSI + 16384,
                 O_PC = O_PD + 524288, O_PCV = O_PC + 36864, O_SK = O_PCV + 524288, O_SV = O_SK + 2097152, O_SSR = O_SV + 2097152, O_SSI = O_SSR + 262144,
                 O_SD = O_SSI + 262144, O_SC = O_SD + 8388608, O_SCV = O_SC + 589824, O_END = O_SCV + 65536;

constexpr int RING_OFF = 0, RING_BYTES = 131072;
constexpr int LDSCTL_OFF = 147456, MISC_OFF = LDSCTL_OFF + 320;
constexpr int LDS_BYTES = 148480;
static_assert(MISC_OFF + 128 <= LDS_BYTES, "LDS map");

#define GAS __attribute__((address_space(1)))
#define LAS __attribute__((address_space(3)))
typedef unsigned short bf16;
typedef unsigned v4u __attribute__((ext_vector_type(4)));
typedef float f32x4 __attribute__((ext_vector_type(4)));
typedef short bf16x8 __attribute__((ext_vector_type(8)));
typedef GAS unsigned gu32;
typedef GAS unsigned long long gu64;
#define RLX_AGENT __ATOMIC_RELAXED, __HIP_MEMORY_SCOPE_AGENT
#define LDS_WAIT() asm volatile("s_waitcnt lgkmcnt(0)" ::: "memory")
#define VM_WAIT() asm volatile("s_waitcnt vmcnt(0)" ::: "memory")
__device__ __forceinline__ unsigned long long rt() { return __builtin_amdgcn_s_memrealtime(); }
__device__ __forceinline__ unsigned f2bf(float f) { unsigned u = __builtin_bit_cast(unsigned, f); return (u + 0x7fffu + ((u >> 16) & 1u)) >> 16; }
__device__ __forceinline__ unsigned pk2(float lo, float hi) { return f2bf(lo) | (f2bf(hi) << 16); }

#define XB_TMO      128
#define XB_XCNT(j)  (256  + 64 * (j))
#define XB_XSUB(j)  (1280 + 64 * (j))
#define XB_XGEN(j)  (2304 + 64 * (j))
#define XB_TOP      3328
#define XB_TOPGEN   3392
#define XCD_BAR_WORDS 3456
#define XB_SPIN_CAP (1u << 18)

__device__ __forceinline__ unsigned xb_ld(unsigned* p)              { return __hip_atomic_load(p, __ATOMIC_RELAXED, __HIP_MEMORY_SCOPE_AGENT); }
__device__ __forceinline__ unsigned xb_add(unsigned* p, unsigned v) { return __hip_atomic_fetch_add(p, v, __ATOMIC_RELAXED, __HIP_MEMORY_SCOPE_AGENT); }
__device__ __forceinline__ unsigned xb_xcc_id() { return (unsigned)__builtin_amdgcn_s_getreg((3 << 11) | 20) & 0xFu; }
#define XB_SPIN(cond, bar) do { unsigned _sp = 0; while (cond) { __builtin_amdgcn_s_sleep(1); \
    if ((++_sp & 255u) == 0u) { if (xb_ld(&(bar)[XB_TMO])) break; if (_sp > XB_SPIN_CAP) { atomicAdd(&(bar)[XB_TMO], 1u); break; } } } } while (0)

struct XcdBarrier {
    unsigned* bar; unsigned x;
    volatile LAS unsigned* st;
};

__device__ __forceinline__ XcdBarrier xcd_barrier_post(unsigned* bar, volatile LAS unsigned* st) {
    XcdBarrier b; b.bar = bar; b.x = xb_xcc_id(); b.st = st;
    if (threadIdx.x == 0) (void)xb_add(&bar[XB_XCNT(b.x)], 1u);
    return b;
}
__device__ __forceinline__ void xcd_barrier_complete(unsigned* bar, unsigned x, unsigned& nloc, unsigned& nx) {
    const unsigned G = gridDim.x * gridDim.y * gridDim.z;
    unsigned sum, cnt, mine, sp = 0u;
    for (;;) {
        sum = 0u; cnt = 0u; mine = 0u;
#pragma unroll
        for (unsigned j = 0; j < 16; ++j) { const unsigned c = xb_ld(&bar[XB_XCNT(j)]); sum += c; cnt += (c > 0u) ? 1u : 0u; mine = (j == x) ? c : mine; }
        if (sum == G) break;
        __builtin_amdgcn_s_sleep(1);
        if ((++sp & 255u) == 0u) { if (xb_ld(&bar[XB_TMO])) break; if (sp > XB_SPIN_CAP) { atomicAdd(&bar[XB_TMO], 1u); break; } }
    }
    nloc = mine > 0u ? mine : 1u; nx = cnt > 0u ? cnt : 1u;
}

__device__ __forceinline__ void xcd_barrier(const XcdBarrier& b) {
    asm volatile("s_waitcnt vmcnt(0)" ::: "memory");
    __syncthreads();
    if (threadIdx.x == 0) {
        unsigned* bar = b.bar;
        __builtin_amdgcn_s_waitcnt(0);
        unsigned nloc = b.st[0], nx = b.st[1];
        if (nloc == 0u) { xcd_barrier_complete(bar, b.x, nloc, nx); b.st[0] = nloc; b.st[1] = nx; }
        const unsigned old = xb_add(&bar[XB_XSUB(b.x)], 1u);
        const unsigned gen = old / nloc;
        if (old + 1u == (gen + 1u) * nloc) {
            __builtin_amdgcn_fence(__ATOMIC_RELEASE, "agent");
            asm volatile("s_waitcnt vmcnt(0)" ::: "memory");
            const unsigned og = xb_add(&bar[XB_TOP], 1u);
            const unsigned tg = og / nx;
            if (og + 1u == (tg + 1u) * nx) xb_add(&bar[XB_TOPGEN], 1u);
            else XB_SPIN(xb_ld(&bar[XB_TOPGEN]) == tg, bar);
            __builtin_amdgcn_fence(__ATOMIC_ACQUIRE, "agent");
            xb_add(&bar[XB_XGEN(b.x)], 1u);
            asm volatile("s_waitcnt vmcnt(0)" ::: "memory");
        } else {
            XB_SPIN(xb_ld(&bar[XB_XGEN(b.x)]) == gen, bar);
            __builtin_amdgcn_fence(__ATOMIC_ACQUIRE, "agent");
            asm volatile("s_waitcnt vmcnt(0)" ::: "memory");
        }
    }
    __syncthreads();
}
typedef float f32x16 __attribute__((ext_vector_type(16)));
typedef float f32x2v __attribute__((ext_vector_type(2)));
typedef unsigned v2u __attribute__((ext_vector_type(2)));
#define DI __device__ __forceinline__
#define MFMA32(a, b, c) __builtin_amdgcn_mfma_f32_32x32x16_bf16((a), (b), (c), 0, 0, 0)
#define MFMA16(a, b, c) __builtin_amdgcn_mfma_f32_16x16x32_bf16((a), (b), (c), 0, 0, 0)
DI float bf2f(unsigned short h) { return __uint_as_float((unsigned)h << 16); }
DI float bflo(unsigned w) { return __uint_as_float(w << 16); }
DI float bfhi(unsigned w) { return __uint_as_float(w & 0xffff0000u); }
DI unsigned cvtpk(float lo, float hi) { return pg8::cvt_pk_bf16(lo, hi); }
DI unsigned short cvt1(float v) { return (unsigned short)(pg8::cvt_pk_bf16(v, 0.f) & 0xffffu); }
#define CR(k) (((k) & 3) + 8 * ((k) >> 2))
DI int crow(int reg, int h) { return (reg & 3) + 8 * (reg >> 2) + 4 * h; }
DI bf16x8 pack8(float a0, float a1, float a2, float a3, float a4, float a5, float a6, float a7) {
    v4u p; p.x = cvtpk(a0, a1); p.y = cvtpk(a2, a3); p.z = cvtpk(a4, a5); p.w = cvtpk(a6, a7); return __builtin_bit_cast(bf16x8, p); }
DI bf16x8 pack_step(const f32x16& x, int s) { return s == 0 ? pack8(x[0], x[1], x[2], x[3], x[4], x[5], x[6], x[7]) : pack8(x[8], x[9], x[10], x[11], x[12], x[13], x[14], x[15]); }
DI float wave_sum(float v) {
#pragma unroll
    for (int o = 1; o < 64; o <<= 1) v += __shfl_xor(v, o);
    return v;
}
DI float wave_max(float v) {
#pragma unroll
    for (int o = 1; o < 64; o <<= 1) v = fmaxf(v, __shfl_xor(v, o));
    return v;
}
DI float gelu_tanh(float x) {
    const float t = 1.5957691216057308f * (x + 0.044715f * x * x * x);
    return x * __builtin_amdgcn_rcpf(1.0f + __expf(-t));
}
DI float sigmoidf_(float x) { return __builtin_amdgcn_rcpf(1.0f + __expf(-x)); }
DI float siluf_(float x) { return x * __builtin_amdgcn_rcpf(1.0f + __expf(-x)); }
DI float softplusf_(float x) { const float e = __expf(-fabsf(x)); const float l = e < 1e-3f ? e * (1.f - 0.5f * e) : __logf(1.f + e); return fmaxf(x, 0.f) + l; }
DI int frag_off(int row, int k, int nks) { const int rt = row >> 5, r = row & 31, ks = k >> 4, w = k & 15, h = (w >> 2) & 1, j = ((w >> 3) << 2) | (w & 3); return (((rt * nks + ks) * 64) + r + 32 * h) * 8 + j; }

DI int opaque_tid() { int t = threadIdx.x; asm volatile("" : "+v"(t)); return t; }
struct Frame {
    LAS unsigned char* lds;
    volatile LAS unsigned* MISC;
    gu32* ctl;
    unsigned char* ws;
    const float* const* in;
    int tid, lane, wave, vcu, G;
};
struct Args { const float* in[35]; float* out; unsigned char* ws;
#if PROBE_CK
    int pass;
#endif
};
enum { I_XP = 0, I_XS, I_CK, I_CV, I_SSR, I_SSI, I_SD, I_SC, I_N1G, I_WIN, I_QNG, I_KNG, I_SINK, I_LAMR, I_LAMI, I_LOGDT, I_BRE, I_BIM, I_CRE, I_CIM, I_SSMD, I_GLUW, I_GLUB,
       I_SGNG, I_SGW, I_SGB, I_CONVW, I_ALOG, I_DTB, I_DNG, I_WBR, I_WOUT, I_N2G, I_WFF1, I_WFF2 };

template <int MODE>
DI void p0_transpose_item(const float* W, int K, int Nsrc, bf16* WT, const float* gain, LAS float* scr, int kb, int nb, int lane) {
    const int k0 = 64 * kb, n0 = 32 * nb;
    const int nd = n0 + (lane & 31);
    const int ns = MODE == 1 ? (nd < 4360 ? nd : (nd < 4608 ? -1 : nd - 248)) : nd;
    float tv[32];
#pragma unroll
    for (int i = 0; i < 32; ++i) { const int kk = 2 * i + (lane >> 5); tv[i] = ns >= 0 ? W[(size_t)(k0 + kk) * Nsrc + ns] : 0.f; }
#pragma unroll
    for (int i = 0; i < 32; ++i) { const int kk = 2 * i + (lane >> 5); float v = tv[i]; if (gain) v *= gain[k0 + kk]; scr[kk * 33 + (lane & 31)] = v; }
    LDS_WAIT(); asm volatile("" ::: "memory");
    const int c = lane & 7;
#pragma unroll
    for (int j = 0; j < 4; ++j) { const int n = (lane >> 3) + 8 * j; const LAS float* s = scr + (8 * c) * 33 + n;
        v4u o; o.x = cvtpk(s[0 * 33], s[1 * 33]); o.y = cvtpk(s[2 * 33], s[3 * 33]); o.z = cvtpk(s[4 * 33], s[5 * 33]); o.w = cvtpk(s[6 * 33], s[7 * 33]);
        *(GAS v4u*)(WT + (size_t)(n0 + n) * K + k0 + 8 * c) = o; }
    LDS_WAIT(); asm volatile("" ::: "memory");
}

DI void p0_prologue(Frame& F, const Args& A) {
    LAS float* scr = (LAS float*)(F.lds + RING_OFF + F.wave * 16384);
    const int gw = F.vcu * NWAVES + F.wave, NGW = F.G * NWAVES, lane = F.lane;
    unsigned char* ws = F.ws;
    constexpr int IT_IN = 32 * 400, IT_SQ = 32 * 64, IT_W1 = 32 * 256, IT_W2 = 128 * 64, IT_GLU = 8 * 16, IT_L = IT_IN + 2 * IT_SQ + IT_W1 + IT_W2 + IT_GLU;
    for (int it = gw; it < DEPTH * IT_L; it += NGW) {
        const int l = it / IT_L; int r = it % IT_L;
        if (r < IT_IN) { p0_transpose_item<1>(A.in[I_WIN] + (size_t)l * DM * NIN, DM, NIN, (bf16*)(ws + WS_WIN) + (size_t)l * NINP * DM, A.in[I_N1G] + l * DM, scr, r / 400, r % 400, lane); continue; } r -= IT_IN;
        if (r < IT_SQ) { p0_transpose_item<0>(A.in[I_WBR] + (size_t)l * DM * DM, DM, DM, (bf16*)(ws + WS_WB) + (size_t)l * DM * DM, nullptr, scr, r / 64, r % 64, lane); continue; } r -= IT_SQ;
        if (r < IT_SQ) { p0_transpose_item<0>(A.in[I_WOUT] + (size_t)l * DM * DM, DM, DM, (bf16*)(ws + WS_WO) + (size_t)l * DM * DM, nullptr, scr, r / 64, r % 64, lane); continue; } r -= IT_SQ;
        if (r < IT_W1) { p0_transpose_item<0>(A.in[I_WFF1] + (size_t)l * DM * DFF, DM, DFF, (bf16*)(ws + WS_W1) + (size_t)l * DFF * DM, A.in[I_N2G] + l * DM, scr, r / 256, r % 256, lane); continue; } r -= IT_W1;
        if (r < IT_W2) { p0_transpose_item<0>(A.in[I_WFF2] + (size_t)l * DFF * DM, DFF, DM, (bf16*)(ws + WS_W2) + (size_t)l * DM * DFF, nullptr, scr, r / 64, r % 64, lane); continue; } r -= IT_W2;
        p0_transpose_item<0>(A.in[I_GLUW] + (size_t)l * 512 * 512, 512, 512, (bf16*)(ws + WS_WG) + (size_t)l * 512 * 512, nullptr, scr, r / 16, r % 16, lane);
    }
    float* ssq0 = (float*)(ws + WS_SSQP);
    for (int m = gw; m < MPAD; m += NGW) {
        GAS v4u* o16 = (GAS v4u*)((bf16*)(ws + WS_XB) + (size_t)m * DM) + lane;
        if (m < pg8::MROWS) {
            const float* xrow = m < MP ? A.in[I_XP] + (size_t)m * DM : A.in[I_XS] + (size_t)(m - MP) * DM;
            const GAS f32x4* xr = (const GAS f32x4*)xrow + 2 * lane;
            float s = 0.f;
#pragma unroll
            for (int j = 0; j < 4; ++j) { const f32x4 a = xr[128 * j], b = xr[128 * j + 1];
                s += (a.x * a.x + a.y * a.y) + (a.z * a.z + a.w * a.w) + (b.x * b.x + b.y * b.y) + (b.z * b.z + b.w * b.w);
                v4u o; o.x = cvtpk(a.x, a.y); o.y = cvtpk(a.z, a.w); o.z = cvtpk(b.x, b.y); o.w = cvtpk(b.z, b.w); o16[64 * j] = o; }
            s = wave_sum(s);
            if (m < MP) { if (lane < 32) ssq0[(size_t)m * 32 + lane] = lane == 0 ? s : 0.f; }
            else { float* sq = (float*)(ws + WS_SSQS) + (m - MP) * 128; sq[lane] = lane == 0 ? s : 0.f; sq[64 + lane] = 0.f; }
        } else {
#pragma unroll
            for (int j = 0; j < 4; ++j) o16[64 * j] = (v4u){0u, 0u, 0u, 0u};
            if (lane < 32) ssq0[(size_t)m * 32 + lane] = 0.f;
        }
    }
    const int gt = gw * 64 + lane, NGT = NGW * 64;
    {
        float* ct = (float*)(ws + WS_ROPE); float* st = ct + 4097 * 32;
        for (int e = gt; e < 4097 * 32; e += NGT) { const int p = e >> 5, i = e & 31; const double pos = p < 4096 ? (double)p : (double)PASTLEN;
            const float invf = powf(10000.0f, -(float)i / 32.0f); const float angf = (float)pos * invf;
            const double ang = (double)angf; const double n = rint(ang * 0.15915494309189535); const double r = ang - n * 6.283185307179586;
            ct[e] = cosf((float)r); st[e] = sinf((float)r); }
    }
    {
        f32x2v* abar = (f32x2v*)(ws + WS_ABAR); f32x2v* a32 = (f32x2v*)(ws + WS_A32); f32x2v* bbar = (f32x2v*)(ws + WS_BBAR);
        for (int e = gt; e < DEPTH * 32 * 64; e += NGT) { const int lg = e >> 6;
            const float lr = A.in[I_LAMR][e], li = A.in[I_LAMI][e], dt = expf(A.in[I_LOGDT][lg]);
            const float mag = expf(lr * dt), ar = mag * cosf(li * dt), ai = mag * sinf(li * dt);
            abar[e] = (f32x2v){ar, ai};
            const float m32 = expf(lr * dt * 32.f); a32[e] = (f32x2v){m32 * cosf(li * dt * 32.f), m32 * sinf(li * dt * 32.f)};
            const float nr = ar - 1.f, ni = ai, den = 1.f / (lr * lr + li * li); const float qr = (nr * lr + ni * li) * den, qi = (ni * lr - nr * li) * den;
            for (int c = 0; c < 16; ++c) { const float br = A.in[I_BRE][(size_t)e * 16 + c], bi = A.in[I_BIM][(size_t)e * 16 + c]; bbar[(size_t)e * 16 + c] = (f32x2v){qr * br - qi * bi, qr * bi + qi * br}; }
        }
        bf16* bfr = (bf16*)(ws + WS_BFRAG);
        for (int e = gt; e < DEPTH * 32 * 4 * 64 * 8; e += NGT) { const int j = e & 7, ln = (e >> 3) & 63, tile = (e >> 9) & 3, lg = e >> 11;
            const int pst = 32 * (tile >> 1) + (ln & 31), c = 8 * (ln >> 5) + j; const size_t src = ((size_t)lg * 64 + pst) * 16 + c;
            const float lr = A.in[I_LAMR][lg * 64 + pst], li = A.in[I_LAMI][lg * 64 + pst], dt = expf(A.in[I_LOGDT][lg]);
            const float mag = expf(lr * dt), ar = mag * cosf(li * dt), ai = mag * sinf(li * dt);
            const float nr = ar - 1.f, ni = ai, den = 1.f / (lr * lr + li * li); const float qr = (nr * lr + ni * li) * den, qi = (ni * lr - nr * li) * den;
            const float br = A.in[I_BRE][src], bi = A.in[I_BIM][src];
            bfr[e] = cvt1((tile & 1) ? qr * bi + qi * br : qr * br - qi * bi); }
        bf16* cf = (bf16*)(ws + WS_CFRAG);
        for (int e = gt; e < DEPTH * 32 * 4 * 64 * 8; e += NGT) { const int j = e & 7, ln = (e >> 3) & 63, kb = (e >> 9) & 3, lg = e >> 11;
            const int k = 32 * kb + 8 * (ln >> 4) + j, c = ln & 15, p = k >> 1;
            const float v = (k & 1) ? -A.in[I_CIM][((size_t)lg * 16 + c) * 64 + p] : A.in[I_CRE][((size_t)lg * 16 + c) * 64 + p];
            cf[e] = cvt1(v); }
    }
    {
        bf16* wt = (bf16*)(ws + WS_WTRIL);
        for (int e = gt; e < DEPTH * 4 * 128 * 128; e += NGT) { const int s = e & 127, t = (e >> 7) & 127; wt[e] = s <= t ? cvt1(A.in[I_SGW][e]) : (bf16)0; }
    }
}

#if PROBE_CK
DI void p0_xonly(Frame& F, const Args& A) {
    const int gw = F.vcu * NWAVES + F.wave, NGW = F.G * NWAVES, lane = opaque_tid() & 63;
    unsigned char* ws = F.ws;
    float* ssq0 = (float*)(ws + WS_SSQP);
    for (int m = gw; m < MPAD; m += NGW) {
        GAS v4u* o16 = (GAS v4u*)((bf16*)(ws + WS_XB) + (size_t)m * DM) + lane;
        if (m < pg8::MROWS) {
            const float* xrow = m < MP ? A.in[I_XP] + (size_t)m * DM : A.in[I_XS] + (size_t)(m - MP) * DM;
            const GAS f32x4* xr = (const GAS f32x4*)xrow + 2 * lane;
            float s = 0.f;
#pragma unroll
            for (int j = 0; j < 4; ++j) { const f32x4 a = xr[128 * j], b = xr[128 * j + 1];
                s += (a.x * a.x + a.y * a.y) + (a.z * a.z + a.w * a.w) + (b.x * b.x + b.y * b.y) + (b.z * b.z + b.w * b.w);
                v4u o; o.x = cvtpk(a.x, a.y); o.y = cvtpk(a.z, a.w); o.z = cvtpk(b.x, b.y); o.w = cvtpk(b.z, b.w); o16[64 * j] = o; }
            s = wave_sum(s);
            if (m < MP) { if (lane < 32) ssq0[(size_t)m * 32 + lane] = lane == 0 ? s : 0.f; }
            else { float* sq = (float*)(ws + WS_SSQS) + (m - MP) * 128; sq[lane] = lane == 0 ? s : 0.f; sq[64 + lane] = 0.f; }
        } else {
#pragma unroll
            for (int j = 0; j < 4; ++j) o16[64 * j] = (v4u){0u, 0u, 0u, 0u};
            if (lane < 32) ssq0[(size_t)m * 32 + lane] = 0.f;
        }
    }
}
#endif
struct Lyr {
    int l;
    const bf16* Z; const float* ZAB; bf16* YC;
    const float* cosT; const float* sinT;
    const Args* A; float* out; unsigned char* ws;
};

DI void attn_item(Frame& F, const Lyr& L, int item) {
    const int b = item >> 6, kvh = (item >> 5) & 1, blk = item & 31, tid = opaque_tid(), l = L.l;
    LAS bf16* Ks = (LAS bf16*)(F.lds); LAS bf16* VT = (LAS bf16*)(F.lds + 36864);
    {
        const int kap = tid & 255, tk = blk * 128 - 128 + kap;
        if (tid < 256) {
            if (tk >= 0) {
                const GAS v4u* src = (const GAS v4u*)(L.Z + (size_t)(b * SEQ + tk) * ZW + ZC_K + kvh * 64);
                float x[64]; float ss = 0.f;
#pragma unroll
                for (int i = 0; i < 8; ++i) { const v4u w = src[i]; x[8 * i] = bflo(w.x); x[8 * i + 1] = bfhi(w.x); x[8 * i + 2] = bflo(w.y); x[8 * i + 3] = bfhi(w.y); x[8 * i + 4] = bflo(w.z); x[8 * i + 5] = bfhi(w.z); x[8 * i + 6] = bflo(w.w); x[8 * i + 7] = bfhi(w.w); }
#pragma unroll
                for (int i = 0; i < 64; ++i) ss += x[i] * x[i];
                const float rs = __builtin_amdgcn_rsqf(ss * (1.f / 64.f) + pg8::RMS_EPS);
                const float* kg = L.A->in[I_KNG] + l * 64;
                const bool wr = blk == 31 && kap >= 128;
                GAS float* pk = (GAS float*)(L.out + O_PK + ((size_t)((l * NB + b) * 128 + (kap - 128)) * 2 + kvh) * 64);
                const GAS f32x4* ct = (const GAS f32x4*)(L.cosT + tk * 32); const GAS f32x4* st4 = (const GAS f32x4*)(L.sinT + tk * 32);
#pragma unroll
                for (int i4 = 0; i4 < 8; ++i4) { const f32x4 c = ct[i4], s = st4[i4]; float lo[4], hi[4];
#pragma unroll
                    for (int q = 0; q < 4; ++q) { const int i = 4 * i4 + q; const float x1 = x[i] * rs * kg[i], x2 = x[i + 32] * rs * kg[i + 32]; lo[q] = x1 * c[q] - x2 * s[q]; hi[q] = x2 * c[q] + x1 * s[q]; }
                    *(LAS v2u*)(Ks + kap * 72 + 4 * i4) = (v2u){cvtpk(lo[0], lo[1]), cvtpk(lo[2], lo[3])}; *(LAS v2u*)(Ks + kap * 72 + 32 + 4 * i4) = (v2u){cvtpk(hi[0], hi[1]), cvtpk(hi[2], hi[3])};
                    if (wr) { *(GAS f32x4*)(pk + 4 * i4) = (f32x4){lo[0], lo[1], lo[2], lo[3]}; *(GAS f32x4*)(pk + 32 + 4 * i4) = (f32x4){hi[0], hi[1], hi[2], hi[3]}; }
                    }
            } else {
#pragma unroll
                for (int i = 0; i < 8; ++i) *(LAS v4u*)(Ks + kap * 72 + 8 * i) = (v4u){0u, 0u, 0u, 0u};
            }
        } else {
            if (tk >= 0) {
                const GAS v4u* src = (const GAS v4u*)(L.Z + (size_t)(b * SEQ + tk) * ZW + ZC_V + kvh * 64);
#pragma unroll
                for (int i = 0; i < 8; ++i) { const v4u w = src[i]; const unsigned ww[4] = {w.x, w.y, w.z, w.w};
#pragma unroll
                    for (int q = 0; q < 4; ++q) { VT[(8 * i + 2 * q) * 264 + kap] = (bf16)(ww[q] & 0xffffu); VT[(8 * i + 2 * q + 1) * 264 + kap] = (bf16)(ww[q] >> 16); }
                    if (blk == 31 && kap >= 128) { GAS f32x4* pv = (GAS f32x4*)(L.out + O_PV + ((size_t)((l * NB + b) * 128 + (kap - 128)) * 2 + kvh) * 64) + 2 * i;
                        pv[0] = (f32x4){bflo(w.x), bfhi(w.x), bflo(w.y), bfhi(w.y)}; pv[1] = (f32x4){bflo(w.z), bfhi(w.z), bflo(w.w), bfhi(w.w)}; } }
            } else {
#pragma unroll
                for (int d = 0; d < 64; ++d) VT[d * 264 + kap] = (bf16)0;
            }
        }
    }
    __syncthreads();
    const int w = F.wave, lane = opaque_tid() & 63, r = lane & 31, h = lane >> 5, g = w >> 1, head = kvh * 4 + g;
    const float sinkl = L.A->in[I_SINK][l * 8 + head] * LOG2E;
    const float* qg = L.A->in[I_QNG] + l * 64;
#pragma unroll 1
    for (int sub = 0; sub < 2; ++sub) {
        const int q0 = (w & 1) * 64 + sub * 32, tq = blk * 128 + q0 + r;
        bf16x8 qf[4];
        {
            const GAS v4u* src = (const GAS v4u*)(L.Z + (size_t)(b * SEQ + tq) * ZW + ZC_Q + head * 64 + 8 * h);
            float x[4][8]; float ss = 0.f;
#pragma unroll
            for (int ks = 0; ks < 4; ++ks) { const v4u wv = src[2 * ks]; x[ks][0] = bflo(wv.x); x[ks][1] = bfhi(wv.x); x[ks][2] = bflo(wv.y); x[ks][3] = bfhi(wv.y); x[ks][4] = bflo(wv.z); x[ks][5] = bfhi(wv.z); x[ks][6] = bflo(wv.w); x[ks][7] = bfhi(wv.w);
#pragma unroll
                for (int j = 0; j < 8; ++j) ss += x[ks][j] * x[ks][j]; }
            ss += __shfl_xor(ss, 32);
            const float rs = __builtin_amdgcn_rsqf(ss * (1.f / 64.f) + pg8::RMS_EPS) ;
            const float sc = 0.125f * LOG2E;
            float o[4][8];
#pragma unroll
            for (int kp = 0; kp < 2; ++kp)
#pragma unroll
                for (int j = 0; j < 8; ++j) { const int i = 16 * kp + 8 * h + j; const float c = L.cosT[tq * 32 + i], s = L.sinT[tq * 32 + i];
                    const float x1 = x[kp][j] * rs * qg[i], x2 = x[kp + 2][j] * rs * qg[i + 32];
                    o[kp][j] = (x1 * c - x2 * s) * sc; o[kp + 2][j] = (x2 * c + x1 * s) * sc; }
#pragma unroll
            for (int ks = 0; ks < 4; ++ks) qf[ks] = pack8(o[ks][0], o[ks][1], o[ks][2], o[ks][3], o[ks][4], o[ks][5], o[ks][6], o[ks][7]);
        }
        f32x16 st[5];
#pragma unroll
        for (int kt = 0; kt < 5; ++kt) {
#pragma unroll
            for (int i = 0; i < 16; ++i) st[kt][i] = 0.f;
#pragma unroll
            for (int ks = 0; ks < 4; ++ks) { const bf16x8 a = *(const LAS bf16x8*)(Ks + (q0 + 32 * kt + r) * 72 + 16 * ks + 8 * h); st[kt] = MFMA32(a, qf[ks], st[kt]); }
        }
        float mx = sinkl; const int rlo = r + 1 - 4 * h, kmin = 128 - q0 - 4 * h;
#pragma unroll
        for (int kt = 0; kt < 5; ++kt)
#pragma unroll
            for (int i = 0; i < 16; ++i) { const int kk = 32 * kt + CR(i);
                const bool ok = (kk >= rlo) && (kk <= rlo + 127) && (blk > 0 || kk >= kmin);
                st[kt][i] = ok ? st[kt][i] : -INFINITY; mx = fmaxf(mx, st[kt][i]); }
        mx = fmaxf(mx, __shfl_xor(mx, 32));
        float sum = 0.f;
#pragma unroll
        for (int kt = 0; kt < 5; ++kt)
#pragma unroll
            for (int i = 0; i < 16; ++i) { const float p = __builtin_amdgcn_exp2f(st[kt][i] - mx); st[kt][i] = p; sum += p; }
        sum += __shfl_xor(sum, 32);
        const float inv = __builtin_amdgcn_rcpf(sum + __builtin_amdgcn_exp2f(sinkl - mx));
#pragma unroll
        for (int kt = 0; kt < 5; ++kt) st[kt] = st[kt] * inv;
        f32x16 o2[2];
#pragma unroll
        for (int dt = 0; dt < 2; ++dt) {
#pragma unroll
            for (int i = 0; i < 16; ++i) o2[dt][i] = 0.f; }
#pragma unroll
        for (int kt = 0; kt < 5; ++kt)
#pragma unroll
            for (int s = 0; s < 2; ++s) { const bf16x8 pa = pack_step(st[kt], s);
#pragma unroll
                for (int dt = 0; dt < 2; ++dt) { const LAS bf16* vp = VT + (dt * 32 + r) * 264 + q0 + 32 * kt + 16 * s + 4 * h;
                    const v2u lo = *(const LAS v2u*)vp, hi = *(const LAS v2u*)(vp + 8); const v4u bb = {lo.x, lo.y, hi.x, hi.y};
                    o2[dt] = MFMA32(pa, __builtin_bit_cast(bf16x8, bb), o2[dt]); } }
        GAS bf16* yo = (GAS bf16*)L.YC + (size_t)(b * SEQ + blk * 128 + q0 + 4 * h) * DM + head * 64 + r;
#pragma unroll
        for (int i = 0; i < 16; ++i) {
#pragma unroll
            for (int dt = 0; dt < 2; ++dt) yo[CR(i) * DM + dt * 32] = cvt1(o2[dt][i]); }
    }
    __syncthreads();
}
DI void sgate_item(Frame& F, const Lyr& L, int item) {
    const int b = item >> 7, n = (item >> 2) & 31, g = item & 3, tid = opaque_tid(), l = L.l;
    LAS bf16* VT = (LAS bf16*)(F.lds);
    const int t = tid >> 2, qd = tid & 3, m0 = b * SEQ + n * 128;
    {
        const GAS f32x4* sp = (const GAS f32x4*)((const float*)(L.ws + WS_SGQ) + (size_t)(m0 + t) * 8); const f32x4 s0 = sp[0], s1 = sp[1];
        const float ss = ((s0[0] + s0[1]) + (s0[2] + s0[3])) + ((s1[0] + s1[1]) + (s1[2] + s1[3]));
        const float rs = __builtin_amdgcn_rsqf(ss * (1.f / 512.f) + pg8::RMS_EPS);
        const GAS v4u* sg = (const GAS v4u*)(L.Z + (size_t)(m0 + t) * ZW + ZC_GV + g * 128 + qd * 32);
        const float* gn = L.A->in[I_SGNG] + l * 512 + g * 128 + qd * 32;
#pragma unroll
        for (int i = 0; i < 4; ++i) { const v4u w = sg[i]; const unsigned ww[4] = {w.x, w.y, w.z, w.w};
#pragma unroll
            for (int q = 0; q < 4; ++q) { const int hc = qd * 32 + 8 * i + 2 * q; const float a = bflo(ww[q]) * rs * gn[8 * i + 2 * q], c = bfhi(ww[q]) * rs * gn[8 * i + 2 * q + 1];
                VT[hc * 136 + t] = cvt1(a); VT[(hc + 1) * 136 + t] = cvt1(c);
                if (n == 31) { float* pc = L.out + O_PCV + ((size_t)(l * NB + b) * 128 + t) * 512 + g * 128 + hc; pc[0] = a; pc[1] = c; } } }
    }
    __syncthreads();
    const int w = F.wave, lane = opaque_tid() & 63, r = lane & 31, h = lane >> 5, tt = w >> 1;
    const bf16* Wt = (const bf16*)(L.ws + WS_WTRIL) + (size_t)(l * 4 + g) * 16384;
    f32x16 acc[2];
#pragma unroll
    for (int i = 0; i < 2; ++i)
#pragma unroll
        for (int k = 0; k < 16; ++k) acc[i][k] = 0.f;
    bf16x8 af[8];
#pragma unroll
    for (int ks = 0; ks < 8; ++ks) af[ks] = *(const GAS bf16x8*)(Wt + (tt * 32 + r) * 128 + 16 * ks + 8 * h);
#pragma unroll
    for (int ks = 0; ks < 8; ++ks) if (ks < 2 * (tt + 1)) {
#pragma unroll
        for (int i = 0; i < 2; ++i) { const int ht = 2 * (w & 1) + i; const bf16x8 bq = *(const LAS bf16x8*)(VT + (ht * 32 + r) * 136 + 16 * ks + 8 * h); acc[i] = MFMA32(af[ks], bq, acc[i]); }
    }
    const float* bias = L.A->in[I_SGB] + (l * 4 + g) * 128;
#pragma unroll
    for (int i = 0; i < 2; ++i) { const int hc = (2 * (w & 1) + i) * 32 + r;
        const GAS bf16* zu = (const GAS bf16*)L.Z + (size_t)(m0 + tt * 32 + 4 * h) * ZW + ZC_GU + g * 128 + hc; GAS bf16* yo = (GAS bf16*)L.YC + (size_t)(m0 + tt * 32 + 4 * h) * DM + 1024 + g * 128 + hc;
        const float* bs = bias + tt * 32 + 4 * h;
#pragma unroll
        for (int k = 0; k < 16; ++k) { const float u = bf2f(zu[CR(k) * ZW]); yo[CR(k) * DM] = cvt1(u * (acc[i][k] + bs[CR(k)])); } }
    __syncthreads();
}

DI void ssm_pass1_task(Frame& F, const Lyr& L, int task) {
    const int b = task >> 10, sb = (task >> 5) & 31, g = task & 31, lane = opaque_tid() & 63, p = lane, r = lane & 31, hh = lane >> 5, l = L.l, w = F.wave;
    LAS unsigned* Sw = (LAS unsigned*)(F.lds + w * 8704);
    const int e = (l * 32 + g) * 64 + p;
    const f32x2v a = ((const f32x2v*)(L.ws + WS_ABAR))[e];
    const GAS bf16x8* bfp = (const GAS bf16x8*)((const bf16*)(L.ws + WS_BFRAG) + (size_t)(l * 32 + g) * 2048) + lane;
    bf16x8 Bf[4];
#pragma unroll
    for (int t = 0; t < 4; ++t) Bf[t] = bfp[t * 64];
    const GAS bf16x8* up = (const GAS bf16x8*)(L.Z + (size_t)(b * SEQ + sb * 128 + r) * ZW + ZC_SU + g * 16 + 8 * hh);
    bf16x8 ub[4];
#pragma unroll
    for (int j = 0; j < 4; ++j) ub[j] = up[(size_t)j * 32 * ZW / 8];
    float sr = 0.f, si = 0.f;
    f32x16 zero;
#pragma unroll
    for (int k = 0; k < 16; ++k) zero[k] = 0.f;
#pragma unroll 1
    for (int j = 0; j < 4; ++j) {
        const bf16x8 uj = j == 0 ? ub[0] : j == 1 ? ub[1] : j == 2 ? ub[2] : ub[3];
#pragma unroll
        for (int q = 0; q < 2; ++q) { const f32x16 re = MFMA32(uj, Bf[2 * q], zero), im = MFMA32(uj, Bf[2 * q + 1], zero);
#pragma unroll
            for (int k = 0; k < 16; ++k) Sw[(CR(k) + 4 * hh) * 68 + 32 * q + r] = cvtpk(re[k], im[k]); }
        LDS_WAIT(); asm volatile("" ::: "memory");
        unsigned wv[32];
#pragma unroll
        for (int t = 0; t < 32; ++t) wv[t] = Sw[t * 68 + p];
        {
            GAS unsigned* bu = (GAS unsigned*)(L.ws + WS_BU) + ((size_t)(b * 32 + g) * 128 + sb * 4 + j) * 2048 + p;
#pragma unroll
            for (int t = 0; t < 32; ++t) bu[t * 64] = wv[t]; }
#pragma unroll
        for (int t = 0; t < 32; ++t) { const float nr = a.x * sr - a.y * si + bflo(wv[t]), ni = a.x * si + a.y * sr + bfhi(wv[t]); sr = nr; si = ni; }
        ((f32x2v*)(L.ws + WS_E))[((size_t)(b * 32 + g) * 128 + sb * 4 + j) * 64 + p] = (f32x2v){sr, si};
        LDS_WAIT(); asm volatile("" ::: "memory");
    }
}
constexpr int DP_KF = 0, DP_VF = 32768, DP_QB = 65536, DP_KB = 82944, DP_AM = 100352, DP_GC = 116736, DP_BETA = DP_GC + 256, DP_EG = DP_GC + 512, DP_KEX = DP_GC + 768;
DI void dprep_item(Frame& F, const Lyr& L, int item) {
    const int b = item >> 8, h = (item >> 6) & 3, n = item & 63, l = L.l; int tid = opaque_tid();
    LAS float* Kf = (LAS float*)(F.lds + DP_KF); LAS float* Vf = (LAS float*)(F.lds + DP_VF);
    LAS bf16* Qb = (LAS bf16*)(F.lds + DP_QB); LAS bf16* Kb = (LAS bf16*)(F.lds + DP_KB);
    LAS float* Am = (LAS float*)(F.lds + DP_AM);
    LAS float* gcs = (LAS float*)(F.lds + DP_GC); LAS float* betas = (LAS float*)(F.lds + DP_BETA); LAS float* egs = (LAS float*)(F.lds + DP_EG); LAS float* kex = (LAS float*)(F.lds + DP_KEX);
    const int m0 = b * SEQ + n * 64;
    {
        const int t = tid >> 3, sub = tid & 7, tg = n * 64 + t;
#pragma unroll 1
        for (int wh = 0; wh < 3; ++wh) {
            const int ch0 = wh * 512 + h * 128 + sub * 16;
            const float* cw = L.A->in[I_CONVW] + (size_t)l * 4 * 1536 + ch0;
            float y[16];
#pragma unroll
            for (int c = 0; c < 16; ++c) y[c] = 0.f;
#pragma unroll
            for (int i = 0; i < 4; ++i) {
                if (tg - 3 + i >= 0) {
                    const GAS v4u* src = (const GAS v4u*)(L.Z + (size_t)(m0 + t - 3 + i) * ZW + ZC_DQ + ch0); const v4u a0 = src[0], a1 = src[1];
                    const unsigned ww[8] = {a0.x, a0.y, a0.z, a0.w, a1.x, a1.y, a1.z, a1.w};
#pragma unroll
                    for (int q = 0; q < 8; ++q) { y[2 * q] += cw[i * 1536 + 2 * q] * bflo(ww[q]); y[2 * q + 1] += cw[i * 1536 + 2 * q + 1] * bfhi(ww[q]); }
                    if (i == 3 && n == 63 && t >= 61) { float* pc = L.out + O_PC + ((size_t)(l * NB + b) * 3 + (t - 61)) * 1536 + ch0;
#pragma unroll
                        for (int q = 0; q < 8; ++q) { pc[2 * q] = bflo(ww[q]); pc[2 * q + 1] = bfhi(ww[q]); } }
                }
            }
            float ss = 0.f;
#pragma unroll
            for (int c = 0; c < 16; ++c) { y[c] = siluf_(y[c]); ss += y[c] * y[c]; }
            ss += __shfl_xor(ss, 1); ss += __shfl_xor(ss, 2); ss += __shfl_xor(ss, 4);
            const float rn = wh == 0 ? __builtin_amdgcn_rsqf(ss + pg8::RMS_EPS) * 0.08838834764831845f : (wh == 1 ? __builtin_amdgcn_rsqf(ss + pg8::RMS_EPS) : 1.0f);
            LAS bf16* bdst = (wh == 0 ? Qb : Kb) + t * 136 + sub * 16; LAS float* fdst = (wh == 1 ? Kf : Vf) + t * 128 + sub * 16;
#pragma unroll
            for (int c = 0; c < 16; c += 2) { const float v0 = y[c] * rn, v1 = y[c + 1] * rn;
                if (wh < 2) *(LAS unsigned*)(bdst + c) = cvtpk(v0, v1);
                if (wh > 0) { fdst[c] = v0; fdst[c + 1] = v1; } }
        }
    }
    tid = opaque_tid();
    if (tid < 64) {
        const int t = tid; const float* zab = L.ZAB + (size_t)(m0 + t) * 8;
        const float gg = -__expf(L.A->in[I_ALOG][l * 4 + h]) * softplusf_(zab[h] + L.A->in[I_DTB][l * 4 + h]);
        float c = gg;
#pragma unroll
        for (int o = 1; o < 64; o <<= 1) { const float v = __shfl_up(c, o); if (t >= o) c += v; }
        const float clast = __shfl(c, 63);
        gcs[t] = c; betas[t] = sigmoidf_(zab[4 + h]); egs[t] = __expf(c); kex[t] = __expf(clast - c);
        if (t == 63) ((float*)(L.ws + WS_GE))[item] = __expf(c);
    }
    __syncthreads();
    {
        const int w = F.wave, lane = opaque_tid() & 63, r = lane & 31, hh = lane >> 5, which = w >> 2, tt = (w >> 1) & 1, st = w & 1;
        f32x16 acc;
#pragma unroll
        for (int k = 0; k < 16; ++k) acc[k] = 0.f;
        const LAS bf16* Ap = (which ? Qb : Kb) + (tt * 32 + r) * 136 + 8 * hh; const LAS bf16* Bp = Kb + (st * 32 + r) * 136 + 8 * hh;
#pragma unroll
        for (int ks = 0; ks < 8; ++ks) acc = MFMA32(*(const LAS bf16x8*)(Ap + 16 * ks), *(const LAS bf16x8*)(Bp + 16 * ks), acc);
        bf16* QKo = (bf16*)(L.ws + WS_QK) + (size_t)item * 4096;
        const int s = st * 32 + r; const float gs = gcs[s];
        const int tb = tt * 32 + 4 * hh; const LAS float* gct = gcs + tb; const LAS float* bet = betas + tb; LAS float* Amp = Am + tb * 64 + s; bf16* qko = QKo + frag_off(tb, s, 4);
#pragma unroll
        for (int k = 0; k < 16; ++k) { const int t = tb + CR(k); const float dec = __expf(gct[CR(k)] - gs);
            if (which == 0) Amp[CR(k) * 64] = t > s ? bet[CR(k)] * acc[k] * dec : 0.f;
            else qko[CR(k) * 8] = cvt1(t >= s ? acc[k] * dec : 0.f); }
    }
    __syncthreads();
    tid = opaque_tid();
    {
        const int u = tid & 255;
        if (tid < 256) { const int t = u >> 2, d0 = (u & 3) * 32; bf16* QG = (bf16*)(L.ws + WS_QG) + (size_t)item * 8192; const float e = egs[t];
#pragma unroll 2
          for (int d = 0; d < 32; d += 4) { const int dk = d0 + d;
              const v2u o = {cvtpk(bf2f(Qb[t * 136 + dk]) * e, bf2f(Qb[t * 136 + dk + 1]) * e), cvtpk(bf2f(Qb[t * 136 + dk + 2]) * e, bf2f(Qb[t * 136 + dk + 3]) * e)};
              *(GAS v2u*)(QG + frag_off(t, dk, 8)) = o; } }
        else { const int dk = u >> 1, s0 = (u & 1) * 32; bf16* KE = (bf16*)(L.ws + WS_KE) + (size_t)item * 8192;
#pragma unroll 2
          for (int s = 0; s < 32; s += 4) { const int tk = s0 + s;
              const v2u o = {cvtpk(Kf[tk * 128 + dk] * kex[tk], Kf[(tk + 1) * 128 + dk] * kex[tk + 1]), cvtpk(Kf[(tk + 2) * 128 + dk] * kex[tk + 2], Kf[(tk + 3) * 128 + dk] * kex[tk + 3])};
              *(GAS v2u*)(KE + frag_off(dk, tk, 4)) = o; } }
    }
    __syncthreads();
    tid = opaque_tid();
    if (tid < 256) {
        const int c = tid; const bool isw = c >= 128; LAS float* X = isw ? Kf + (c - 128) : Vf + c;
        unsigned* U0 = (unsigned*)(L.ws + WS_U0) + (size_t)item * 4096 + ((c & 127) >> 5) * 1024 + (c & 31); bf16* WN = (bf16*)(L.ws + WS_WN) + (size_t)item * 8192;
#pragma unroll 1
        for (int tb = 0; tb < 4; ++tb) {
            float a[16];
#pragma unroll
            for (int i = 0; i < 16; ++i) { const int t = tb * 16 + i; a[i] = betas[t] * (isw ? egs[t] : 1.0f) * X[t * 128]; }
#pragma unroll 1
            for (int sb = 0; sb < tb; ++sb) {
                float xs[16];
#pragma unroll
                for (int j = 0; j < 16; ++j) xs[j] = X[(sb * 16 + j) * 128];
#pragma unroll
                for (int i = 0; i < 16; ++i) { const LAS f32x4* ar = (const LAS f32x4*)(Am + (tb * 16 + i) * 64 + sb * 16);
#pragma unroll
                    for (int j4 = 0; j4 < 4; ++j4) { const f32x4 av = ar[j4]; a[i] -= av.x * xs[4 * j4]; a[i] -= av.y * xs[4 * j4 + 1]; a[i] -= av.z * xs[4 * j4 + 2]; a[i] -= av.w * xs[4 * j4 + 3]; }
                    if ((i & 3) == 3) asm volatile("" ::: "memory"); }
            }
#pragma unroll
            for (int i = 1; i < 16; ++i) { const LAS float* ar = Am + (tb * 16 + i) * 64 + tb * 16;
#pragma unroll
                for (int j = 0; j < i; ++j) a[i] -= ar[j] * a[j];
                if ((i & 3) == 3) asm volatile("" ::: "memory"); }
#pragma unroll
            for (int i = 0; i < 16; ++i) { const int t = tb * 16 + i; X[t * 128] = a[i];
                if (!isw) { if ((i & 1) == 0) U0[(((tb >> 1) * 8 + (((i & 3) >> 1) | ((2 * (tb & 1) + (i >> 3)) << 1))) * 64) + ((i >> 2) & 1) * 32] = cvtpk(a[i], a[i + 1 < 16 ? i + 1 : 15]); } else WN[frag_off(t, c - 128, 8)] = cvt1(-a[i]); }
        }
    }
    __syncthreads();
}
constexpr int SC_BUF = 57344, SC_WN = 0, SC_QG = 16384, SC_QK = 32768, SC_KE = 40960;
struct ScanRegs { v4u a[14]; };
DI void dscan_issue(ScanRegs& R, const unsigned char* ws, size_t item, int lw, int lane) {
    const GAS v4u* wn = (const GAS v4u*)(ws + WS_WN + item * 16384) + lane; const GAS v4u* qg = (const GAS v4u*)(ws + WS_QG + item * 16384) + lane;
    const GAS v4u* qk = (const GAS v4u*)(ws + WS_QK + item * 8192) + lane;  const GAS v4u* ke = (const GAS v4u*)(ws + WS_KE + item * 16384) + lane;
#pragma unroll
    for (int i = 0; i < 4; ++i) { const int f = lw + 4 * i; R.a[i] = wn[f * 64]; R.a[4 + i] = qg[f * 64]; R.a[8 + i] = ke[f * 64]; }
#pragma unroll
    for (int i = 0; i < 2; ++i) R.a[12 + i] = qk[(lw + 4 * i) * 64];
}
DI void dscan_store_a(const ScanRegs& R, LAS unsigned char* buf, int lw, int lane) {
    LAS v4u* b = (LAS v4u*)buf + lane;
#pragma unroll
    for (int i = 0; i < 4; ++i) { const int f = lw + 4 * i; b[(SC_WN / 16) + f * 64] = R.a[i]; b[(SC_QG / 16) + f * 64] = R.a[4 + i]; b[(SC_KE / 16) + f * 64] = R.a[8 + i]; }
#pragma unroll
    for (int i = 0; i < 2; ++i) b[(SC_QK / 16) + (lw + 4 * i) * 64] = R.a[12 + i];
}
#define SC_RD(off) (*(const LAS bf16x8*)(buf + (off)))
#define SC_SB() __builtin_amdgcn_sched_barrier(0)
DI void dscan_chunk(f32x16 (&S)[4], unsigned (&Uw)[16], unsigned (&Unw)[16], float& gen, const LAS unsigned char* buf, const GAS unsigned* U1, const GAS float* GE, GAS unsigned* od, int n) {
    f32x16 U[2];
#pragma unroll
    for (int rt = 0; rt < 2; ++rt)
#pragma unroll
        for (int kp = 0; kp < 8; ++kp) { U[rt][2 * kp] = bflo(Uw[rt * 8 + kp]); U[rt][2 * kp + 1] = bfhi(Uw[rt * 8 + kp]); }
    const float ge = gen;
    f32x16 O[2];
    bf16x8 fa[4], fb[4];
    fa[0] = SC_RD(SC_WN); fa[1] = SC_RD(SC_QG); fa[2] = SC_RD(SC_WN + 8 * 1024); fa[3] = SC_RD(SC_QG + 8 * 1024);
    const bool more = n + 1 < 64;
    f32x16 zero;
#pragma unroll
    for (int k = 0; k < 16; ++k) zero[k] = 0.f;
    bf16x8 qa[2], qb[2];
#pragma unroll
    for (int ks = 0; ks < 8; ++ks) {
        bf16x8 (&cur)[4] = (ks & 1) ? fb : fa; bf16x8 (&nxt)[4] = (ks & 1) ? fa : fb;
        if (ks < 7) { nxt[0] = SC_RD(SC_WN + (ks + 1) * 1024); nxt[1] = SC_RD(SC_QG + (ks + 1) * 1024); nxt[2] = SC_RD(SC_WN + (8 + ks + 1) * 1024); nxt[3] = SC_RD(SC_QG + (8 + ks + 1) * 1024); }
        else { qa[0] = SC_RD(SC_QK); qa[1] = SC_RD(SC_QK + 4 * 1024); }
        SC_SB();
        const bf16x8 sb = pack_step(S[ks >> 1], ks & 1);
        U[0] = MFMA32(cur[0], sb, U[0]); O[0] = MFMA32(cur[1], sb, ks == 0 ? zero : O[0]); U[1] = MFMA32(cur[2], sb, U[1]); O[1] = MFMA32(cur[3], sb, ks == 0 ? zero : O[1]);
        if (more) { if (ks == 0) gen = GE[n + 1];
#pragma unroll
            for (int j = 0; j < 2; ++j) Unw[(ks >> 2) * 8 + 2 * (ks & 3) + j] = U1[((ks >> 2) * 8 + 2 * (ks & 3) + j) * 64]; }
        if (ks & 1) S[ks >> 1] = S[ks >> 1] * ge;
        SC_SB();
    }
    bf16x8 Ub[4];
#pragma unroll
    for (int rt = 0; rt < 2; ++rt) { Ub[2 * rt] = pack_step(U[rt], 0); Ub[2 * rt + 1] = pack_step(U[rt], 1); }
#pragma unroll
    for (int ks = 0; ks < 4; ++ks) {
        bf16x8 (&cur)[2] = (ks & 1) ? qb : qa; bf16x8 (&nxt)[2] = (ks & 1) ? qa : qb;
        if (ks < 3) { nxt[0] = SC_RD(SC_QK + (ks + 1) * 1024); nxt[1] = SC_RD(SC_QK + (4 + ks + 1) * 1024); }
        else {
#pragma unroll
            for (int d = 0; d < 4; ++d) fa[d] = SC_RD(SC_KE + (d * 4) * 1024); }
        SC_SB();
        O[0] = MFMA32(cur[0], Ub[ks], O[0]); O[1] = MFMA32(cur[1], Ub[ks], O[1]);
        SC_SB();
    }
#pragma unroll
    for (int ks = 0; ks < 4; ++ks) {
        bf16x8 (&cur)[4] = (ks & 1) ? fb : fa; bf16x8 (&nxt)[4] = (ks & 1) ? fa : fb;
        if (ks < 3) {
#pragma unroll
            for (int d = 0; d < 4; ++d) nxt[d] = SC_RD(SC_KE + (d * 4 + ks + 1) * 1024); }
        SC_SB();
#pragma unroll
        for (int d = 0; d < 4; ++d) S[d] = MFMA32(cur[d], Ub[ks], S[d]);
#pragma unroll
        for (int j = 0; j < 4; ++j) od[((ks >> 1) * 8 + 4 * (ks & 1) + j) * 64] = cvtpk(O[ks >> 1][8 * (ks & 1) + 2 * j], O[ks >> 1][8 * (ks & 1) + 2 * j + 1]);
        SC_SB();
    }
}
DI void dscan_wg(Frame& F, const Lyr& L, int bh, size_t od_extra = 0, int hs_ = 0) {
    const int b = bh >> 2, h = bh & 3, w = F.wave, lane = opaque_tid() & 63, r = lane & 31, hh = lane >> 5, dv0 = (w & 3) * 32, l = L.l;
    const bool loader = w >= 4; const int lw = w - 4;
    const size_t item0 = (size_t)bh * 64;
    if (loader) {
        ScanRegs R0, R1, R2, R3;
        dscan_issue(R0, L.ws, item0, lw, lane);
        asm volatile("s_waitcnt vmcnt(0)" ::: "memory");
        dscan_store_a(R0, F.lds, lw, lane);
        asm volatile("s_waitcnt lgkmcnt(0)" ::: "memory");
        dscan_issue(R1, L.ws, item0 + 1, lw, lane);
        dscan_issue(R2, L.ws, item0 + 2, lw, lane);
        dscan_issue(R3, L.ws, item0 + 3, lw, lane);
#define SC_TRIP(RS, RN, BUFOFF, NEXT) \
            __builtin_amdgcn_s_barrier(); asm volatile("" ::: "memory"); \
            asm volatile("s_waitcnt vmcnt(28)" ::: "memory"); \
            dscan_store_a(RS, F.lds + (BUFOFF), lw, lane); \
            asm volatile("s_waitcnt lgkmcnt(0)" ::: "memory"); \
            dscan_issue(RN, L.ws, item0 + ((NEXT) < 64 ? (NEXT) : 63), lw, lane);
#pragma unroll 1
        for (int n = 0; n < 64; n += 4) {
            SC_TRIP(R1, R0, SC_BUF, n + 4)
            SC_TRIP(R2, R1, 0, n + 5)
            SC_TRIP(R3, R2, SC_BUF, n + 6)
            SC_TRIP(R0, R3, 0, n + 7)
        }
#undef SC_TRIP
        asm volatile("s_waitcnt vmcnt(0)" ::: "memory");
    } else {
        f32x16 S[4]; unsigned UA[16], UB[16];
#pragma unroll
        for (int d = 0; d < 4; ++d)
#pragma unroll
            for (int k = 0; k < 16; ++k) S[d][k] = 0.f;
        const int uoff = (4 * hh) * 128 + dv0 + r, sl = w & 3;
        GAS unsigned* ODp = (GAS unsigned*)(L.ws + WS_OD) + (item0 * 4 + sl) * 1024 + lane;
        const GAS unsigned* U0 = (const GAS unsigned*)((const unsigned*)(L.ws + WS_U0) + item0 * 4096) + sl * 1024 + lane;
        const GAS float* GE = (const GAS float*)(L.ws + WS_GE) + item0;
        float gen = GE[0];
#pragma unroll
        for (int rt = 0; rt < 2; ++rt)
#pragma unroll
            for (int kp = 0; kp < 8; ++kp) UA[rt * 8 + kp] = U0[(rt * 8 + kp) * 64];
#pragma unroll 1
        for (int n = 0; n < 64; n += 2) {
            __builtin_amdgcn_s_barrier(); asm volatile("" ::: "memory");
            dscan_chunk(S, UA, UB, gen, F.lds + lane * 16, U0 + (size_t)(n + 1) * 4096, GE, ODp + (size_t)n * 4096, n);
            __builtin_amdgcn_s_barrier(); asm volatile("" ::: "memory");
            dscan_chunk(S, UB, UA, gen, F.lds + SC_BUF + lane * 16, U0 + (size_t)(n + 2) * 4096, GE, ODp + (size_t)(n + 1) * 4096, n + 1);
        }
        GAS float* PD = (GAS float*)(L.out + O_PD + ((size_t)(l * NB + b) * 4 + h) * 16384);
#pragma unroll
        for (int d = 0; d < 4; ++d)
#pragma unroll
            for (int k = 0; k < 16; ++k) (PD + (d * 32 + CR(k)) * 128)[uoff] = S[d][k];
    }
    __syncthreads();
}

DI void ssm_pass2_item(Frame& F, const Lyr& L, int item) {
    const int b = item >> 7, blk = item & 127, w = F.wave, lane = opaque_tid() & 63, l = L.l;
    LAS bf16* Sw = (LAS bf16*)(F.lds + w * 8704); LAS bf16* Y = (LAS bf16*)(F.lds + 69632);
    const int m0 = b * SEQ + blk * 32;
#pragma unroll 1
    for (int gi = 0; gi < 4; ++gi) {
        const int g = 4 * w + gi, p = lane, e = (l * 32 + g) * 64 + p;
        const f32x2v a = ((const f32x2v*)(L.ws + WS_ABAR))[e], a32 = ((const f32x2v*)(L.ws + WS_A32))[e];
        float sr = 0.f, si = 0.f; unsigned wv[32];
        const GAS f32x2v* E = (const GAS f32x2v*)(L.ws + WS_E) + (size_t)(b * 32 + g) * 128 * 64 + p;
        {
            float t2r = a32.x * a32.x - a32.y * a32.y, t2i = 2.f * a32.x * a32.y; const float a128r = t2r * t2r - t2i * t2i, a128i = 2.f * t2r * t2i;
            const int sbn = blk >> 2, jn = blk & 3;
            const GAS unsigned* bu = (const GAS unsigned*)(L.ws + WS_BU) + ((size_t)(b * 32 + g) * 128 + blk) * 2048 + p;
            f32x2v evs[31];
#pragma unroll
            for (int i = 0; i < 31; ++i) evs[i] = E[(4 * (i < sbn ? i : 0) + 3) * 64];
            const f32x2v evl = E[(jn > 0 ? blk - 1 : 0) * 64];
#pragma unroll
            for (int t = 0; t < 16; ++t) wv[t] = bu[t * 64];
#pragma unroll
            for (int i = 0; i < 31; ++i) if (i < sbn) { const float nr = a128r * sr - a128i * si + evs[i].x, ni = a128r * si + a128i * sr + evs[i].y; sr = nr; si = ni; }
            if (jn > 0) { const f32x2v ev = evl;
                for (int j = 0; j < jn; ++j) { const float nr = a32.x * sr - a32.y * si, ni = a32.x * si + a32.y * sr; sr = nr; si = ni; }
                sr += ev.x; si += ev.y; }
        }
        const bf16* zrow = L.Z + (size_t)m0 * ZW + ZC_SU + g * 16;
        const int r16 = lane & 15, q4 = lane >> 4;
        const GAS bf16x8* Cf = (const GAS bf16x8*)((const bf16*)(L.ws + WS_CFRAG) + (size_t)(l * 32 + g) * 2048) + lane;
        bf16x8 cbv[4]; unsigned short uz[8];
#pragma unroll
        for (int kb = 0; kb < 4; ++kb) cbv[kb] = Cf[kb * 64];
        const float dsk = L.A->in[I_SSMD][l * 512 + g * 16 + r16];
#pragma unroll
        for (int rt = 0; rt < 2; ++rt)
#pragma unroll
            for (int k = 0; k < 4; ++k) uz[rt * 4 + k] = zrow[(size_t)(rt * 16 + 4 * q4 + k) * ZW + r16];
        {
            const GAS unsigned* bu2 = (const GAS unsigned*)(L.ws + WS_BU) + ((size_t)(b * 32 + g) * 128 + blk) * 2048 + p;
#pragma unroll
            for (int t = 16; t < 32; ++t) wv[t] = bu2[t * 64];
#pragma unroll
            for (int t = 0; t < 32; ++t) { const float nr = a.x * sr - a.y * si + bflo(wv[t]), ni = a.x * si + a.y * sr + bfhi(wv[t]); sr = nr; si = ni;
                *(LAS unsigned*)(Sw + t * 136 + 2 * p) = cvtpk(sr, si); }
        }
        if (blk == 127) { L.out[O_PSR + (size_t)((l * NB + b) * 32 + g) * 64 + p] = sr; L.out[O_PSI + (size_t)((l * NB + b) * 32 + g) * 64 + p] = si; }
        LDS_WAIT(); asm volatile("" ::: "memory");
        f32x4 yy[2] = {{0.f, 0.f, 0.f, 0.f}, {0.f, 0.f, 0.f, 0.f}};
#pragma unroll
        for (int kb = 0; kb < 4; ++kb) { const bf16x8 cb = cbv[kb];
#pragma unroll
            for (int rt = 0; rt < 2; ++rt) yy[rt] = MFMA16(*(const LAS bf16x8*)(Sw + (rt * 16 + r16) * 136 + 32 * kb + 8 * q4), cb, yy[rt]); }
#pragma unroll
        for (int rt = 0; rt < 2; ++rt)
#pragma unroll
            for (int k = 0; k < 4; ++k) { const int t = rt * 16 + 4 * q4 + k; const float u = bf2f(uz[rt * 4 + k]);
                Y[t * 520 + g * 16 + r16] = cvt1(gelu_tanh(yy[rt][k] + dsk * u)); }
        LDS_WAIT(); asm volatile("" ::: "memory");
    }
    {
        const int r = lane & 31, hh = lane >> 5;
        const bf16* Wg = (const bf16*)(L.ws + WS_WG) + (size_t)l * 262144;
        bf16x8 wq[16][2];
#pragma unroll
        for (int j = 0; j < 8; ++j)
#pragma unroll
            for (int ct = 0; ct < 2; ++ct) wq[j][ct] = *(const GAS bf16x8*)(Wg + (size_t)(64 * w + 32 * ct + r) * 512 + 16 * j + 8 * hh);
        __syncthreads();
        f32x16 acc[2];
#pragma unroll
        for (int ct = 0; ct < 2; ++ct)
#pragma unroll
            for (int k = 0; k < 16; ++k) acc[ct][k] = 0.f;
#pragma unroll
        for (int ks = 0; ks < 32; ++ks) {
            if ((ks & 7) == 0 && ks + 8 < 32) {
#pragma unroll
                for (int j = 0; j < 8; ++j)
#pragma unroll
                    for (int ct = 0; ct < 2; ++ct) wq[(ks + 8 + j) & 15][ct] = *(const GAS bf16x8*)(Wg + (size_t)(64 * w + 32 * ct + r) * 512 + 16 * (ks + 8 + j) + 8 * hh); }
            const bf16x8 a = *(const LAS bf16x8*)(Y + r * 520 + 16 * ks + 8 * hh);
#pragma unroll
            for (int ct = 0; ct < 2; ++ct) acc[ct] = MFMA32(a, wq[ks & 15][ct], acc[ct]); }
#pragma unroll
        for (int ct = 0; ct < 2; ++ct) { const int nn = 64 * w + 32 * ct + r; const float bg = L.A->in[I_GLUB][l * 512 + nn];
            const LAS bf16* Yp = Y + (4 * hh) * 520 + nn; GAS bf16* yo = (GAS bf16*)L.YC + (size_t)(m0 + 4 * hh) * DM + 512 + nn;
#pragma unroll
            for (int k = 0; k < 16; ++k) { const float y = bf2f(Yp[CR(k) * 520]); yo[CR(k) * DM] = cvt1(y * sigmoidf_(acc[ct][k] + bg)); } }
    }
    __syncthreads();
}

DI void dpost_rows(Frame& F, const Lyr& L) {
    const int gw = F.vcu * NWAVES + F.wave, NGW = F.G * NWAVES, lane = opaque_tid() & 63, l = L.l;
    const unsigned* OD = (const unsigned*)(L.ws + WS_OD);
    const float g0 = L.A->in[I_DNG][l * 128 + 2 * lane], g1 = L.A->in[I_DNG][l * 128 + 2 * lane + 1];
    for (int rw0 = gw * 4; rw0 < MP * 4; rw0 += NGW * 4) {
        f32x2v o[4]; unsigned zg[4];
#pragma unroll
        for (int j = 0; j < 4; ++j) { const int m = (rw0 + j) >> 2, h = (rw0 + j) & 3;
            { const int tp = m & 4095, t = tp & 63, tt = t & 31, kk = (tt & 3) | ((tt >> 3) << 2);
              const v2u ow = *(const GAS v2u*)(OD + (((((size_t)((m >> 12) * 4 + h) * 64 + (tp >> 6)) * 4 + (lane >> 4)) * 2 + (t >> 5)) * 8 + (kk >> 1)) * 64 + ((tt >> 2) & 1) * 32 + 2 * (lane & 15));
              o[j] = (kk & 1) ? (f32x2v){bfhi(ow.x), bfhi(ow.y)} : (f32x2v){bflo(ow.x), bflo(ow.y)}; }
            zg[j] = *(const GAS unsigned*)(L.Z + (size_t)m * ZW + ZC_DG + h * 128 + 2 * lane); }
#pragma unroll
        for (int j = 0; j < 4; ++j) { const int m = (rw0 + j) >> 2, h = (rw0 + j) & 3;
            const float ss = wave_sum(o[j].x * o[j].x + o[j].y * o[j].y);
            const float rs = __builtin_amdgcn_rsqf(ss * (1.f / 128.f) + pg8::RMS_EPS);
            *(GAS unsigned*)(L.YC + (size_t)m * DM + 1536 + h * 128 + 2 * lane) = cvtpk(o[j].x * rs * g0 * siluf_(bflo(zg[j])), o[j].y * rs * g1 * siluf_(bfhi(zg[j]))); }
    }
}
DI float block_sum(LAS float* red, float v, int tid, int grp_waves) {
    v = wave_sum(v);
    __syncthreads();
    if ((tid & 63) == 0) red[tid >> 6] = v;
    __syncthreads();
    const int w = tid >> 6, g0 = (w / grp_waves) * grp_waves; float s = 0.f;
    for (int i = 0; i < grp_waves; ++i) s += red[g0 + i];
    return s;
}
DI void sample_attn(Frame& F, const Lyr& L, int b) {
    const int tid = opaque_tid(), lane = tid & 63, w = F.wave, l = L.l, row = MP + b;
    const bf16* zrow = L.Z + (size_t)row * ZW; bf16* yrow = L.YC + (size_t)row * DM; const Args& A = *L.A;
    LAS float* fl = (LAS float*)F.lds; LAS float* q_l = fl; LAS float* k_l = fl + 512; LAS float* v_l = fl + 640; LAS float* sc_l = fl + 768;
    const float* cosr = L.cosT + 4096 * 32; const float* sinr = L.sinT + 4096 * 32;
    {
        const int d = lane, i = d & 31;
        { const float x = bf2f(zrow[ZC_Q + tid]); const float ss = wave_sum(x * x); const float xn = x * __builtin_amdgcn_rsqf(ss * (1.f / 64.f) + pg8::RMS_EPS) * A.in[I_QNG][l * 64 + d];
          const float pr = __shfl_xor(xn, 32); const float c = cosr[i], s = sinr[i]; q_l[tid] = (d < 32 ? xn * c - pr * s : xn * c + pr * s) * 0.125f; }
        if (w < 2) { const float x = bf2f(zrow[ZC_K + tid]); const float ss = wave_sum(x * x); const float xn = x * __builtin_amdgcn_rsqf(ss * (1.f / 64.f) + pg8::RMS_EPS) * A.in[I_KNG][l * 64 + d];
          const float pr = __shfl_xor(xn, 32); const float c = cosr[i], s = sinr[i]; k_l[tid] = d < 32 ? xn * c - pr * s : xn * c + pr * s; }
        else if (w < 4) v_l[tid - 128] = bf2f(zrow[ZC_V + tid - 128]);
    }
    __syncthreads();
    const float* ck = A.in[I_CK] + (size_t)(l * NS + b) * 16384; const float* cv = A.in[I_CV] + (size_t)(l * NS + b) * 16384;
    {
        GAS f32x4* ok = (GAS f32x4*)(L.out + O_SK + (size_t)(l * NS + b) * 16384); GAS f32x4* ov = (GAS f32x4*)(L.out + O_SV + (size_t)(l * NS + b) * 16384);
#pragma unroll
        for (int k = 0; k < 8; ++k) { const int idx = tid + 512 * k, i = idx >> 5, c4 = idx & 31;
            ok[idx] = i < 127 ? ((const GAS f32x4*)ck)[idx + 32] : *(const LAS f32x4*)(k_l + 4 * c4);
            ov[idx] = i < 127 ? ((const GAS f32x4*)cv)[idx + 32] : *(const LAS f32x4*)(v_l + 4 * c4); }
    }
    const int head = w, kvh = head >> 2;
    {
        float sc[2];
#pragma unroll
        for (int jj = 0; jj < 2; ++jj) { const int j = lane + 64 * jj; float acc = 0.f;
            if (j < 127) { const GAS f32x4* kp = (const GAS f32x4*)(ck + (size_t)(j + 1) * 128 + kvh * 64);
#pragma unroll
                for (int d4 = 0; d4 < 16; ++d4) { const f32x4 kv = kp[d4]; const f32x4 qv = *(const LAS f32x4*)(q_l + head * 64 + 4 * d4); acc += (kv.x * qv.x + kv.y * qv.y) + (kv.z * qv.z + kv.w * qv.w); } }
            else {
#pragma unroll
                for (int d4 = 0; d4 < 16; ++d4) { const f32x4 kv = *(const LAS f32x4*)(k_l + kvh * 64 + 4 * d4); const f32x4 qv = *(const LAS f32x4*)(q_l + head * 64 + 4 * d4); acc += (kv.x * qv.x + kv.y * qv.y) + (kv.z * qv.z + kv.w * qv.w); } }
            sc[jj] = acc; }
        const float sink = A.in[I_SINK][l * 8 + head];
        const float mx = fmaxf(wave_max(fmaxf(sc[0], sc[1])), sink);
        const float p0 = __expf(sc[0] - mx), p1 = __expf(sc[1] - mx);
        const float inv = 1.f / (wave_sum(p0 + p1) + __expf(sink - mx));
        sc_l[head * 128 + lane] = p0 * inv; sc_l[head * 128 + lane + 64] = p1 * inv;
        LDS_WAIT(); asm volatile("" ::: "memory");
    }
    {
        const int d4 = (lane & 15) * 4, ks = lane >> 4; f32x4 o = {0.f, 0.f, 0.f, 0.f};
        const int jend = ks == 3 ? 31 : 32;
#pragma unroll 8
        for (int jj = 0; jj < jend; ++jj) { const int j = 32 * ks + jj; const float p = sc_l[head * 128 + j]; const f32x4 v = *(const GAS f32x4*)(cv + (size_t)(j + 1) * 128 + kvh * 64 + d4); o += v * p; }
        if (ks == 3) { const float p = sc_l[head * 128 + 127]; o += *(const LAS f32x4*)(v_l + kvh * 64 + d4) * p; }
#pragma unroll
        for (int e = 0; e < 4; ++e) { o[e] += __shfl_xor(o[e], 16); o[e] += __shfl_xor(o[e], 32); }
        if (ks == 0) *(GAS v2u*)(yrow + head * 64 + d4) = (v2u){cvtpk(o[0], o[1]), cvtpk(o[2], o[3])};
    }
    __syncthreads();
}
DI void sample_ssm(Frame& F, const Lyr& L, int b) {
    const int tid = opaque_tid(), l = L.l, row = MP + b;
    const bf16* zrow = L.Z + (size_t)row * ZW; bf16* yrow = L.YC + (size_t)row * DM; const Args& A = *L.A;
    LAS float* fl = (LAS float*)F.lds; LAS float* s_l = fl; LAS float* y_l = fl + 4096; LAS float* part = fl + 4608;
#pragma unroll 1
    for (int k = 0; k < 4; ++k) { const int idx = tid + 512 * k, g = idx >> 6, e = l * 2048 + idx;
        const f32x2v a = ((const f32x2v*)(L.ws + WS_ABAR))[e];
        const float s0r = A.in[I_SSR][(size_t)(l * NS + b) * 2048 + idx], s0i = A.in[I_SSI][(size_t)(l * NS + b) * 2048 + idx];
        float br = 0.f, bi = 0.f; const GAS f32x4* bbp = (const GAS f32x4*)((const f32x2v*)(L.ws + WS_BBAR) + (size_t)e * 16);
        const GAS v4u* up = (const GAS v4u*)(zrow + ZC_SU + g * 16); const v4u u0 = up[0], u1 = up[1]; const unsigned ww[8] = {u0.x, u0.y, u0.z, u0.w, u1.x, u1.y, u1.z, u1.w};
#pragma unroll
        for (int c = 0; c < 8; ++c) { const f32x4 bv = bbp[c]; const float x0 = bflo(ww[c]), x1 = bfhi(ww[c]); br += bv.x * x0 + bv.z * x1; bi += bv.y * x0 + bv.w * x1; }
        const float sr = a.x * s0r - a.y * s0i + br, si = a.x * s0i + a.y * s0r + bi;
        L.out[O_SSR + (size_t)(l * NS + b) * 2048 + idx] = sr; L.out[O_SSI + (size_t)(l * NS + b) * 2048 + idx] = si;
        s_l[2 * idx] = sr; s_l[2 * idx + 1] = si; }
    __syncthreads();
    {
        const int g = tid >> 4, c = tid & 15; const GAS f32x4* cr = (const GAS f32x4*)(A.in[I_CRE] + ((size_t)(l * 32 + g) * 16 + c) * 64); const GAS f32x4* ci = (const GAS f32x4*)(A.in[I_CIM] + ((size_t)(l * 32 + g) * 16 + c) * 64);
        float acc = 0.f;
#pragma unroll
        for (int p4 = 0; p4 < 16; ++p4) { const f32x4 a = cr[p4], bq = ci[p4]; const LAS f32x4* sp = (const LAS f32x4*)(s_l + 2 * (g * 64 + 4 * p4)); const f32x4 s0 = sp[0], s1 = sp[1];
            acc += (a.x * s0.x - bq.x * s0.y) + (a.y * s0.z - bq.y * s0.w) + (a.z * s1.x - bq.z * s1.y) + (a.w * s1.z - bq.w * s1.w); }
        acc += A.in[I_SSMD][l * 512 + tid] * bf2f(zrow[ZC_SU + tid]);
        y_l[tid] = gelu_tanh(acc);
    }
    __syncthreads();
    {
        const int n4 = (tid & 127) * 4, ks = tid >> 7; const GAS f32x4* gw = (const GAS f32x4*)(A.in[I_GLUW] + (size_t)l * 262144 + (size_t)(ks * 128) * 512 + n4); f32x4 acc = {0.f, 0.f, 0.f, 0.f};
#pragma unroll 16
        for (int k = 0; k < 128; ++k) acc += gw[k * 128] * y_l[ks * 128 + k];
        *(LAS f32x4*)(part + ks * 512 + n4) = acc;
    }
    __syncthreads();
    { const float acc = A.in[I_GLUB][l * 512 + tid] + (part[tid] + part[512 + tid]) + (part[1024 + tid] + part[1536 + tid]); yrow[512 + tid] = cvt1(y_l[tid] * sigmoidf_(acc)); }
    __syncthreads();
}
DI void sample_sgate(Frame& F, const Lyr& L, int b) {
    const int tid = opaque_tid(), l = L.l, row = MP + b;
    const bf16* zrow = L.Z + (size_t)row * ZW; bf16* yrow = L.YC + (size_t)row * DM; const Args& A = *L.A;
    LAS float* red = (LAS float*)F.lds;
    const float u = bf2f(zrow[ZC_GU + tid]), v = bf2f(zrow[ZC_GV + tid]);
    const float ss = block_sum(red, v * v, tid, 8);
    const float vn = v * __builtin_amdgcn_rsqf(ss * (1.f / 512.f) + pg8::RMS_EPS) * A.in[I_SGNG][l * 512 + tid];
    L.out[O_SCV + (size_t)(l * NS + b) * 512 + tid] = vn;
    const int g = tid >> 7;
    yrow[1024 + tid] = cvt1(u * (A.in[I_SGW][(size_t)(l * 4 + g) * 16384] * vn + A.in[I_SGB][(l * 4 + g) * 128]));
    __syncthreads();
}
DI void sample_delta(Frame& F, const Lyr& L, int b, int h) {
    const int tid = opaque_tid(), l = L.l, row = MP + b;
    const bf16* zrow = L.Z + (size_t)row * ZW; const float* zab = L.ZAB + (size_t)row * 8; bf16* yrow = L.YC + (size_t)row * DM; const Args& A = *L.A;
    LAS float* fl = (LAS float*)F.lds; LAS float* red = fl; LAS float* q_l = fl + 16; LAS float* k_l = fl + 144; LAS float* v_l = fl + 272; LAS float* U_l = fl + 400; LAS float* part = fl + 528;
    float y = 0.f;
    if (tid < 384) { const int wh = tid >> 7, d = tid & 127, ch = wh * 512 + h * 128 + d; const float x = bf2f(zrow[ZC_DQ + ch]);
        const float* sc0 = A.in[I_SC] + (size_t)(l * NS + b) * 3 * 1536 + ch; const float* cw = A.in[I_CONVW] + (size_t)l * 4 * 1536 + ch;
        const float b0 = sc0[0], b1 = sc0[1536], b2 = sc0[3072];
        y = siluf_(cw[0] * b0 + cw[1536] * b1 + cw[3072] * b2 + cw[4608] * x);
        float* oc = L.out + O_SC + (size_t)(l * NS + b) * 3 * 1536 + ch; oc[0] = b1; oc[1536] = b2; oc[3072] = x; }
    const float ssq = block_sum(red, y * y, tid, 2);
    if (tid < 128) q_l[tid] = y * __builtin_amdgcn_rsqf(ssq + pg8::RMS_EPS) * 0.08838834764831845f;
    else if (tid < 256) k_l[tid - 128] = y * __builtin_amdgcn_rsqf(ssq + pg8::RMS_EPS);
    else if (tid < 384) v_l[tid - 256] = y;
    const float gg = -__expf(A.in[I_ALOG][l * 4 + h]) * softplusf_(zab[h] + A.in[I_DTB][l * 4 + h]);
    const float eg = __expf(gg), beta = sigmoidf_(zab[4 + h]);
    __syncthreads();
    const int dks = tid >> 5, dv4 = (tid & 31) * 4;
    const GAS f32x4* S0 = (const GAS f32x4*)(A.in[I_SD] + ((size_t)(l * NS + b) * 4 + h) * 16384 + (size_t)(dks * 8) * 128 + dv4);
    f32x4 s[8]; f32x4 ks = {0.f, 0.f, 0.f, 0.f};
#pragma unroll
    for (int i = 0; i < 8; ++i) s[i] = S0[i * 32];
#pragma unroll
    for (int i = 0; i < 8; ++i) ks += s[i] * k_l[dks * 8 + i];
    *(LAS f32x4*)(part + dks * 128 + dv4) = ks;
    __syncthreads();
    if (tid < 128) { float t = 0.f;
#pragma unroll
        for (int i = 0; i < 16; ++i) t += part[i * 128 + tid];
        U_l[tid] = beta * (v_l[tid] - eg * t); }
    __syncthreads();
    {
        const f32x4 U = *(const LAS f32x4*)(U_l + dv4); f32x4 o = {0.f, 0.f, 0.f, 0.f};
        GAS f32x4* S1 = (GAS f32x4*)(L.out + O_SD + ((size_t)(l * NS + b) * 4 + h) * 16384 + (size_t)(dks * 8) * 128 + dv4);
#pragma unroll
        for (int i = 0; i < 8; ++i) { const f32x4 sn = s[i] * eg + U * k_l[dks * 8 + i]; S1[i * 32] = sn; o += sn * q_l[dks * 8 + i]; }
        *(LAS f32x4*)(part + dks * 128 + dv4) = o;
    }
    __syncthreads();
    float o = 0.f;
    if (tid < 128) {
#pragma unroll
        for (int i = 0; i < 16; ++i) o += part[i * 128 + tid]; }
    const float so = block_sum(red, o * o, tid, 2);
    if (tid < 128) yrow[1536 + h * 128 + tid] = cvt1(o * __builtin_amdgcn_rsqf(so * (1.f / 128.f) + pg8::RMS_EPS) * A.in[I_DNG][l * 128 + tid] * siluf_(bf2f(zrow[ZC_DG + h * 128 + tid])));
    __syncthreads();
}
DI void sample_sub(Frame& F, const Lyr& L, int it) {
    const int part = it >> 5, b = it & 31;
    if (part < 4) sample_delta(F, L, b, part);
    else if (part == 4) sample_attn(F, L, b);
    else if (part == 5) sample_ssm(F, L, b);
    else sample_sgate(F, L, b);
}
enum { TH_IN = 0, TH_BR = 1, TH_RES = 2, TH_FF1 = 3 };
struct ThinArgs {
    const bf16* X; const bf16* Wt; int N, K;
    int first, stride;
    bf16* Z; float* ZAB; bf16* G; bf16* GS; bf16* H; bf16* XB;
    const float* R; float* Xs;
    const float* ssq_in; float* ssq_out;
};
template <int MODE>
DI void thin_gemm(Frame& F, const ThinArgs& T) {
    constexpr int NC = (MODE == TH_BR || MODE == TH_RES) ? 1 : 2;
    const int tid = opaque_tid(), lane = tid & 63, w = F.wave, r16 = lane & 15, q4 = lane >> 4;
    LAS float* red = (LAS float*)F.lds;
    LAS float* sqs = (LAS float*)(F.lds + 32768);
    LAS float* rsl = (LAS float*)(F.lds + 32768 + 4096);
    const int ncg = T.N / (16 * NC), K = T.K, kw = K / 8, nst = kw / 32;
    if (T.first >= ncg) return;
    if (MODE == TH_IN || MODE == TH_FF1) {
        const int row = tid >> 4, part = tid & 15; const f32x4 v = *(const GAS f32x4*)(T.ssq_in + row * 128 + part * 8), v2 = *(const GAS f32x4*)(T.ssq_in + row * 128 + part * 8 + 4);
        float s = ((v[0] + v[1]) + (v[2] + v[3])) + ((v2[0] + v2[1]) + (v2[2] + v2[3]));
        s += __shfl_xor(s, 1); s += __shfl_xor(s, 2); s += __shfl_xor(s, 4); s += __shfl_xor(s, 8);
        if (part == 0) rsl[row] = __builtin_amdgcn_rsqf(s * (1.0f / 2048.0f) + pg8::RMS_EPS);
        __syncthreads();
    }
    for (int cg = T.first; cg < ncg; cg += T.stride) {
        if (MODE == TH_IN && cg >= 137 && cg < 144) continue;
        const GAS bf16x8* wp0 = (const GAS bf16x8*)(T.Wt + (size_t)(cg * 16 * NC + r16) * K + w * kw + 8 * q4);
        const GAS bf16x8* wp1 = (const GAS bf16x8*)(T.Wt + (size_t)(cg * 16 * NC + (NC == 2 ? 16 : 0) + r16) * K + w * kw + 8 * q4);
        const GAS bf16x8* x0 = (const GAS bf16x8*)(T.X + (size_t)r16 * K + w * kw + 8 * q4);
        const GAS bf16x8* x1 = (const GAS bf16x8*)(T.X + (size_t)(16 + r16) * K + w * kw + 8 * q4);
        f32x4 a00 = {0.f, 0.f, 0.f, 0.f}, a01 = a00, a10 = a00, a11 = a00;
#pragma unroll 8
        for (int s = 0; s < nst; ++s) { const bf16x8 w0 = wp0[4 * s], xa = x0[4 * s], xb = x1[4 * s];
            a00 = MFMA16(w0, xa, a00); a01 = MFMA16(w0, xb, a01);
            if (NC == 2) { const bf16x8 w1 = wp1[4 * s]; a10 = MFMA16(w1, xa, a10); a11 = MFMA16(w1, xb, a11); } }
        LAS f32x4* rw = (LAS f32x4*)red + (w * 4) * 64 + lane;
        rw[0] = a00; rw[64] = a01; if (NC == 2) { rw[128] = a10; rw[192] = a11; }
        __syncthreads();
#pragma unroll
        for (int o = 0; o < NC; ++o) {
            const int e = tid + 512 * o, t = e >> 8, ln = (e >> 2) & 63, reg = e & 3, i = 16 * (t & 1) + (ln & 15), c = cg * 16 * NC + 16 * (t >> 1) + 4 * (ln >> 4) + reg;
            float v = 0.f;
            if (MODE == TH_BR) {
#pragma unroll
                for (int b = 0; b < 4; ++b) { const float g = bf2f(T.G[(size_t)i * 8192 + b * 2048 + c]);
                    v += g * (red[(((2 * b) * 4 + t) * 64 + ln) * 4 + reg] + red[(((2 * b + 1) * 4 + t) * 64 + ln) * 4 + reg]); }
            } else {
#pragma unroll
                for (int ww = 0; ww < 8; ++ww) v += red[((ww * 4 + t) * 64 + ln) * 4 + reg];
            }
            if (MODE == TH_IN) { const float z = v * rsl[i];
                if (c < 4352) T.Z[(size_t)i * ZW + c] = cvt1((c >= 1280 && c < 2304) ? gelu_tanh(z) : z);
                else if (c < 4360) T.ZAB[i * 8 + (c - 4352)] = z;
                else if (c >= 4608) T.G[(size_t)i * 8192 + (c - 4608)] = cvt1(fmaxf(sigmoidf_(z), 1e-18f)); }
            else if (MODE == TH_BR) T.GS[(size_t)i * DM + c] = cvt1(v);
            else if (MODE == TH_FF1) { const float a = fmaxf(v * rsl[i], 0.f); T.H[(size_t)i * DFF + c] = cvt1(a * a); }
            else { const float x = T.R[i * DM + c] + v; T.Xs[i * DM + c] = x; T.XB[(size_t)i * DM + c] = cvt1(x); sqs[e] = x * x; }
        }
        __syncthreads();
        if (MODE == TH_RES) { if (tid < 32) { const int rh = tid >> 4, rr = tid & 15; float s = 0.f;
#pragma unroll
                for (int ch = 0; ch < NC; ++ch)
#pragma unroll
                    for (int q = 0; q < 4; ++q)
#pragma unroll
                        for (int g = 0; g < 4; ++g) s += sqs[(2 * ch + rh) * 256 + (q * 16 + rr) * 4 + g];
                T.ssq_out[tid * 128 + cg] = s; } }
    }
    __syncthreads();
}
template <class Ord> DI void fill_rstd(LAS float* rsl, const Ord& S2, const float* P) {
    LAS int* pmv = (LAS int*)(rsl + 2048);
    const int t = opaque_tid();
    if (t < 8) { pg8::Unit u_; pmv[t] = S2.next(t, u_) ? u_.pm : -1; }
    __syncthreads();
#pragma unroll
    for (int pass = 0; pass < 2; ++pass) {
        f32x4 v[2][8]; int pm[2];
#pragma unroll
        for (int j = 0; j < 2; ++j) { const int idx = t + 512 * (2 * pass + j); pm[j] = pmv[idx >> 8];
            const GAS f32x4* p = (const GAS f32x4*)(P + (size_t)((pm[j] < 0 ? 0 : pm[j]) * 256 + (idx & 255)) * 32);
#pragma unroll
            for (int i = 0; i < 8; ++i) v[j][i] = p[i]; }
#pragma unroll
        for (int j = 0; j < 2; ++j) { const int idx = t + 512 * (2 * pass + j); float s = 0.f;
#pragma unroll
            for (int i = 0; i < 8; ++i) s += (v[j][i][0] + v[j][i][1]) + (v[j][i][2] + v[j][i][3]);
            if (pm[j] >= 0) rsl[idx] = __builtin_amdgcn_rsqf(s * (1.0f / 2048.0f) + pg8::RMS_EPS); }
    }
    __syncthreads();
}
__global__ void __launch_bounds__(NWAVES * 64, 2) hybrid_fwd(Args args) {
    extern __shared__ __attribute__((aligned(16))) unsigned char lds[];
    Frame F;
    F.lds = (LAS unsigned char*)lds;
    F.MISC = (volatile LAS unsigned*)(F.lds + MISC_OFF);
    F.tid = threadIdx.x; F.lane = F.tid & 63; F.wave = __builtin_amdgcn_readfirstlane(F.tid >> 6);
    F.G = gridDim.x; { const int bx = blockIdx.x; F.vcu = (F.G % 8 == 0) ? (bx % 8) * (F.G / 8) + bx / 8 : bx; }
    F.ws = args.ws; F.ctl = (gu32*)(args.ws + WS_CTL);
    for (int u = F.tid; u < (LDS_BYTES - LDSCTL_OFF) / 4; u += NWAVES * 64) ((LAS unsigned*)(F.lds + LDSCTL_OFF))[u] = 0u;
    __syncthreads();
    XcdBarrier bar = xcd_barrier_post((unsigned*)(F.ctl + CW_BAR), F.MISC + 8);
    unsigned char* ws = args.ws;
#define GRID_BARK(k) do { GRID_BAR(); if ((PROBE_BARMASK >> (k)) & 1) GRID_BAR(); } while (0)
#define GRID_BAR() do { for (int brep_ = 0; brep_ < REP_BAR; ++brep_) { XcdBarrier b2_ = bar; asm volatile("" : "+s"(b2_.bar), "+s"(b2_.x)); xcd_barrier(b2_); } } while (0)
    const int bid = blockIdx.x, G = F.G;

#ifndef NO_P0
    for (int rep_ = 0; rep_ < REP_P0; ++rep_) { p0_prologue(F, args); if (rep_ + 1 < REP_P0) GRID_BAR(); }
#endif
    GRID_BARK(0);

#pragma unroll 1
    for (int l = 0; l < DEPTH; ++l) {
        { GAS unsigned char* wsg_ = (GAS unsigned char*)args.ws; asm volatile("" : "+s"(wsg_)); ws = (unsigned char*)wsg_; }
        float* ssq = (float*)(ws + WS_SSQP);
        bf16* XB = (bf16*)(ws + WS_XB); bf16* Zb = (bf16*)(ws + WS_Z); bf16* Gb = (bf16*)(ws + WS_G); bf16* YC = (bf16*)(ws + WS_YCAT); bf16* GS = (bf16*)(ws + WS_GS); bf16* Hb = (bf16*)(ws + WS_H);
        float* ZAB = (float*)(ws + WS_ZAB);
        float* outp; { GAS float* og_ = (GAS float*)args.out; asm volatile("" : "+s"(og_)); outp = (float*)og_; }
        float* Xp = outp + O_YP; float* Xs = outp + O_YS;
        Lyr L; L.l = l; L.Z = Zb; L.ZAB = ZAB; L.YC = YC; L.cosT = (const float*)(ws + WS_ROPE); L.sinT = L.cosT + 4097 * 32; L.A = &args; L.out = outp; L.ws = ws;
        float* ssqs = (float*)(ws + WS_SSQS);
        ThinArgs T{}; T.Z = Zb + (size_t)MP * ZW; T.ZAB = ZAB + (size_t)MP * 8; T.G = Gb + (size_t)MP * GW; T.GS = GS + (size_t)MP * DM; T.H = Hb + (size_t)MP * DFF; T.XB = XB + (size_t)MP * DM; T.Xs = Xs; T.first = F.vcu; T.stride = G;
        {
            pg8::Gemm g{XB, (const bf16*)(ws + WS_WIN) + (size_t)l * NINP * DM, MP, NINP, DM};
            LAS float* rsl = (LAS float*)(F.lds + RING_BYTES);
#pragma unroll 1
            for (int half = 0; half < 2; ++half) {
                pg8::SplitOrder S; S.init(G, bid, half ? 768 : 0, half ? 832 : 768);
                fill_rstd(rsl, S, ssq + (size_t)(2 * l) * MPAD * 32);
                pg8::EpiIn E{Zb, ZAB, Gb, rsl, (float*)(ws + WS_SGQ)};
#ifndef NO_GIN
                for (int rep_ = 0; rep_ < REP_GIN; ++rep_)
                pg8::gemm_phase<pg8::EpiIn, pg8::SplitOrder, true, true>(F.lds + RING_OFF, g, S, E);
#endif
                if (half == 0) GRID_BARK(1);
            }
            T.X = XB + (size_t)MP * DM; T.Wt = g.Bt; T.N = NINP; T.K = DM; T.ssq_in = ssqs + (2 * l) * 4096;
            { const int late = 832 % G;
              if (G > late) { T.first = bid >= late ? bid - late : 1 << 30; T.stride = G - late; } }
            for (int rep_ = 0; rep_ < REP_THIN; ++rep_) thin_gemm<TH_IN>(F, T);
            T.first = F.vcu; T.stride = G;
        }
        {
            const int late = 832 % G, early = G - late;
            for (int rep_ = 0; rep_ < REP_A; ++rep_)
            for (int it = (bid >= late ? bid - late : 768); ; ) {
                if (it < 768) {
#ifndef NO_DPREP
                if (it < 512) dprep_item(F, L, it); else
#endif
#ifndef NO_SSM1
                { ssm_pass1_task(F, L, (it - 512) * 8 + F.wave); __syncthreads(); }
#else
                {}
#endif
                }
                __syncthreads();
                if (opaque_tid() == 0) F.MISC[16] = __hip_atomic_fetch_add(F.ctl + CW_QUEUE + 64 * l, 1u, __ATOMIC_RELAXED, __HIP_MEMORY_SCOPE_AGENT);
                __syncthreads();
                it = early + (int)F.MISC[16];
                if (it >= 768) break;
            }
        }
        GRID_BARK(2);
        for (int rep_ = 0; rep_ < REP_B; ++rep_) {
#ifndef NO_DSCAN
        if (bid < 8) { for (int r2_ = 0; r2_ < REP_SCAN; ++r2_) dscan_wg(F, L, bid);
#if PROBE_DET
            dscan_wg(F, L, bid, (WS_H - WS_OD) / 4);
#endif
#if PROBE_HS >= 0
            dscan_wg(F, L, bid, (WS_H - WS_OD) / 4, 1);
#endif
#if PROBE_ENDDLY
            for (int q_ = 0; q_ < PROBE_ENDDLY; ++q_) __builtin_amdgcn_s_sleep(127);
#endif
        }
        else
#endif
        for (int it = bid - 8; it < 864; ) {
#ifndef NO_SSM2
            if (it < 256) { for (int r2_ = 0; r2_ < REP_BOTH; ++r2_) ssm_pass2_item(F, L, it); } else
#endif
#ifndef NO_ATTN
            if (it < 384) { if (it >= 256) attn_item(F, L, it - 256); } else
#endif
#ifndef NO_SAMPLE
            if (it < 608) { if (it >= 384) for (int r2_ = 0; r2_ < REP_SAMP; ++r2_) sample_sub(F, L, it - 384); } else
#endif
#ifndef NO_SGATE
            { if (it >= 608) sgate_item(F, L, it - 608); }
#else
            {}
#endif
            __syncthreads();
            if (opaque_tid() == 0) F.MISC[16] = __hip_atomic_fetch_add(F.ctl + CW_QUEUE + 64 * l + 16, 1u, __ATOMIC_RELAXED, __HIP_MEMORY_SCOPE_AGENT);
            __syncthreads();
            it = (G - 8) + (int)F.MISC[16];
        }
        }
        GRID_BARK(3);
        if (PROBE_BAR2) GRID_BAR();
#if PROBE_DET
        det_compare(F, L);
#endif
#ifndef NO_DPOST
        dpost_rows(F, L);
#endif
        GRID_BARK(4);
        {
            pg8::Gemm g{YC, (const bf16*)(ws + WS_WB) + (size_t)l * DM * DM, MP, DM, DM}; pg8::StaticOrder S; S.init(MP, DM, G, bid);
            pg8::EpiGate E{Gb, GS};
#ifndef NO_GBR
            for (int rep_ = 0; rep_ < REP_G3; ++rep_)
            pg8::gemm_phase<pg8::EpiGate, pg8::StaticOrder, true, true>(F.lds + RING_OFF, g, S, E);
#endif
            T.X = YC + (size_t)MP * DM; T.Wt = g.Bt; T.N = DM; T.K = DM;
            for (int rep_ = 0; rep_ < REP_THIN; ++rep_) thin_gemm<TH_BR>(F, T);
        }
        GRID_BARK(5);
        {
            pg8::Gemm g{GS, (const bf16*)(ws + WS_WO) + (size_t)l * DM * DM, MP, DM, DM}; pg8::StaticOrder S; S.init(MP, DM, G, bid);
            pg8::EpiRes E{l == 0 ? args.in[I_XP] : Xp, l == 0 ? args.in[I_XS] : Xs, Xp, Xs, XB, ssq + (size_t)(2 * l + 1) * MPAD * 32};
#ifndef NO_GRES
            if (REP_G3 > 1) { pg8::EpiRes E2 = E; E2.Xp = (float*)(ws + 1100 * MiB); E2.XB = (bf16*)(ws + 1170 * MiB); E2.ssq_out = (float*)(ws + 1210 * MiB);
                pg8::gemm_phase<pg8::EpiRes, pg8::StaticOrder, true, true>(F.lds + RING_OFF, g, S, E2); }
            pg8::gemm_phase<pg8::EpiRes, pg8::StaticOrder, true, true>(F.lds + RING_OFF, g, S, E);
#endif
            T.X = GS + (size_t)MP * DM; T.Wt = g.Bt; T.N = DM; T.K = DM; T.R = l == 0 ? args.in[I_XS] : Xs; T.ssq_out = ssqs + (2 * l + 1) * 4096;
            thin_gemm<TH_RES>(F, T);
        }
        GRID_BARK(6);
        {
            pg8::Gemm g{XB, (const bf16*)(ws + WS_W1) + (size_t)l * DFF * DM, MP, DFF, DM}; pg8::StaticOrder S; S.init(MP, DFF, G, bid);
            LAS float* rsl = (LAS float*)(F.lds + RING_BYTES);
            { pg8::StaticOrder S2; S2.init(MP, DFF, G, bid); fill_rstd(rsl, S2, ssq + (size_t)(2 * l + 1) * MPAD * 32); }
            pg8::EpiFf1 E{Hb, rsl};
#ifndef NO_GFF1
            for (int rep_ = 0; rep_ < REP_GFF1; ++rep_)
            pg8::gemm_phase<pg8::EpiFf1, pg8::StaticOrder, true, true>(F.lds + RING_OFF, g, S, E);
#endif
            T.X = XB + (size_t)MP * DM; T.Wt = g.Bt; T.N = DFF; T.K = DM; T.ssq_in = ssqs + (2 * l + 1) * 4096;
            for (int rep_ = 0; rep_ < REP_THIN; ++rep_) thin_gemm<TH_FF1>(F, T);
        }
        GRID_BARK(7);
        {
            pg8::Gemm g{Hb, (const bf16*)(ws + WS_W2) + (size_t)l * DM * DFF, MP, DM, DFF}; pg8::StaticOrder S; S.init(MP, DM, G, bid);
            pg8::EpiRes E{Xp, Xs, Xp, Xs, XB, ssq + (size_t)(2 * l + 2) * MPAD * 32};
#ifndef NO_GRES
            if (REP_G3 > 1) { pg8::EpiRes E2 = E; E2.Xp = (float*)(ws + 1100 * MiB); E2.XB = (bf16*)(ws + 1170 * MiB); E2.ssq_out = (float*)(ws + 1210 * MiB);
                pg8::gemm_phase<pg8::EpiRes, pg8::StaticOrder, true, true>(F.lds + RING_OFF, g, S, E2); }
            pg8::gemm_phase<pg8::EpiRes, pg8::StaticOrder, true, true>(F.lds + RING_OFF, g, S, E);
#endif
            T.X = Hb + (size_t)MP * DFF; T.Wt = g.Bt; T.N = DM; T.K = DFF; T.R = Xs; T.ssq_out = ssqs + (2 * l + 2) * 4096;
            thin_gemm<TH_RES>(F, T);
        }
        GRID_BARK(8);
    }
#if PROBE_DET
    if (bid == 0 && opaque_tid() == 0) {
        unsigned* C = (unsigned*)(args.ws + WS_CTL) + 1024;
        const unsigned cnt = __hip_atomic_load(C, __ATOMIC_RELAXED, __HIP_MEMORY_SCOPE_AGENT), early = __hip_atomic_load(C + 1, __ATOMIC_RELAXED, __HIP_MEMORY_SCOPE_AGENT), mask = __hip_atomic_load(C + 2, __ATOMIC_RELAXED, __HIP_MEMORY_SCOPE_AGENT);
        if (cnt) {
            const size_t offs[16] = {O_YP, O_YS, O_PK, O_PV, O_PSR, O_PSI, O_PD, O_PC, O_PCV, O_SK, O_SV, O_SSR, O_SSI, O_SD, O_SC, O_SCV};
            int idx;
            if (PROBE_DET == 1) { idx = 1; unsigned c = cnt; while (c > 1 && idx < 15) { c >>= 1; ++idx; } }
            else if (PROBE_DET == 2) idx = (int)((64u - early) >> 2);
            else idx = __builtin_popcount(mask) > 15 ? 15 : __builtin_popcount(mask);
            size_t o = O_YP; for (int i = 0; i < 16; ++i) o = (i == idx) ? offs[i] : o;
            ((float*)args.out)[o] = __builtin_nanf("");
        }
    }
#endif
}

extern "C" void kernel_launch(void* const* d_in, const int* in_sizes, int n_in, void* d_out, int out_size, void* d_ws, size_t ws_size, hipStream_t stream) {
    static int grid = 0;
    if (grid == 0) {
        if (n_in != 35 || out_size != (int)O_END || ws_size < WS_END) { fprintf(stderr, "kernel_launch: unexpected problem shape (n_in %d, out %d, ws %zu)\n", n_in, out_size, ws_size); grid = -1; return; }
        int dev = 0, cus = 0, per_cu = 0;
        if (hipGetDevice(&dev) != hipSuccess || hipDeviceGetAttribute(&cus, hipDeviceAttributeMultiprocessorCount, dev) != hipSuccess) { grid = -1; return; }
        if (hipFuncSetAttribute((const void*)hybrid_fwd, hipFuncAttributeMaxDynamicSharedMemorySize, LDS_BYTES) != hipSuccess) { grid = -1; return; }
        if (hipOccupancyMaxActiveBlocksPerMultiprocessor(&per_cu, (const void*)hybrid_fwd, NWAVES * 64, LDS_BYTES) != hipSuccess || per_cu < 1)
            fprintf(stderr, "kernel_launch: occupancy query reports %d workgroups per CU\n", per_cu);
        (void)hipGetLastError();
        grid = cus;
    }
    if (grid < 0) return;
    if (hipMemsetAsync((char*)d_ws + WS_CTL, 0, CTL_ZERO_BYTES, stream) != hipSuccess) return;
    Args a{};
    for (int i = 0; i < 35; ++i) a.in[i] = (const float*)d_in[i];
    a.out = (float*)d_out; a.ws = (unsigned char*)d_ws;
    hipLaunchKernelGGL(hybrid_fwd, dim3(grid), dim3(NWAVES * 64), LDS_BYTES, stream, a);
}
```

```cpp
#include <hip/hip_runtime.h>
#include <cstdio>
#include <cstdint>
#ifndef REP_P0
#define REP_P0 1
#endif
#ifndef REP_A
#define REP_A 1
#endif
#ifndef REP_B
#define REP_B 1
#endif
#ifndef REP_GIN
#define REP_GIN 1
#endif
#ifndef REP_GFF1
#define REP_GFF1 1
#endif
#ifndef REP_THIN
#define REP_THIN 1
#endif
#ifndef REP_BAR
#define REP_BAR 1
#endif
#ifndef REP_G3
#define REP_G3 1
#endif
#ifndef REP_DPREP
#define REP_DPREP 1
#endif
#ifndef REP_AOTH
#define REP_AOTH 1
#endif
#ifndef REP_SCAN
#define REP_SCAN 1
#endif
#ifndef REP_BOTH
#define REP_BOTH 1
#endif
#ifndef PG8_B_AUX
#define PG8_B_AUX 0
#endif
#ifndef REP_SAMP
#define REP_SAMP 1
#endif
#ifndef PROBE_MFMA2
#define PROBE_MFMA2 0
#endif
#ifndef PROBE_LDS2
#define PROBE_LDS2 0
#endif
#ifndef PROBE_LDLY
#define PROBE_LDLY 0
#endif
#ifndef PROBE_CDLY
#define PROBE_CDLY 0
#endif
#ifndef PROBE_BAR2
#define PROBE_BAR2 0
#endif
#ifndef PROBE_ODLY
#define PROBE_ODLY 0
#endif
#ifndef PROBE_GFRAG
#define PROBE_GFRAG 0
#endif
#ifndef PROBE_ENDDLY
#define PROBE_ENDDLY 0
#endif
#ifndef PROBE_VMCAP
#define PROBE_VMCAP 0
#endif
#ifndef PROBE_WT
#define PROBE_WT 0
#endif
#ifndef PROBE_DET
#define PROBE_DET 0
#endif
#ifndef PROBE_CK
#define PROBE_CK 0
#endif
#ifndef PROBE_CKMODE
#define PROBE_CKMODE 0
#endif
#ifndef PROBE_DRAIN
#define PROBE_DRAIN 0
#endif
#ifndef PROBE_BARMASK
#define PROBE_BARMASK 0
#endif
#ifndef PROBE_HS
#define PROBE_HS -1
#endif
#ifndef PROBE_V0
#define PROBE_V0 0
#endif
#ifndef PROBE_INJ_L
#define PROBE_INJ_L 0
#endif
#ifndef PROBE_INJ_K
#define PROBE_INJ_K 10
#endif
#ifndef PROBE_M0NOP
#define PROBE_M0NOP 0
#endif
#ifndef PROBE_WTE
#define PROBE_WTE 0
#endif
#ifndef PROBE_NTS
#define PROBE_NTS 0
#endif
namespace pg8 {
#define PG8_LAS __attribute__((address_space(3)))
typedef unsigned short bf16_t;
typedef short bf16x8 __attribute__((ext_vector_type(8)));
typedef float f32x4 __attribute__((ext_vector_type(4)));
typedef unsigned u32x4 __attribute__((ext_vector_type(4)));
constexpr int BM = 256, BK = 64, HALF = 128, HTB = HALF * BK * 2  , STAGE_BYTES = 8 * HTB, NXCD = 8, WGM = 8;

__host__ __device__ __forceinline__ int lds_byte(int r, int c) { const int st = (r >> 4) * 2 + (c >> 5), rr = r & 15, cc = c & 31, ob = rr * 64 + cc * 2; return st * 1024 + (ob ^ (((ob >> 9) & 1) << 5)); }
__host__ __device__ __forceinline__ void stage_rc(int b, int& R, int& C) { const int st = b / 1024, sb = b % 1024, swz = sb ^ (((sb >> 9) & 1) << 5); R = (st >> 1) * 16 + swz / 64; C = (st & 1) * 32 + (swz % 64) / 2; }
__host__ __device__ __forceinline__ int perm32(int rho) { const int n = rho >> 4, i = rho & 15; return 8 * (i >> 2) + 4 * n + (i & 3); }

struct Unit { int pm, pn, ui; };
struct Gemm { const bf16_t* A; const bf16_t* Bt; int M, N, K; };

struct StaticOrder {
    int nM, nN, nwg, G, c;
    __host__ __device__ __forceinline__ void init(int M, int N, int G_, int c_) { nM = M / BM; nN = N / BM; nwg = nM * nN; G = G_; c = c_; }
    __host__ __device__ __forceinline__ bool next(int i, Unit& u) const {
        const long L = (long)i * G + c; if (L >= nwg) return false;
        int wgid = (int)L; { const int q = nwg / NXCD, r = nwg % NXCD, xcd = wgid % NXCD, off = wgid / NXCD; wgid = (xcd < r ? xcd * (q + 1) : r * (q + 1) + (xcd - r) * q) + off; }
        const int nig = WGM * nN, gid = wgid / nig, fm = gid * WGM, gsz = (nM - fm) < WGM ? (nM - fm) : WGM;
        u.pm = fm + ((wgid % nig) % gsz); u.pn = (wgid % nig) / gsz; u.ui = i; return true;
    }
    __device__ __forceinline__ void a_ready(const Unit&) const {}
    __device__ __forceinline__ void done(const Unit&) const {}
};

struct SplitOrder {
    int G, c, L0, cnt;
    __host__ __device__ __forceinline__ void init(int G_, int c_, int L0_, int cnt_) { G = G_; c = c_; L0 = L0_; cnt = cnt_; }
    static __host__ __device__ __forceinline__ void map_grid(int L, int nM, int nN, int pn0, Unit& u) {
        const int nwg = nM * nN; int wgid = L; { const int q = nwg / NXCD, r = nwg % NXCD, xcd = wgid % NXCD, off = wgid / NXCD; wgid = (xcd < r ? xcd * (q + 1) : r * (q + 1) + (xcd - r) * q) + off; }
        const int nig = WGM * nN, gid = wgid / nig, fm = gid * WGM, gsz = (nM - fm) < WGM ? (nM - fm) : WGM;
        u.pm = fm + ((wgid % nig) % gsz); u.pn = pn0 + (wgid % nig) / gsz;
    }
    __host__ __device__ __forceinline__ bool next(int i, Unit& u) const {
        const int l = i * G + c; if (l >= cnt) return false;
        const int L = L0 + l;
        if (L < 576) map_grid(L, 32, 18, 0, u); else map_grid(L - 576, 32, 32, 18, u);
        u.ui = i; return true;
    }
    __device__ __forceinline__ void a_ready(const Unit&) const {}
    __device__ __forceinline__ void done(const Unit&) const {}
};
typedef float f32x2 __attribute__((ext_vector_type(2)));
typedef __bf16 bf16x2_t __attribute__((ext_vector_type(2)));
#if PROBE_NTS
#define PG8_ST16(p, v) __builtin_nontemporal_store((v), (p))
#else
#define PG8_ST16(p, v) (*(p) = (v))
#endif
__device__ __forceinline__ unsigned cvt_pk_bf16(float lo, float hi) { f32x2 v = {lo, hi}; bf16x2_t b = __builtin_convertvector(v, bf16x2_t); return __builtin_bit_cast(unsigned, b); }
__device__ __forceinline__ float bflo(unsigned w) { return __uint_as_float(w << 16); }
__device__ __forceinline__ float bfhi(unsigned w) { return __uint_as_float(w & 0xffff0000u); }
constexpr int MROWS = 8224;
constexpr float RMS_EPS = 1e-6f;

__device__ __forceinline__ float row_rstd(const float* P, int row) {
    const f32x4* p = (const f32x4*)(P + (size_t)row * 32); float s = 0.f;
#pragma unroll
    for (int i = 0; i < 8; ++i) { const f32x4 v = p[i]; s += (v[0] + v[1]) + (v[2] + v[3]); }
    return __builtin_amdgcn_rsqf(s * (1.0f / 2048.0f) + RMS_EPS);
}
struct EpiIn {
    static constexpr bool PERM = true, AFTER_DRAIN = false, HOOK = false;
    bf16_t* Z; float* ZAB; bf16_t* G; const PG8_LAS float* rsl;
    float* SGQ;
    static __device__ __forceinline__ float gelu_t(float x) { const float t = 1.5957691216057308f * (x + 0.044715f * x * x * x); return x * __builtin_amdgcn_rcpf(1.0f + __expf(-t)); }
    __device__ __forceinline__ void operator()(const f32x4 (&acc)[2][2][4][2], const Unit& u, int wr, int wc, int fr, int fq) const {
        const int row0 = u.pm * BM + wr * 64 + fr, colw = wc * 32 + 8 * fq;
        const bool isg = u.pn >= 5 && u.pn <= 8;
#pragma unroll
        for (int ai = 0; ai < 2; ++ai)
#pragma unroll
            for (int m = 0; m < 4; ++m) { const int row = row0 + ai * HALF + m * 16;
                const float rs = rsl[u.ui * BM + (row - u.pm * BM)];
                float sq = 0.f;
#pragma unroll
                for (int bj = 0; bj < 2; ++bj) { f32x4 v0 = acc[ai][bj][m][0] * rs, v1 = acc[ai][bj][m][1] * rs; const int col = colw + bj * HALF;
                    if (u.pn < 17) {
                        if (isg) {
#pragma unroll
                            for (int i = 0; i < 4; ++i) { v0[i] = gelu_t(v0[i]); v1[i] = gelu_t(v1[i]); }
                            sq += (v0[0] * v0[0] + v0[1] * v0[1]) + (v0[2] * v0[2] + v0[3] * v0[3]) + (v1[0] * v1[0] + v1[1] * v1[1]) + (v1[2] * v1[2] + v1[3] * v1[3]); }
                        u32x4 w; w.x = cvt_pk_bf16(v0[0], v0[1]); w.y = cvt_pk_bf16(v0[2], v0[3]); w.z = cvt_pk_bf16(v1[0], v1[1]); w.w = cvt_pk_bf16(v1[2], v1[3]);
                        PG8_ST16((u32x4*)(Z + (size_t)row * 4352 + u.pn * BM + col), w); }
                    else if (u.pn == 17) { if (col == 0) { *(f32x4*)(ZAB + (size_t)row * 8) = v0; *(f32x4*)(ZAB + (size_t)row * 8 + 4) = v1; } }
                    else { float s[8];
#pragma unroll
                        for (int i = 0; i < 4; ++i) { s[i] = fmaxf(__builtin_amdgcn_rcpf(1.0f + __expf(-v0[i])), 1e-18f); s[4 + i] = fmaxf(__builtin_amdgcn_rcpf(1.0f + __expf(-v1[i])), 1e-18f); }
                        u32x4 w; w.x = cvt_pk_bf16(s[0], s[1]); w.y = cvt_pk_bf16(s[2], s[3]); w.z = cvt_pk_bf16(s[4], s[5]); w.w = cvt_pk_bf16(s[6], s[7]);
                        PG8_ST16((u32x4*)(G + (size_t)row * 8192 + (u.pn - 18) * BM + col), w); } }
                if (u.pn == 7 || u.pn == 8) { sq += __shfl_xor(sq, 16); sq += __shfl_xor(sq, 32); if (fq == 0) SGQ[(size_t)row * 8 + (u.pn - 7) * 4 + wc] = sq; } }
    }
};
struct EpiFf1 {
    static constexpr bool PERM = true, AFTER_DRAIN = false, HOOK = false;
    bf16_t* H; const PG8_LAS float* rsl;
    __device__ __forceinline__ void operator()(const f32x4 (&acc)[2][2][4][2], const Unit& u, int wr, int wc, int fr, int fq) const {
        const int row0 = u.pm * BM + wr * 64 + fr, col0 = u.pn * BM + wc * 32 + 8 * fq;
#pragma unroll
        for (int ai = 0; ai < 2; ++ai)
#pragma unroll
            for (int m = 0; m < 4; ++m) { const int row = row0 + ai * HALF + m * 16;
                const float rs = rsl[u.ui * BM + (row - u.pm * BM)];
#pragma unroll
                for (int bj = 0; bj < 2; ++bj) { f32x4 v0 = acc[ai][bj][m][0] * rs, v1 = acc[ai][bj][m][1] * rs;
#pragma unroll
                    for (int i = 0; i < 4; ++i) { const float a = fmaxf(v0[i], 0.f), b = fmaxf(v1[i], 0.f); v0[i] = a * a; v1[i] = b * b; }
                    u32x4 w; w.x = cvt_pk_bf16(v0[0], v0[1]); w.y = cvt_pk_bf16(v0[2], v0[3]); w.z = cvt_pk_bf16(v1[0], v1[1]); w.w = cvt_pk_bf16(v1[2], v1[3]);
                    PG8_ST16((u32x4*)(H + (size_t)row * 8192 + col0 + bj * HALF), w); } }
    }
};
struct EpiRes {
    static constexpr bool PERM = true, AFTER_DRAIN = false, HOOK = false;
    const float* Rp; const float* Rs; float* Xp; float* Xs; bf16_t* XB; float* ssq_out;
    __device__ __forceinline__ void operator()(const f32x4 (&acc)[2][2][4][2], const Unit& u, int wr, int wc, int fr, int fq) const {
        const int row0 = u.pm * BM + wr * 64 + fr, col0 = u.pn * BM + wc * 32 + 8 * fq;
#pragma unroll
        for (int ai = 0; ai < 2; ++ai) {
            f32x4 res[4][2][2];
#pragma unroll
            for (int m = 0; m < 4; ++m) { const float* rp = Rp + (size_t)(row0 + ai * HALF + m * 16) * 2048 + col0;
#pragma unroll
                for (int bj = 0; bj < 2; ++bj) { res[m][bj][0] = *(const f32x4*)(rp + bj * HALF); res[m][bj][1] = *(const f32x4*)(rp + bj * HALF + 4); } }
#pragma unroll
            for (int m = 0; m < 4; ++m) { const int row = row0 + ai * HALF + m * 16; float* xp = Xp + (size_t)row * 2048 + col0; float sq = 0.f;
#pragma unroll
                for (int bj = 0; bj < 2; ++bj) {
                    const f32x4 v0 = acc[ai][bj][m][0] + res[m][bj][0], v1 = acc[ai][bj][m][1] + res[m][bj][1];
                    *(f32x4*)(xp + bj * HALF) = v0; *(f32x4*)(xp + bj * HALF + 4) = v1;
                    u32x4 w; w.x = cvt_pk_bf16(v0[0], v0[1]); w.y = cvt_pk_bf16(v0[2], v0[3]); w.z = cvt_pk_bf16(v1[0], v1[1]); w.w = cvt_pk_bf16(v1[2], v1[3]);
                    PG8_ST16((u32x4*)(XB + (size_t)row * 2048 + col0 + bj * HALF), w);
                    sq += (v0[0] * v0[0] + v0[1] * v0[1]) + (v0[2] * v0[2] + v0[3] * v0[3]) + (v1[0] * v1[0] + v1[1] * v1[1]) + (v1[2] * v1[2] + v1[3] * v1[3]); }
                sq += __shfl_xor(sq, 16); sq += __shfl_xor(sq, 32);
                if (fq == 0) ssq_out[(size_t)row * 32 + u.pn * 4 + wc] = sq; }
            asm volatile("" ::: "memory"); }
    }
};
struct EpiGate {
    static constexpr bool PERM = true, AFTER_DRAIN = false, HOOK = true;
    const bf16_t* G; bf16_t* GS;
    __device__ __forceinline__ void hook(f32x4 (&acc)[2][2][4][2], const Unit& u, int bidx, int wr, int wc, int fr, int fq) const {
        const bf16_t* gp0 = G + (size_t)(u.pm * BM + wr * 64 + fr) * 8192 + (size_t)(bidx - 1) * 2048 + u.pn * BM + wc * 32 + 8 * fq;
#pragma unroll
        for (int ai = 0; ai < 2; ++ai)
#pragma unroll
            for (int m = 0; m < 4; ++m)
#pragma unroll
                for (int bj = 0; bj < 2; ++bj) { const bf16_t* gp = gp0 + (size_t)(ai * HALF + m * 16) * 8192 + bj * HALF;
                    const u32x4 ga = *(const u32x4*)gp, gb = *(const u32x4*)(gp + 2048);
                    acc[ai][bj][m][0][0] *= bflo(ga.x) * __builtin_amdgcn_rcpf(bflo(gb.x)); acc[ai][bj][m][0][1] *= bfhi(ga.x) * __builtin_amdgcn_rcpf(bfhi(gb.x));
                    acc[ai][bj][m][0][2] *= bflo(ga.y) * __builtin_amdgcn_rcpf(bflo(gb.y)); acc[ai][bj][m][0][3] *= bfhi(ga.y) * __builtin_amdgcn_rcpf(bfhi(gb.y));
                    acc[ai][bj][m][1][0] *= bflo(ga.z) * __builtin_amdgcn_rcpf(bflo(gb.z)); acc[ai][bj][m][1][1] *= bfhi(ga.z) * __builtin_amdgcn_rcpf(bfhi(gb.z));
                    acc[ai][bj][m][1][2] *= bflo(ga.w) * __builtin_amdgcn_rcpf(bflo(gb.w)); acc[ai][bj][m][1][3] *= bfhi(ga.w) * __builtin_amdgcn_rcpf(bfhi(gb.w));
                    if (bj == 1 && m == 3) asm volatile("" ::: "memory"); }
        asm volatile("s_waitcnt vmcnt(0)" ::: "memory");
    }
    __device__ __forceinline__ void operator()(const f32x4 (&acc)[2][2][4][2], const Unit& u, int wr, int wc, int fr, int fq) const {
        const int row0 = u.pm * BM + wr * 64 + fr, col0 = u.pn * BM + wc * 32 + 8 * fq;
#pragma unroll
        for (int ai = 0; ai < 2; ++ai) { u32x4 g[4][2];
#pragma unroll
            for (int m = 0; m < 4; ++m)
#pragma unroll
                for (int bj = 0; bj < 2; ++bj) g[m][bj] = *(const u32x4*)(G + (size_t)(row0 + ai * HALF + m * 16) * 8192 + 3 * 2048 + col0 + bj * HALF);
#pragma unroll
            for (int m = 0; m < 4; ++m)
#pragma unroll
                for (int bj = 0; bj < 2; ++bj) { const f32x4 a0 = acc[ai][bj][m][0], a1 = acc[ai][bj][m][1]; const u32x4 gg = g[m][bj];
                    u32x4 w; w.x = cvt_pk_bf16(a0[0] * bflo(gg.x), a0[1] * bfhi(gg.x)); w.y = cvt_pk_bf16(a0[2] * bflo(gg.y), a0[3] * bfhi(gg.y));
                    w.z = cvt_pk_bf16(a1[0] * bflo(gg.z), a1[1] * bfhi(gg.z)); w.w = cvt_pk_bf16(a1[2] * bflo(gg.w), a1[3] * bfhi(gg.w));
                    PG8_ST16((u32x4*)(GS + (size_t)(row0 + ai * HALF + m * 16) * 2048 + col0 + bj * HALF), w); }
            asm volatile("" ::: "memory"); }
    }
};
template <class Epi, class Sched, bool ALIGN_EPI = false, bool SP2 = false>
__device__ __forceinline__ void gemm_phase(PG8_LAS unsigned char* lds, const Gemm g, const Sched& S, const Epi& E) {
    int tid_ = threadIdx.x; asm volatile("" : "+v"(tid_));
    const int tid = tid_, wid = __builtin_amdgcn_readfirstlane(tid >> 6), lane = tid & 63, wr = wid >> 2, wc = wid & 3, fr = lane & 15, fq = lane >> 4;
    const int K = g.K, nt = K / BK;
    unsigned voffA[2], voffB[2];
#pragma unroll
    for (int i = 0; i < 2; ++i) { int R, C; stage_rc(tid * 16 + i * 8192, R, C); const int Rb = Epi::PERM ? ((R & ~31) + perm32(R & 31)) : R;
        voffA[i] = (unsigned)(R * K + C) * 2u; voffB[i] = (unsigned)(Rb * K + C) * 2u; }
    const size_t kstep = (size_t)(BK * 2);
    const size_t hstep = (size_t)HALF * K * 2;
    const size_t tstep = 2 * hstep;
    const unsigned ldsw = (unsigned)wid * 1024u;
    const int aoff = lds_byte(wr * 64 + fr, fq * 8), boff = lds_byte(wc * 32 + fr, fq * 8);
#define PG8_SA(b, h) (((b) * 2 + (h)) * HTB)
#define PG8_SB(b, h) ((4 + (b) * 2 + (h)) * HTB)
#if PROBE_M0NOP
#define PG8_STAGE(bufoff, gbase, voff) do { _Pragma("unroll") for (int _i = 0; _i < 2; ++_i) { const unsigned la_ = (unsigned)(unsigned long)(lds + (bufoff) + ldsw + _i * 8192); const char* gb_ = (const char*)(gbase); \
        asm volatile("s_mov_b32 m0, %0\n\ts_nop 4\n\tglobal_load_lds_dwordx4 %1, %2" :: "s"(la_), "v"((voff)[_i]), "s"(gb_) : "memory", "m0"); } } while (0)
#define PG8_STAGEB(bufoff, gbase, voff) PG8_STAGE(bufoff, gbase, voff)
#else
#define PG8_STAGE(bufoff, gbase, voff) do { _Pragma("unroll") for (int _i = 0; _i < 2; ++_i) \
        __builtin_amdgcn_global_load_lds((const unsigned*)((const char*)(gbase) + (voff)[_i]), (PG8_LAS unsigned*)(lds + (bufoff) + ldsw + _i * 8192), 16, 0, 0); } while (0)
#define PG8_STAGEB(bufoff, gbase, voff) do { _Pragma("unroll") for (int _i = 0; _i < 2; ++_i) \
        __builtin_amdgcn_global_load_lds((const unsigned*)((const char*)(gbase) + (voff)[_i]), (PG8_LAS unsigned*)(lds + (bufoff) + ldsw + _i * 8192), 16, 0, PG8_B_AUX); } while (0)
#endif
#define PG8_LDA(dst, b, h) do { _Pragma("unroll") for (int m = 0; m < 4; ++m) _Pragma("unroll") for (int k = 0; k < 2; ++k) dst[m][k] = *(const PG8_LAS bf16x8*)(lds + PG8_SA(b, h) + aoff + m * 2048 + k * 1024); } while (0)
#define PG8_LDB(dst, b, h) do { _Pragma("unroll") for (int n = 0; n < 2; ++n) _Pragma("unroll") for (int k = 0; k < 2; ++k) dst[n][k] = *(const PG8_LAS bf16x8*)(lds + PG8_SB(b, h) + boff + n * 2048 + k * 1024); } while (0)
#define PG8_MMA(ai, bj, At, Bt) do { __builtin_amdgcn_s_setprio(1); _Pragma("unroll") for (int m = 0; m < 4; ++m) _Pragma("unroll") for (int n = 0; n < 2; ++n) _Pragma("unroll") for (int k = 0; k < 2; ++k) \
        acc[ai][bj][m][n] = __builtin_amdgcn_mfma_f32_16x16x32_bf16(Bt[n][k], At[m][k], acc[ai][bj][m][n], 0, 0, 0); __builtin_amdgcn_s_setprio(0); } while (0)
#if PROBE_V0
#define PG8_WAIT_V(n) asm volatile("s_waitcnt vmcnt(0)" ::: "memory")
#else
#define PG8_WAIT_V(n) asm volatile("s_waitcnt vmcnt(" #n ")" ::: "memory")
#endif
#define PG8_WAIT_L(n) asm volatile("s_waitcnt lgkmcnt(" #n ")" ::: "memory")
#define PG8_BAR __builtin_amdgcn_s_barrier()
#define PG8_SCHED __builtin_amdgcn_sched_barrier(0)
    Unit cur, nxt; int ui = 0;
    if (!S.next(0, cur)) return;
    f32x4 acc[2][2][4][2];
#pragma unroll
    for (int a = 0; a < 2; ++a)
#pragma unroll
        for (int b = 0; b < 2; ++b)
#pragma unroll
            for (int m = 0; m < 4; ++m)
#pragma unroll
                for (int n = 0; n < 2; ++n) acc[a][b][m][n] = (f32x4){0.f, 0.f, 0.f, 0.f};
    bf16x8 At[4][2], B0[2][2], B1[2][2];
    const char* cA = (const char*)g.A + (size_t)cur.pm * tstep; const char* cB = (const char*)g.Bt + (size_t)cur.pn * tstep;
    S.a_ready(cur);
    if constexpr (SP2) {
        PG8_STAGEB(PG8_SB(0, 0), cB, voffB); PG8_STAGEB(PG8_SB(0, 1), cB + hstep, voffB); PG8_STAGE(PG8_SA(0, 0), cA, voffA); PG8_STAGE(PG8_SA(0, 1), cA + hstep, voffA);
        if (wr == 1) PG8_BAR;
        PG8_WAIT_V(2); PG8_BAR;
        PG8_STAGEB(PG8_SB(1, 0), cB + kstep, voffB); PG8_STAGE(PG8_SA(1, 0), cA + kstep, voffA); PG8_STAGEB(PG8_SB(1, 1), cB + hstep + kstep, voffB);
        PG8_WAIT_V(6); PG8_BAR;
    } else {
        PG8_STAGEB(PG8_SB(0, 0), cB, voffB); PG8_STAGE(PG8_SA(0, 0), cA, voffA); PG8_STAGEB(PG8_SB(0, 1), cB + hstep, voffB); PG8_STAGE(PG8_SA(0, 1), cA + hstep, voffA);
        if (wr == 1) PG8_BAR;
        PG8_WAIT_V(4); PG8_BAR;
        PG8_STAGEB(PG8_SB(1, 0), cB + kstep, voffB); PG8_STAGE(PG8_SA(1, 0), cA + kstep, voffA); PG8_STAGEB(PG8_SB(1, 1), cB + hstep + kstep, voffB);
        PG8_WAIT_V(6); PG8_BAR;
    }
    for (;;) {
        const bool has_next = S.next(ui + 1, nxt);
        const char* nA = has_next ? (const char*)g.A + (size_t)nxt.pm * tstep : cA; const char* nB = has_next ? (const char*)g.Bt + (size_t)nxt.pn * tstep : cB;
        for (int t = 0; t < nt; t += 2) {
            const bool last = (t == nt - 2);
            const char* a1 = cA + (size_t)(t + 1) * kstep;
            const char* a2 = last ? nA : cA + (size_t)(t + 2) * kstep; const char* b2 = last ? nB : cB + (size_t)(t + 2) * kstep;
            const char* a3 = a2 + kstep; const char* b3 = b2 + kstep;
            if (last && has_next) S.a_ready(nxt);
            if constexpr (SP2) {
            PG8_LDB(B0, 0, 0); PG8_LDB(B1, 0, 1); PG8_SCHED; PG8_LDA(At, 0, 0); PG8_STAGE(PG8_SA(1, 1), a1 + hstep, voffA);
            PG8_WAIT_V(8); PG8_WAIT_L(0); PG8_BAR; PG8_MMA(0, 0, At, B0); PG8_MMA(0, 1, At, B1); PG8_BAR; PG8_SCHED;
            PG8_LDA(At, 0, 1); PG8_STAGEB(PG8_SB(0, 0), b2, voffB); PG8_STAGEB(PG8_SB(0, 1), b2 + hstep, voffB); PG8_STAGE(PG8_SA(0, 0), a2, voffA);
            PG8_WAIT_V(8); PG8_WAIT_L(0); PG8_BAR; PG8_MMA(1, 0, At, B0); PG8_MMA(1, 1, At, B1); PG8_BAR; PG8_SCHED;
            PG8_LDB(B0, 1, 0); PG8_LDB(B1, 1, 1); PG8_SCHED; PG8_LDA(At, 1, 0); PG8_STAGE(PG8_SA(0, 1), a2 + hstep, voffA);
            PG8_WAIT_V(8); PG8_WAIT_L(0); PG8_BAR; PG8_MMA(0, 0, At, B0); PG8_MMA(0, 1, At, B1); PG8_BAR; PG8_SCHED;
            PG8_LDA(At, 1, 1); PG8_STAGEB(PG8_SB(1, 0), b3, voffB); PG8_STAGEB(PG8_SB(1, 1), b3 + hstep, voffB); PG8_STAGE(PG8_SA(1, 0), a3, voffA);
            PG8_WAIT_V(8); PG8_WAIT_L(0); PG8_BAR; PG8_MMA(1, 0, At, B0); PG8_MMA(1, 1, At, B1); PG8_BAR; PG8_SCHED;
            } else {
            PG8_LDB(B0, 0, 0); PG8_SCHED; PG8_LDA(At, 0, 0); PG8_STAGE(PG8_SA(1, 1), a1 + hstep, voffA);
            PG8_WAIT_L(8); PG8_BAR; PG8_WAIT_L(0); PG8_MMA(0, 0, At, B0); PG8_BAR; PG8_SCHED;
            PG8_LDB(B1, 0, 1); PG8_STAGEB(PG8_SB(0, 0), b2, voffB);
            PG8_BAR; PG8_WAIT_L(0); PG8_MMA(0, 1, At, B1); PG8_BAR;
            PG8_LDA(At, 0, 1); PG8_STAGE(PG8_SA(0, 0), a2, voffA);
            PG8_BAR; PG8_WAIT_L(0); PG8_MMA(1, 0, At, B0); PG8_BAR; PG8_SCHED;
            PG8_STAGEB(PG8_SB(0, 1), b2 + hstep, voffB);
            PG8_WAIT_V(6); PG8_BAR; PG8_MMA(1, 1, At, B1); PG8_BAR;
            PG8_LDB(B0, 1, 0); PG8_SCHED; PG8_LDA(At, 1, 0); PG8_STAGE(PG8_SA(0, 1), a2 + hstep, voffA);
            PG8_WAIT_L(8); PG8_BAR; PG8_WAIT_L(0); PG8_MMA(0, 0, At, B0); PG8_BAR; PG8_SCHED;
            PG8_LDB(B1, 1, 1); PG8_STAGEB(PG8_SB(1, 0), b3, voffB);
            PG8_BAR; PG8_WAIT_L(0); PG8_MMA(0, 1, At, B1); PG8_BAR;
            PG8_LDA(At, 1, 1); PG8_STAGE(PG8_SA(1, 0), a3, voffA);
            PG8_BAR; PG8_WAIT_L(0); PG8_MMA(1, 0, At, B0); PG8_BAR; PG8_SCHED;
            PG8_STAGEB(PG8_SB(1, 1), b3 + hstep, voffB);
            PG8_WAIT_V(6); PG8_BAR; PG8_MMA(1, 1, At, B1); PG8_BAR;
            }
            if constexpr (Epi::HOOK) { if ((((t + 2) & 7) == 0) && !last) { E.hook(acc, cur, (t + 2) >> 3, wr, wc, fr, fq); PG8_SCHED; } }
        }
        if constexpr (ALIGN_EPI) { if (wr == 0) PG8_BAR; }
        if constexpr (!Epi::AFTER_DRAIN) { E(acc, cur, wr, wc, fr, fq); S.done(cur); }
        if (!has_next) break;
#pragma unroll
        for (int a = 0; a < 2; ++a)
#pragma unroll
            for (int b = 0; b < 2; ++b)
#pragma unroll
                for (int m = 0; m < 4; ++m)
#pragma unroll
                    for (int n = 0; n < 2; ++n) acc[a][b][m][n] = (f32x4){0.f, 0.f, 0.f, 0.f};
        cur = nxt; cA = nA; cB = nB; ++ui;
        if constexpr (ALIGN_EPI) { if (wr == 1) PG8_BAR; }
    }
    PG8_WAIT_V(0);
    if constexpr (!ALIGN_EPI) { if (wr == 0) PG8_BAR; }
    PG8_BAR;
    if constexpr (Epi::AFTER_DRAIN) { E.fused(acc, cur, wr, wc, fr, fq, lds, wid, lane); S.done(cur); }
#undef PG8_SA
#undef PG8_SB
#undef PG8_STAGE
#undef PG8_STAGEB
#undef PG8_LDA
#undef PG8_LDB
#undef PG8_MMA
#undef PG8_WAIT_V
#undef PG8_WAIT_L
#undef PG8_BAR
#undef PG8_SCHED
}
}
constexpr int NWAVES = 8;
constexpr int DM = 2048, SEQ = 4096, NB = 2, MP = NB * SEQ  , NS = 32  , MPAD = 8448, DEPTH = 4, DFF = 8192;
constexpr int NIN = 12552, NINP = 12800, ZW = 4352, GW = 8192, PASTLEN = 16384;
constexpr int ZC_Q = 0, ZC_K = 512, ZC_V = 640, ZC_SU = 768, ZC_GU = 1280, ZC_GV = 1792, ZC_DQ = 2304, ZC_DK = 2816, ZC_DV = 3328, ZC_DG = 3840;
constexpr float LOG2E = 1.4426950408889634f;

constexpr size_t MiB = 1u << 20;
constexpr size_t WS_CTL = 0, CTL_ZERO_BYTES = 1 * MiB;
constexpr size_t WS_ROPE = 1 * MiB;
constexpr size_t WS_ABAR = 3 * MiB;
constexpr size_t WS_A32 = WS_ABAR + 65536;
constexpr size_t WS_CFRAG = WS_ABAR + 131072;
constexpr size_t WS_BBAR = 4 * MiB;
constexpr size_t WS_WTRIL = 5 * MiB;
constexpr size_t WS_WG = 6 * MiB;
constexpr size_t WS_E = 8 * MiB;
constexpr size_t WS_ZAB = 12 * MiB;
constexpr size_t WS_GE = 13 * MiB;
constexpr size_t WS_WIN = 16 * MiB;
constexpr size_t WS_WB = 216 * MiB;
constexpr size_t WS_WO = 248 * MiB;
constexpr size_t WS_W1 = 280 * MiB;
constexpr size_t WS_W2 = 408 * MiB;
constexpr size_t WS_XB = 536 * MiB;
constexpr size_t WS_Z = 570 * MiB;
constexpr size_t WS_G = 642 * MiB;
constexpr size_t WS_YCAT = 774 * MiB;
constexpr size_t WS_GS = 808 * MiB;
constexpr size_t WS_H = 842 * MiB;
constexpr size_t WS_OD = 974 * MiB;
constexpr size_t WS_U0 = 990 * MiB;
constexpr size_t WS_WN = 1006 * MiB;
constexpr size_t WS_QG = 1014 * MiB;
constexpr size_t WS_QK = 1022 * MiB;
constexpr size_t WS_KE = 1026 * MiB;
constexpr size_t WS_SSQP = 1034 * MiB;
constexpr size_t WS_SSQS = 1046 * MiB;
constexpr size_t WS_SGQ = 1047 * MiB;
constexpr size_t WS_BFRAG = 1048 * MiB;
constexpr size_t WS_BU = 1049 * MiB;
constexpr size_t WS_END = 1113 * MiB;
constexpr int CW_TMO = 0;
constexpr int CW_QUEUE = 2048;
constexpr int CW_BAR = 4096;

constexpr size_t O_YP = 0, O_YS = 16777216, O_PK = O_YS + 65536, O_PV = O_PK + 131072, O_PSR = O_PV + 131072, O_PSI = O_PSR + 16384, O_PD = O_PSI + 16384,
                 O_PC = O_PD + 524288, O_PCV = O_PC + 36864, O_SK = O_PCV + 524288, O_SV = O_SK + 2097152, O_SSR = O_SV + 2097152, O_SSI = O_SSR + 262144,
                 O_SD = O_SSI + 262144, O_SC = O_SD + 8388608, O_SCV = O_SC + 589824, O_END = O_SCV + 65536;

constexpr int RING_OFF = 0, RING_BYTES = 131072;
constexpr int LDSCTL_OFF = 147456, MISC_OFF = LDSCTL_OFF + 320;
constexpr int LDS_BYTES = 148480;
static_assert(MISC_OFF + 128 <= LDS_BYTES, "LDS map");

#define GAS __attribute__((address_space(1)))
#define LAS __attribute__((address_space(3)))
typedef unsigned short bf16;
typedef unsigned v4u __attribute__((ext_vector_type(4)));
typedef float f32x4 __attribute__((ext_vector_type(4)));
typedef short bf16x8 __attribute__((ext_vector_type(8)));
typedef GAS unsigned gu32;
typedef GAS unsigned long long gu64;
#define RLX_AGENT __ATOMIC_RELAXED, __HIP_MEMORY_SCOPE_AGENT
#define LDS_WAIT() asm volatile("s_waitcnt lgkmcnt(0)" ::: "memory")
#define VM_WAIT() asm volatile("s_waitcnt vmcnt(0)" ::: "memory")
__device__ __forceinline__ unsigned long long rt() { return __builtin_amdgcn_s_memrealtime(); }
__device__ __forceinline__ unsigned f2bf(float f) { unsigned u = __builtin_bit_cast(unsigned, f); return (u + 0x7fffu + ((u >> 16) & 1u)) >> 16; }
__device__ __forceinline__ unsigned pk2(float lo, float hi) { return f2bf(lo) | (f2bf(hi) << 16); }

#define XB_TMO      128
#define XB_XCNT(j)  (256  + 64 * (j))
#define XB_XSUB(j)  (1280 + 64 * (j))
#define XB_XGEN(j)  (2304 + 64 * (j))
#define XB_TOP      3328
#define XB_TOPGEN   3392
#define XCD_BAR_WORDS 3456
#define XB_SPIN_CAP (1u << 18)

__device__ __forceinline__ unsigned xb_ld(unsigned* p)              { return __hip_atomic_load(p, __ATOMIC_RELAXED, __HIP_MEMORY_SCOPE_AGENT); }
__device__ __forceinline__ unsigned xb_add(unsigned* p, unsigned v) { return __hip_atomic_fetch_add(p, v, __ATOMIC_RELAXED, __HIP_MEMORY_SCOPE_AGENT); }
__device__ __forceinline__ unsigned xb_xcc_id() { return (unsigned)__builtin_amdgcn_s_getreg((3 << 11) | 20) & 0xFu; }
#define XB_SPIN(cond, bar) do { unsigned _sp = 0; while (cond) { __builtin_amdgcn_s_sleep(1); \
    if ((++_sp & 255u) == 0u) { if (xb_ld(&(bar)[XB_TMO])) break; if (_sp > XB_SPIN_CAP) { atomicAdd(&(bar)[XB_TMO], 1u); break; } } } } while (0)

struct XcdBarrier {
    unsigned* bar; unsigned x;
    volatile LAS unsigned* st;
};

__device__ __forceinline__ XcdBarrier xcd_barrier_post(unsigned* bar, volatile LAS unsigned* st) {
    XcdBarrier b; b.bar = bar; b.x = xb_xcc_id(); b.st = st;
    if (threadIdx.x == 0) (void)xb_add(&bar[XB_XCNT(b.x)], 1u);
    return b;
}
__device__ __forceinline__ void xcd_barrier_complete(unsigned* bar, unsigned x, unsigned& nloc, unsigned& nx) {
    const unsigned G = gridDim.x * gridDim.y * gridDim.z;
    unsigned sum, cnt, mine, sp = 0u;
    for (;;) {
        sum = 0u; cnt = 0u; mine = 0u;
#pragma unroll
        for (unsigned j = 0; j < 16; ++j) { const unsigned c = xb_ld(&bar[XB_XCNT(j)]); sum += c; cnt += (c > 0u) ? 1u : 0u; mine = (j == x) ? c : mine; }
        if (sum == G) break;
        __builtin_amdgcn_s_sleep(1);
        if ((++sp & 255u) == 0u) { if (xb_ld(&bar[XB_TMO])) break; if (sp > XB_SPIN_CAP) { atomicAdd(&bar[XB_TMO], 1u); break; } }
    }
    nloc = mine > 0u ? mine : 1u; nx = cnt > 0u ? cnt : 1u;
}

__device__ __forceinline__ void xcd_barrier(const XcdBarrier& b) {
    asm volatile("s_waitcnt vmcnt(0)" ::: "memory");
    __syncthreads();
    if (threadIdx.x == 0) {
        unsigned* bar = b.bar;
        __builtin_amdgcn_s_waitcnt(0);
        unsigned nloc = b.st[0], nx = b.st[1];
        if (nloc == 0u) { xcd_barrier_complete(bar, b.x, nloc, nx); b.st[0] = nloc; b.st[1] = nx; }
        const unsigned old = xb_add(&bar[XB_XSUB(b.x)], 1u);
        const unsigned gen = old / nloc;
        if (old + 1u == (gen + 1u) * nloc) {
            __builtin_amdgcn_fence(__ATOMIC_RELEASE, "agent");
            asm volatile("s_waitcnt vmcnt(0)" ::: "memory");
            const unsigned og = xb_add(&bar[XB_TOP], 1u);
            const unsigned tg = og / nx;
            if (og + 1u == (tg + 1u) * nx) xb_add(&bar[XB_TOPGEN], 1u);
            else XB_SPIN(xb_ld(&bar[XB_TOPGEN]) == tg, bar);
            __builtin_amdgcn_fence(__ATOMIC_ACQUIRE, "agent");
            xb_add(&bar[XB_XGEN(b.x)], 1u);
            asm volatile("s_waitcnt vmcnt(0)" ::: "memory");
        } else {
            XB_SPIN(xb_ld(&bar[XB_XGEN(b.x)]) == gen, bar);
            __builtin_amdgcn_fence(__ATOMIC_ACQUIRE, "agent");
            asm volatile("s_waitcnt vmcnt(0)" ::: "memory");
        }
    }
    __syncthreads();
}
typedef float f32x16 __attribute__((ext_vector_type(16)));
typedef float f32x2v __attribute__((ext_vector_type(2)));
typedef unsigned v2u __attribute__((ext_vector_type(2)));
#define DI __device__ __forceinline__
#define MFMA32(a, b, c) __builtin_amdgcn_mfma_f32_32x32x16_bf16((a), (b), (c), 0, 0, 0)
#define MFMA16(a, b, c) __builtin_amdgcn_mfma_f32_16x16x32_bf16((a), (b), (c), 0, 0, 0)
DI float bf2f(unsigned short h) { return __uint_as_float((unsigned)h << 16); }
DI float bflo(unsigned w) { return __uint_as_float(w << 16); }
DI float bfhi(unsigned w) { return __uint_as_float(w & 0xffff0000u); }
DI unsigned cvtpk(float lo, float hi) { return pg8::cvt_pk_bf16(lo, hi); }
DI unsigned short cvt1(float v) { return (unsigned short)(pg8::cvt_pk_bf16(v, 0.f) & 0xffffu); }
#define CR(k) (((k) & 3) + 8 * ((k) >> 2))
DI int crow(int reg, int h) { return (reg & 3) + 8 * (reg >> 2) + 4 * h; }
DI bf16x8 pack8(float a0, float a1, float a2, float a3, float a4, float a5, float a6, float a7) {
    v4u p; p.x = cvtpk(a0, a1); p.y = cvtpk(a2, a3); p.z = cvtpk(a4, a5); p.w = cvtpk(a6, a7); return __builtin_bit_cast(bf16x8, p); }
DI bf16x8 pack_step(const f32x16& x, int s) { return s == 0 ? pack8(x[0], x[1], x[2], x[3], x[4], x[5], x[6], x[7]) : pack8(x[8], x[9], x[10], x[11], x[12], x[13], x[14], x[15]); }
DI float wave_sum(float v) {
#pragma unroll
    for (int o = 1; o < 64; o <<= 1) v += __shfl_xor(v, o);
    return v;
}
DI float wave_max(float v) {
#pragma unroll
    for (int o = 1; o < 64; o <<= 1) v = fmaxf(v, __shfl_xor(v, o));
    return v;
}
DI float gelu_tanh(float x) {
    const float t = 1.5957691216057308f * (x + 0.044715f * x * x * x);
    return x * __builtin_amdgcn_rcpf(1.0f + __expf(-t));
}
DI float sigmoidf_(float x) { return __builtin_amdgcn_rcpf(1.0f + __expf(-x)); }
DI float siluf_(float x) { return x * __builtin_amdgcn_rcpf(1.0f + __expf(-x)); }
DI float softplusf_(float x) { const float e = __expf(-fabsf(x)); const float l = e < 1e-3f ? e * (1.f - 0.5f * e) : __logf(1.f + e); return fmaxf(x, 0.f) + l; }
DI int frag_off(int row, int k, int nks) { const int rt = row >> 5, r = row & 31, ks = k >> 4, w = k & 15, h = (w >> 2) & 1, j = ((w >> 3) << 2) | (w & 3); return (((rt * nks + ks) * 64) + r + 32 * h) * 8 + j; }

DI int opaque_tid() { int t = threadIdx.x; asm volatile("" : "+v"(t)); return t; }
struct Frame {
    LAS unsigned char* lds;
    volatile LAS unsigned* MISC;
    gu32* ctl;
    unsigned char* ws;
    const float* const* in;
    int tid, lane, wave, vcu, G;
};
struct Args { const float* in[35]; float* out; unsigned char* ws;
#if PROBE_CK
    int pass;
#endif
};
enum { I_XP = 0, I_XS, I_CK, I_CV, I_SSR, I_SSI, I_SD, I_SC, I_N1G, I_WIN, I_QNG, I_KNG, I_SINK, I_LAMR, I_LAMI, I_LOGDT, I_BRE, I_BIM, I_CRE, I_CIM, I_SSMD, I_GLUW, I_GLUB,
       I_SGNG, I_SGW, I_SGB, I_CONVW, I_ALOG, I_DTB, I_DNG, I_WBR, I_WOUT, I_N2G, I_WFF1, I_WFF2 };

template <int MODE>
DI void p0_transpose_item(const float* W, int K, int Nsrc, bf16* WT, const float* gain, LAS float* scr, int kb, int nb, int lane) {
    const int k0 = 64 * kb, n0 = 32 * nb;
    const int nd = n0 + (lane & 31);
    const int ns = MODE == 1 ? (nd < 4360 ? nd : (nd < 4608 ? -1 : nd - 248)) : nd;
    float tv[32];
#pragma unroll
    for (int i = 0; i < 32; ++i) { const int kk = 2 * i + (lane >> 5); tv[i] = ns >= 0 ? W[(size_t)(k0 + kk) * Nsrc + ns] : 0.f; }
#pragma unroll
    for (int i = 0; i < 32; ++i) { const int kk = 2 * i + (lane >> 5); float v = tv[i]; if (gain) v *= gain[k0 + kk]; scr[kk * 33 + (lane & 31)] = v; }
    LDS_WAIT(); asm volatile("" ::: "memory");
    const int c = lane & 7;
#pragma unroll
    for (int j = 0; j < 4; ++j) { const int n = (lane >> 3) + 8 * j; const LAS float* s = scr + (8 * c) * 33 + n;
        v4u o; o.x = cvtpk(s[0 * 33], s[1 * 33]); o.y = cvtpk(s[2 * 33], s[3 * 33]); o.z = cvtpk(s[4 * 33], s[5 * 33]); o.w = cvtpk(s[6 * 33], s[7 * 33]);
        *(GAS v4u*)(WT + (size_t)(n0 + n) * K + k0 + 8 * c) = o; }
    LDS_WAIT(); asm volatile("" ::: "memory");
}

DI void p0_prologue(Frame& F, const Args& A) {
    LAS float* scr = (LAS float*)(F.lds + RING_OFF + F.wave * 16384);
    const int gw = F.vcu * NWAVES + F.wave, NGW = F.G * NWAVES, lane = F.lane;
    unsigned char* ws = F.ws;
    constexpr int IT_IN = 32 * 400, IT_SQ = 32 * 64, IT_W1 = 32 * 256, IT_W2 = 128 * 64, IT_GLU = 8 * 16, IT_L = IT_IN + 2 * IT_SQ + IT_W1 + IT_W2 + IT_GLU;
    for (int it = gw; it < DEPTH * IT_L; it += NGW) {
        const int l = it / IT_L; int r = it % IT_L;
        if (r < IT_IN) { p0_transpose_item<1>(A.in[I_WIN] + (size_t)l * DM * NIN, DM, NIN, (bf16*)(ws + WS_WIN) + (size_t)l * NINP * DM, A.in[I_N1G] + l * DM, scr, r / 400, r % 400, lane); continue; } r -= IT_IN;
        if (r < IT_SQ) { p0_transpose_item<0>(A.in[I_WBR] + (size_t)l * DM * DM, DM, DM, (bf16*)(ws + WS_WB) + (size_t)l * DM * DM, nullptr, scr, r / 64, r % 64, lane); continue; } r -= IT_SQ;
        if (r < IT_SQ) { p0_transpose_item<0>(A.in[I_WOUT] + (size_t)l * DM * DM, DM, DM, (bf16*)(ws + WS_WO) + (size_t)l * DM * DM, nullptr, scr, r / 64, r % 64, lane); continue; } r -= IT_SQ;
        if (r < IT_W1) { p0_transpose_item<0>(A.in[I_WFF1] + (size_t)l * DM * DFF, DM, DFF, (bf16*)(ws + WS_W1) + (size_t)l * DFF * DM, A.in[I_N2G] + l * DM, scr, r / 256, r % 256, lane); continue; } r -= IT_W1;
        if (r < IT_W2) { p0_transpose_item<0>(A.in[I_WFF2] + (size_t)l * DFF * DM, DFF, DM, (bf16*)(ws + WS_W2) + (size_t)l * DM * DFF, nullptr, scr, r / 64, r % 64, lane); continue; } r -= IT_W2;
        p0_transpose_item<0>(A.in[I_GLUW] + (size_t)l * 512 * 512, 512, 512, (bf16*)(ws + WS_WG) + (size_t)l * 512 * 512, nullptr, scr, r / 16, r % 16, lane);
    }
    float* ssq0 = (float*)(ws + WS_SSQP);
    for (int m = gw; m < MPAD; m += NGW) {
        GAS v4u* o16 = (GAS v4u*)((bf16*)(ws + WS_XB) + (size_t)m * DM) + lane;
        if (m < pg8::MROWS) {
            const float* xrow = m < MP ? A.in[I_XP] + (size_t)m * DM : A.in[I_XS] + (size_t)(m - MP) * DM;
            const GAS f32x4* xr = (const GAS f32x4*)xrow + 2 * lane;
            float s = 0.f;
#pragma unroll
            for (int j = 0; j < 4; ++j) { const f32x4 a = xr[128 * j], b = xr[128 * j + 1];
                s += (a.x * a.x + a.y * a.y) + (a.z * a.z + a.w * a.w) + (b.x * b.x + b.y * b.y) + (b.z * b.z + b.w * b.w);
                v4u o; o.x = cvtpk(a.x, a.y); o.y = cvtpk(a.z, a.w); o.z = cvtpk(b.x, b.y); o.w = cvtpk(b.z, b.w); o16[64 * j] = o; }
            s = wave_sum(s);
            if (m < MP) { if (lane < 32) ssq0[(size_t)m * 32 + lane] = lane == 0 ? s : 0.f; }
            else { float* sq = (float*)(ws + WS_SSQS) + (m - MP) * 128; sq[lane] = lane == 0 ? s : 0.f; sq[64 + lane] = 0.f; }
        } else {
#pragma unroll
            for (int j = 0; j < 4; ++j) o16[64 * j] = (v4u){0u, 0u, 0u, 0u};
            if (lane < 32) ssq0[(size_t)m * 32 + lane] = 0.f;
        }
    }
    const int gt = gw * 64 + lane, NGT = NGW * 64;
    {
        float* ct = (float*)(ws + WS_ROPE); float* st = ct + 4097 * 32;
        for (int e = gt; e < 4097 * 32; e += NGT) { const int p = e >> 5, i = e & 31; const double pos = p < 4096 ? (double)p : (double)PASTLEN;
            const float invf = powf(10000.0f, -(float)i / 32.0f); const float angf = (float)pos * invf;
            const double ang = (double)angf; const double n = rint(ang * 0.15915494309189535); const double r = ang - n * 6.283185307179586;
            ct[e] = cosf((float)r); st[e] = sinf((float)r); }
    }
    {
        f32x2v* abar = (f32x2v*)(ws + WS_ABAR); f32x2v* a32 = (f32x2v*)(ws + WS_A32); f32x2v* bbar = (f32x2v*)(ws + WS_BBAR);
        for (int e = gt; e < DEPTH * 32 * 64; e += NGT) { const int lg = e >> 6;
            const float lr = A.in[I_LAMR][e], li = A.in[I_LAMI][e], dt = expf(A.in[I_LOGDT][lg]);
            const float mag = expf(lr * dt), ar = mag * cosf(li * dt), ai = mag * sinf(li * dt);
            abar[e] = (f32x2v){ar, ai};
            const float m32 = expf(lr * dt * 32.f); a32[e] = (f32x2v){m32 * cosf(li * dt * 32.f), m32 * sinf(li * dt * 32.f)};
            const float nr = ar - 1.f, ni = ai, den = 1.f / (lr * lr + li * li); const float qr = (nr * lr + ni * li) * den, qi = (ni * lr - nr * li) * den;
            for (int c = 0; c < 16; ++c) { const float br = A.in[I_BRE][(size_t)e * 16 + c], bi = A.in[I_BIM][(size_t)e * 16 + c]; bbar[(size_t)e * 16 + c] = (f32x2v){qr * br - qi * bi, qr * bi + qi * br}; }
        }
        bf16* bfr = (bf16*)(ws + WS_BFRAG);
        for (int e = gt; e < DEPTH * 32 * 4 * 64 * 8; e += NGT) { const int j = e & 7, ln = (e >> 3) & 63, tile = (e >> 9) & 3, lg = e >> 11;
            const int pst = 32 * (tile >> 1) + (ln & 31), c = 8 * (ln >> 5) + j; const size_t src = ((size_t)lg * 64 + pst) * 16 + c;
            const float lr = A.in[I_LAMR][lg * 64 + pst], li = A.in[I_LAMI][lg * 64 + pst], dt = expf(A.in[I_LOGDT][lg]);
            const float mag = expf(lr * dt), ar = mag * cosf(li * dt), ai = mag * sinf(li * dt);
            const float nr = ar - 1.f, ni = ai, den = 1.f / (lr * lr + li * li); const float qr = (nr * lr + ni * li) * den, qi = (ni * lr - nr * li) * den;
            const float br = A.in[I_BRE][src], bi = A.in[I_BIM][src];
            bfr[e] = cvt1((tile & 1) ? qr * bi + qi * br : qr * br - qi * bi); }
        bf16* cf = (bf16*)(ws + WS_CFRAG);
        for (int e = gt; e < DEPTH * 32 * 4 * 64 * 8; e += NGT) { const int j = e & 7, ln = (e >> 3) & 63, kb = (e >> 9) & 3, lg = e >> 11;
            const int k = 32 * kb + 8 * (ln >> 4) + j, c = ln & 15, p = k >> 1;
            const float v = (k & 1) ? -A.in[I_CIM][((size_t)lg * 16 + c) * 64 + p] : A.in[I_CRE][((size_t)lg * 16 + c) * 64 + p];
            cf[e] = cvt1(v); }
    }
    {
        bf16* wt = (bf16*)(ws + WS_WTRIL);
        for (int e = gt; e < DEPTH * 4 * 128 * 128; e += NGT) { const int s = e & 127, t = (e >> 7) & 127; wt[e] = s <= t ? cvt1(A.in[I_SGW][e]) : (bf16)0; }
    }
}

#if PROBE_CK
DI void p0_xonly(Frame& F, const Args& A) {
    const int gw = F.vcu * NWAVES + F.wave, NGW = F.G * NWAVES, lane = opaque_tid() & 63;
    unsigned char* ws = F.ws;
    float* ssq0 = (float*)(ws + WS_SSQP);
    for (int m = gw; m < MPAD; m += NGW) {
        GAS v4u* o16 = (GAS v4u*)((bf16*)(ws + WS_XB) + (size_t)m * DM) + lane;
        if (m < pg8::MROWS) {
            const float* xrow = m < MP ? A.in[I_XP] + (size_t)m * DM : A.in[I_XS] + (size_t)(m - MP) * DM;
            const GAS f32x4* xr = (const GAS f32x4*)xrow + 2 * lane;
            float s = 0.f;
#pragma unroll
            for (int j = 0; j < 4; ++j) { const f32x4 a = xr[128 * j], b = xr[128 * j + 1];
                s += (a.x * a.x + a.y * a.y) + (a.z * a.z + a.w * a.w) + (b.x * b.x + b.y * b.y) + (b.z * b.z + b.w * b.w);
                v4u o; o.x = cvtpk(a.x, a.y); o.y = cvtpk(a.z, a.w); o.z = cvtpk(b.x, b.y); o.w = cvtpk(b.z, b.w); o16[64 * j] = o; }
            s = wave_sum(s);
            if (m < MP) { if (lane < 32) ssq0[(size_t)m * 32 + lane] = lane == 0 ? s : 0.f; }
            else { float* sq = (float*)(ws + WS_SSQS) + (m - MP) * 128; sq[lane] = lane == 0 ? s : 0.f; sq[64 + lane] = 0.f; }
        } else {
#pragma unroll
            for (int j = 0; j < 4; ++j) o16[64 * j] = (v4u){0u, 0u, 0u, 0u};
            if (lane < 32) ssq0[(size_t)m * 32 + lane] = 0.f;
        }
    }
}
#endif
struct Lyr {
    int l;
    const bf16* Z; const float* ZAB; bf16* YC;
    const float* cosT; const float* sinT;
    const Args* A; float* out; unsigned char* ws;
};

DI void attn_item(Frame& F, const Lyr& L, int item) {
    const int b = item >> 6, kvh = (item >> 5) & 1, blk = item & 31, tid = opaque_tid(), l = L.l;
    LAS bf16* Ks = (LAS bf16*)(F.lds); LAS bf16* VT = (LAS bf16*)(F.lds + 36864);
    {
        const int kap = tid & 255, tk = blk * 128 - 128 + kap;
        if (tid < 256) {
            if (tk >= 0) {
                const GAS v4u* src = (const GAS v4u*)(L.Z + (size_t)(b * SEQ + tk) * ZW + ZC_K + kvh * 64);
                float x[64]; float ss = 0.f;
#pragma unroll
                for (int i = 0; i < 8; ++i) { const v4u w = src[i]; x[8 * i] = bflo(w.x); x[8 * i + 1] = bfhi(w.x); x[8 * i + 2] = bflo(w.y); x[8 * i + 3] = bfhi(w.y); x[8 * i + 4] = bflo(w.z); x[8 * i + 5] = bfhi(w.z); x[8 * i + 6] = bflo(w.w); x[8 * i + 7] = bfhi(w.w); }
#pragma unroll
                for (int i = 0; i < 64; ++i) ss += x[i] * x[i];
                const float rs = __builtin_amdgcn_rsqf(ss * (1.f / 64.f) + pg8::RMS_EPS);
                const float* kg = L.A->in[I_KNG] + l * 64;
                const bool wr = blk == 31 && kap >= 128;
                GAS float* pk = (GAS float*)(L.out + O_PK + ((size_t)((l * NB + b) * 128 + (kap - 128)) * 2 + kvh) * 64);
                const GAS f32x4* ct = (const GAS f32x4*)(L.cosT + tk * 32); const GAS f32x4* st4 = (const GAS f32x4*)(L.sinT + tk * 32);
#pragma unroll
                for (int i4 = 0; i4 < 8; ++i4) { const f32x4 c = ct[i4], s = st4[i4]; float lo[4], hi[4];
#pragma unroll
                    for (int q = 0; q < 4; ++q) { const int i = 4 * i4 + q; const float x1 = x[i] * rs * kg[i], x2 = x[i + 32] * rs * kg[i + 32]; lo[q] = x1 * c[q] - x2 * s[q]; hi[q] = x2 * c[q] + x1 * s[q]; }
                    *(LAS v2u*)(Ks + kap * 72 + 4 * i4) = (v2u){cvtpk(lo[0], lo[1]), cvtpk(lo[2], lo[3])}; *(LAS v2u*)(Ks + kap * 72 + 32 + 4 * i4) = (v2u){cvtpk(hi[0], hi[1]), cvtpk(hi[2], hi[3])};
                    if (wr) { *(GAS f32x4*)(pk + 4 * i4) = (f32x4){lo[0], lo[1], lo[2], lo[3]}; *(GAS f32x4*)(pk + 32 + 4 * i4) = (f32x4){hi[0], hi[1], hi[2], hi[3]}; }
                    }
            } else {
#pragma unroll
                for (int i = 0; i < 8; ++i) *(LAS v4u*)(Ks + kap * 72 + 8 * i) = (v4u){0u, 0u, 0u, 0u};
            }
        } else {
            if (tk >= 0) {
                const GAS v4u* src = (const GAS v4u*)(L.Z + (size_t)(b * SEQ + tk) * ZW + ZC_V + kvh * 64);
#pragma unroll
                for (int i = 0; i < 8; ++i) { const v4u w = src[i]; const unsigned ww[4] = {w.x, w.y, w.z, w.w};
#pragma unroll
                    for (int q = 0; q < 4; ++q) { VT[(8 * i + 2 * q) * 264 + kap] = (bf16)(ww[q] & 0xffffu); VT[(8 * i + 2 * q + 1) * 264 + kap] = (bf16)(ww[q] >> 16); }
                    if (blk == 31 && kap >= 128) { GAS f32x4* pv = (GAS f32x4*)(L.out + O_PV + ((size_t)((l * NB + b) * 128 + (kap - 128)) * 2 + kvh) * 64) + 2 * i;
                        pv[0] = (f32x4){bflo(w.x), bfhi(w.x), bflo(w.y), bfhi(w.y)}; pv[1] = (f32x4){bflo(w.z), bfhi(w.z), bflo(w.w), bfhi(w.w)}; } }
            } else {
#pragma unroll
                for (int d = 0; d < 64; ++d) VT[d * 264 + kap] = (bf16)0;
            }
        }
    }
    __syncthreads();
    const int w = F.wave, lane = opaque_tid() & 63, r = lane & 31, h = lane >> 5, g = w >> 1, head = kvh * 4 + g;
    const float sinkl = L.A->in[I_SINK][l * 8 + head] * LOG2E;
    const float* qg = L.A->in[I_QNG] + l * 64;
#pragma unroll 1
    for (int sub = 0; sub < 2; ++sub) {
        const int q0 = (w & 1) * 64 + sub * 32, tq = blk * 128 + q0 + r;
        bf16x8 qf[4];
        {
            const GAS v4u* src = (const GAS v4u*)(L.Z + (size_t)(b * SEQ + tq) * ZW + ZC_Q + head * 64 + 8 * h);
            float x[4][8]; float ss = 0.f;
#pragma unroll
            for (int ks = 0; ks < 4; ++ks) { const v4u wv = src[2 * ks]; x[ks][0] = bflo(wv.x); x[ks][1] = bfhi(wv.x); x[ks][2] = bflo(wv.y); x[ks][3] = bfhi(wv.y); x[ks][4] = bflo(wv.z); x[ks][5] = bfhi(wv.z); x[ks][6] = bflo(wv.w); x[ks][7] = bfhi(wv.w);
#pragma unroll
                for (int j = 0; j < 8; ++j) ss += x[ks][j] * x[ks][j]; }
            ss += __shfl_xor(ss, 32);
            const float rs = __builtin_amdgcn_rsqf(ss * (1.f / 64.f) + pg8::RMS_EPS) ;
            const float sc = 0.125f * LOG2E;
            float o[4][8];
#pragma unroll
            for (int kp = 0; kp < 2; ++kp)
#pragma unroll
                for (int j = 0; j < 8; ++j) { const int i = 16 * kp + 8 * h + j; const float c = L.cosT[tq * 32 + i], s = L.sinT[tq * 32 + i];
                    const float x1 = x[kp][j] * rs * qg[i], x2 = x[kp + 2][j] * rs * qg[i + 32];
                    o[kp][j] = (x1 * c - x2 * s) * sc; o[kp + 2][j] = (x2 * c + x1 * s) * sc; }
#pragma unroll
            for (int ks = 0; ks < 4; ++ks) qf[ks] = pack8(o[ks][0], o[ks][1], o[ks][2], o[ks][3], o[ks][4], o[ks][5], o[ks][6], o[ks][7]);
        }
        f32x16 st[5];
#pragma unroll
        for (int kt = 0; kt < 5; ++kt) {
#pragma unroll
            for (int i = 0; i < 16; ++i) st[kt][i] = 0.f;
#pragma unroll
            for (int ks = 0; ks < 4; ++ks) { const bf16x8 a = *(const LAS bf16x8*)(Ks + (q0 + 32 * kt + r) * 72 + 16 * ks + 8 * h); st[kt] = MFMA32(a, qf[ks], st[kt]); }
        }
        float mx = sinkl; const int rlo = r + 1 - 4 * h, kmin = 128 - q0 - 4 * h;
#pragma unroll
        for (int kt = 0; kt < 5; ++kt)
#pragma unroll
            for (int i = 0; i < 16; ++i) { const int kk = 32 * kt + CR(i);
                const bool ok = (kk >= rlo) && (kk <= rlo + 127) && (blk > 0 || kk >= kmin);
                st[kt][i] = ok ? st[kt][i] : -INFINITY; mx = fmaxf(mx, st[kt][i]); }
        mx = fmaxf(mx, __shfl_xor(mx, 32));
        float sum = 0.f;
#pragma unroll
        for (int kt = 0; kt < 5; ++kt)
#pragma unroll
            for (int i = 0; i < 16; ++i) { const float p = __builtin_amdgcn_exp2f(st[kt][i] - mx); st[kt][i] = p; sum += p; }
        sum += __shfl_xor(sum, 32);
        const float inv = __builtin_amdgcn_rcpf(sum + __builtin_amdgcn_exp2f(sinkl - mx));
#pragma unroll
        for (int kt = 0; kt < 5; ++kt) st[kt] = st[kt] * inv;
        f32x16 o2[2];
#pragma unroll
        for (int dt = 0; dt < 2; ++dt) {
#pragma unroll
            for (int i = 0; i < 16; ++i) o2[dt][i] = 0.f; }
#pragma unroll
        for (int kt = 0; kt < 5; ++kt)
#pragma unroll
            for (int s = 0; s < 2; ++s) { const bf16x8 pa = pack_step(st[kt], s);
#pragma unroll
                for (int dt = 0; dt < 2; ++dt) { const LAS bf16* vp = VT + (dt * 32 + r) * 264 + q0 + 32 * kt + 16 * s + 4 * h;
                    const v2u lo = *(const LAS v2u*)vp, hi = *(const LAS v2u*)(vp + 8); const v4u bb = {lo.x, lo.y, hi.x, hi.y};
                    o2[dt] = MFMA32(pa, __builtin_bit_cast(bf16x8, bb), o2[dt]); } }
        GAS bf16* yo = (GAS bf16*)L.YC + (size_t)(b * SEQ + blk * 128 + q0 + 4 * h) * DM + head * 64 + r;
#pragma unroll
        for (int i = 0; i < 16; ++i) {
#pragma unroll
            for (int dt = 0; dt < 2; ++dt) yo[CR(i) * DM + dt * 32] = cvt1(o2[dt][i]); }
    }
    __syncthreads();
}
DI void sgate_item(Frame& F, const Lyr& L, int item) {
    const int b = item >> 7, n = (item >> 2) & 31, g = item & 3, tid = opaque_tid(), l = L.l;
    LAS bf16* VT = (LAS bf16*)(F.lds);
    const int t = tid >> 2, qd = tid & 3, m0 = b * SEQ + n * 128;
    {
        const GAS f32x4* sp = (const GAS f32x4*)((const float*)(L.ws + WS_SGQ) + (size_t)(m0 + t) * 8); const f32x4 s0 = sp[0], s1 = sp[1];
        const float ss = ((s0[0] + s0[1]) + (s0[2] + s0[3])) + ((s1[0] + s1[1]) + (s1[2] + s1[3]));
        const float rs = __builtin_amdgcn_rsqf(ss * (1.f / 512.f) + pg8::RMS_EPS);
        const GAS v4u* sg = (const GAS v4u*)(L.Z + (size_t)(m0 + t) * ZW + ZC_GV + g * 128 + qd * 32);
        const float* gn = L.A->in[I_SGNG] + l * 512 + g * 128 + qd * 32;
#pragma unroll
        for (int i = 0; i < 4; ++i) { const v4u w = sg[i]; const unsigned ww[4] = {w.x, w.y, w.z, w.w};
#pragma unroll
            for (int q = 0; q < 4; ++q) { const int hc = qd * 32 + 8 * i + 2 * q; const float a = bflo(ww[q]) * rs * gn[8 * i + 2 * q], c = bfhi(ww[q]) * rs * gn[8 * i + 2 * q + 1];
                VT[hc * 136 + t] = cvt1(a); VT[(hc + 1) * 136 + t] = cvt1(c);
                if (n == 31) { float* pc = L.out + O_PCV + ((size_t)(l * NB + b) * 128 + t) * 512 + g * 128 + hc; pc[0] = a; pc[1] = c; } } }
    }
    __syncthreads();
    const int w = F.wave, lane = opaque_tid() & 63, r = lane & 31, h = lane >> 5, tt = w >> 1;
    const bf16* Wt = (const bf16*)(L.ws + WS_WTRIL) + (size_t)(l * 4 + g) * 16384;
    f32x16 acc[2];
#pragma unroll
    for (int i = 0; i < 2; ++i)
#pragma unroll
        for (int k = 0; k < 16; ++k) acc[i][k] = 0.f;
    bf16x8 af[8];
#pragma unroll
    for (int ks = 0; ks < 8; ++ks) af[ks] = *(const GAS bf16x8*)(Wt + (tt * 32 + r) * 128 + 16 * ks + 8 * h);
#pragma unroll
    for (int ks = 0; ks < 8; ++ks) if (ks < 2 * (tt + 1)) {
#pragma unroll
        for (int i = 0; i < 2; ++i) { const int ht = 2 * (w & 1) + i; const bf16x8 bq = *(const LAS bf16x8*)(VT + (ht * 32 + r) * 136 + 16 * ks + 8 * h); acc[i] = MFMA32(af[ks], bq, acc[i]); }
    }
    const float* bias = L.A->in[I_SGB] + (l * 4 + g) * 128;
#pragma unroll
    for (int i = 0; i < 2; ++i) { const int hc = (2 * (w & 1) + i) * 32 + r;
        const GAS bf16* zu = (const GAS bf16*)L.Z + (size_t)(m0 + tt * 32 + 4 * h) * ZW + ZC_GU + g * 128 + hc; GAS bf16* yo = (GAS bf16*)L.YC + (size_t)(m0 + tt * 32 + 4 * h) * DM + 1024 + g * 128 + hc;
        const float* bs = bias + tt * 32 + 4 * h;
#pragma unroll
        for (int k = 0; k < 16; ++k) { const float u = bf2f(zu[CR(k) * ZW]); yo[CR(k) * DM] = cvt1(u * (acc[i][k] + bs[CR(k)])); } }
    __syncthreads();
}

DI void ssm_pass1_task(Frame& F, const Lyr& L, int task) {
    const int b = task >> 10, sb = (task >> 5) & 31, g = task & 31, lane = opaque_tid() & 63, p = lane, r = lane & 31, hh = lane >> 5, l = L.l, w = F.wave;
    LAS unsigned* Sw = (LAS unsigned*)(F.lds + w * 8704);
    const int e = (l * 32 + g) * 64 + p;
    const f32x2v a = ((const f32x2v*)(L.ws + WS_ABAR))[e];
    const GAS bf16x8* bfp = (const GAS bf16x8*)((const bf16*)(L.ws + WS_BFRAG) + (size_t)(l * 32 + g) * 2048) + lane;
    bf16x8 Bf[4];
#pragma unroll
    for (int t = 0; t < 4; ++t) Bf[t] = bfp[t * 64];
    const GAS bf16x8* up = (const GAS bf16x8*)(L.Z + (size_t)(b * SEQ + sb * 128 + r) * ZW + ZC_SU + g * 16 + 8 * hh);
    bf16x8 ub[4];
#pragma unroll
    for (int j = 0; j < 4; ++j) ub[j] = up[(size_t)j * 32 * ZW / 8];
    float sr = 0.f, si = 0.f;
    f32x16 zero;
#pragma unroll
    for (int k = 0; k < 16; ++k) zero[k] = 0.f;
#pragma unroll 1
    for (int j = 0; j < 4; ++j) {
        const bf16x8 uj = j == 0 ? ub[0] : j == 1 ? ub[1] : j == 2 ? ub[2] : ub[3];
#pragma unroll
        for (int q = 0; q < 2; ++q) { const f32x16 re = MFMA32(uj, Bf[2 * q], zero), im = MFMA32(uj, Bf[2 * q + 1], zero);
#pragma unroll
            for (int k = 0; k < 16; ++k) Sw[(CR(k) + 4 * hh) * 68 + 32 * q + r] = cvtpk(re[k], im[k]); }
        LDS_WAIT(); asm volatile("" ::: "memory");
        unsigned wv[32];
#pragma unroll
        for (int t = 0; t < 32; ++t) wv[t] = Sw[t * 68 + p];
        {
            GAS unsigned* bu = (GAS unsigned*)(L.ws + WS_BU) + ((size_t)(b * 32 + g) * 128 + sb * 4 + j) * 2048 + p;
#pragma unroll
            for (int t = 0; t < 32; ++t) bu[t * 64] = wv[t]; }
#pragma unroll
        for (int t = 0; t < 32; ++t) { const float nr = a.x * sr - a.y * si + bflo(wv[t]), ni = a.x * si + a.y * sr + bfhi(wv[t]); sr = nr; si = ni; }
        ((f32x2v*)(L.ws + WS_E))[((size_t)(b * 32 + g) * 128 + sb * 4 + j) * 64 + p] = (f32x2v){sr, si};
        LDS_WAIT(); asm volatile("" ::: "memory");
    }
}
constexpr int DP_KF = 0, DP_VF = 32768, DP_QB = 65536, DP_KB = 82944, DP_AM = 100352, DP_GC = 116736, DP_BETA = DP_GC + 256, DP_EG = DP_GC + 512, DP_KEX = DP_GC + 768;
DI void dprep_item(Frame& F, const Lyr& L, int item) {
    const int b = item >> 8, h = (item >> 6) & 3, n = item & 63, l = L.l; int tid = opaque_tid();
    LAS float* Kf = (LAS float*)(F.lds + DP_KF); LAS float* Vf = (LAS float*)(F.lds + DP_VF);
    LAS bf16* Qb = (LAS bf16*)(F.lds + DP_QB); LAS bf16* Kb = (LAS bf16*)(F.lds + DP_KB);
    LAS float* Am = (LAS float*)(F.lds + DP_AM);
    LAS float* gcs = (LAS float*)(F.lds + DP_GC); LAS float* betas = (LAS float*)(F.lds + DP_BETA); LAS float* egs = (LAS float*)(F.lds + DP_EG); LAS float* kex = (LAS float*)(F.lds + DP_KEX);
    const int m0 = b * SEQ + n * 64;
    {
        const int t = tid >> 3, sub = tid & 7, tg = n * 64 + t;
#pragma unroll 1
        for (int wh = 0; wh < 3; ++wh) {
            const int ch0 = wh * 512 + h * 128 + sub * 16;
            const float* cw = L.A->in[I_CONVW] + (size_t)l * 4 * 1536 + ch0;
            float y[16];
#pragma unroll
            for (int c = 0; c < 16; ++c) y[c] = 0.f;
#pragma unroll
            for (int i = 0; i < 4; ++i) {
                if (tg - 3 + i >= 0) {
                    const GAS v4u* src = (const GAS v4u*)(L.Z + (size_t)(m0 + t - 3 + i) * ZW + ZC_DQ + ch0); const v4u a0 = src[0], a1 = src[1];
                    const unsigned ww[8] = {a0.x, a0.y, a0.z, a0.w, a1.x, a1.y, a1.z, a1.w};
#pragma unroll
                    for (int q = 0; q < 8; ++q) { y[2 * q] += cw[i * 1536 + 2 * q] * bflo(ww[q]); y[2 * q + 1] += cw[i * 1536 + 2 * q + 1] * bfhi(ww[q]); }
                    if (i == 3 && n == 63 && t >= 61) { float* pc = L.out + O_PC + ((size_t)(l * NB + b) * 3 + (t - 61)) * 1536 + ch0;
#pragma unroll
                        for (int q = 0; q < 8; ++q) { pc[2 * q] = bflo(ww[q]); pc[2 * q + 1] = bfhi(ww[q]); } }
                }
            }
            float ss = 0.f;
#pragma unroll
            for (int c = 0; c < 16; ++c) { y[c] = siluf_(y[c]); ss += y[c] * y[c]; }
            ss += __shfl_xor(ss, 1); ss += __shfl_xor(ss, 2); ss += __shfl_xor(ss, 4);
            const float rn = wh == 0 ? __builtin_amdgcn_rsqf(ss + pg8::RMS_EPS) * 0.08838834764831845f : (wh == 1 ? __builtin_amdgcn_rsqf(ss + pg8::RMS_EPS) : 1.0f);
            LAS bf16* bdst = (wh == 0 ? Qb : Kb) + t * 136 + sub * 16; LAS float* fdst = (wh == 1 ? Kf : Vf) + t * 128 + sub * 16;
#pragma unroll
            for (int c = 0; c < 16; c += 2) { const float v0 = y[c] * rn, v1 = y[c + 1] * rn;
                if (wh < 2) *(LAS unsigned*)(bdst + c) = cvtpk(v0, v1);
                if (wh > 0) { fdst[c] = v0; fdst[c + 1] = v1; } }
        }
    }
    tid = opaque_tid();
    if (tid < 64) {
        const int t = tid; const float* zab = L.ZAB + (size_t)(m0 + t) * 8;
        const float gg = -__expf(L.A->in[I_ALOG][l * 4 + h]) * softplusf_(zab[h] + L.A->in[I_DTB][l * 4 + h]);
        float c = gg;
#pragma unroll
        for (int o = 1; o < 64; o <<= 1) { const float v = __shfl_up(c, o); if (t >= o) c += v; }
        const float clast = __shfl(c, 63);
        gcs[t] = c; betas[t] = sigmoidf_(zab[4 + h]); egs[t] = __expf(c); kex[t] = __expf(clast - c);
        if (t == 63) ((float*)(L.ws + WS_GE))[item] = __expf(c);
    }
    __syncthreads();
    {
        const int w = F.wave, lane = opaque_tid() & 63, r = lane & 31, hh = lane >> 5, which = w >> 2, tt = (w >> 1) & 1, st = w & 1;
        f32x16 acc;
#pragma unroll
        for (int k = 0; k < 16; ++k) acc[k] = 0.f;
        const LAS bf16* Ap = (which ? Qb : Kb) + (tt * 32 + r) * 136 + 8 * hh; const LAS bf16* Bp = Kb + (st * 32 + r) * 136 + 8 * hh;
#pragma unroll
        for (int ks = 0; ks < 8; ++ks) acc = MFMA32(*(const LAS bf16x8*)(Ap + 16 * ks), *(const LAS bf16x8*)(Bp + 16 * ks), acc);
        bf16* QKo = (bf16*)(L.ws + WS_QK) + (size_t)item * 4096;
        const int s = st * 32 + r; const float gs = gcs[s];
        const int tb = tt * 32 + 4 * hh; const LAS float* gct = gcs + tb; const LAS float* bet = betas + tb; LAS float* Amp = Am + tb * 64 + s; bf16* qko = QKo + frag_off(tb, s, 4);
#pragma unroll
        for (int k = 0; k < 16; ++k) { const int t = tb + CR(k); const float dec = __expf(gct[CR(k)] - gs);
            if (which == 0) Amp[CR(k) * 64] = t > s ? bet[CR(k)] * acc[k] * dec : 0.f;
            else qko[CR(k) * 8] = cvt1(t >= s ? acc[k] * dec : 0.f); }
    }
    __syncthreads();
    tid = opaque_tid();
    {
        const int u = tid & 255;
        if (tid < 256) { const int t = u >> 2, d0 = (u & 3) * 32; bf16* QG = (bf16*)(L.ws + WS_QG) + (size_t)item * 8192; const float e = egs[t];
#pragma unroll 2
          for (int d = 0; d < 32; d += 4) { const int dk = d0 + d;
              const v2u o = {cvtpk(bf2f(Qb[t * 136 + dk]) * e, bf2f(Qb[t * 136 + dk + 1]) * e), cvtpk(bf2f(Qb[t * 136 + dk + 2]) * e, bf2f(Qb[t * 136 + dk + 3]) * e)};
              *(GAS v2u*)(QG + frag_off(t, dk, 8)) = o; } }
        else { const int dk = u >> 1, s0 = (u & 1) * 32; bf16* KE = (bf16*)(L.ws + WS_KE) + (size_t)item * 8192;
#pragma unroll 2
          for (int s = 0; s < 32; s += 4) { const int tk = s0 + s;
              const v2u o = {cvtpk(Kf[tk * 128 + dk] * kex[tk], Kf[(tk + 1) * 128 + dk] * kex[tk + 1]), cvtpk(Kf[(tk + 2) * 128 + dk] * kex[tk + 2], Kf[(tk + 3) * 128 + dk] * kex[tk + 3])};
              *(GAS v2u*)(KE + frag_off(dk, tk, 4)) = o; } }
    }
    __syncthreads();
    tid = opaque_tid();
    if (tid < 256) {
        const int c = tid; const bool isw = c >= 128; LAS float* X = isw ? Kf + (c - 128) : Vf + c;
        unsigned* U0 = (unsigned*)(L.ws + WS_U0) + (size_t)item * 4096 + ((c & 127) >> 5) * 1024 + (c & 31); bf16* WN = (bf16*)(L.ws + WS_WN) + (size_t)item * 8192;
#pragma unroll 1
        for (int tb = 0; tb < 4; ++tb) {
            float a[16];
#pragma unroll
            for (int i = 0; i < 16; ++i) { const int t = tb * 16 + i; a[i] = betas[t] * (isw ? egs[t] : 1.0f) * X[t * 128]; }
#pragma unroll 1
            for (int sb = 0; sb < tb; ++sb) {
                float xs[16];
#pragma unroll
                for (int j = 0; j < 16; ++j) xs[j] = X[(sb * 16 + j) * 128];
#pragma unroll
                for (int i = 0; i < 16; ++i) { const LAS f32x4* ar = (const LAS f32x4*)(Am + (tb * 16 + i) * 64 + sb * 16);
#pragma unroll
                    for (int j4 = 0; j4 < 4; ++j4) { const f32x4 av = ar[j4]; a[i] -= av.x * xs[4 * j4]; a[i] -= av.y * xs[4 * j4 + 1]; a[i] -= av.z * xs[4 * j4 + 2]; a[i] -= av.w * xs[4 * j4 + 3]; }
                    if ((i & 3) == 3) asm volatile("" ::: "memory"); }
            }
#pragma unroll
            for (int i = 1; i < 16; ++i) { const LAS float* ar = Am + (tb * 16 + i) * 64 + tb * 16;
#pragma unroll
                for (int j = 0; j < i; ++j) a[i] -= ar[j] * a[j];
                if ((i & 3) == 3) asm volatile("" ::: "memory"); }
#pragma unroll
            for (int i = 0; i < 16; ++i) { const int t = tb * 16 + i; X[t * 128] = a[i];
                if (!isw) { if ((i & 1) == 0) U0[(((tb >> 1) * 8 + (((i & 3) >> 1) | ((2 * (tb & 1) + (i >> 3)) << 1))) * 64) + ((i >> 2) & 1) * 32] = cvtpk(a[i], a[i + 1 < 16 ? i + 1 : 15]); } else WN[frag_off(t, c - 128, 8)] = cvt1(-a[i]); }
        }
    }
    __syncthreads();
}
constexpr int SC_BUF = 57344, SC_WN = 0, SC_QG = 16384, SC_QK = 32768, SC_KE = 40960;
struct ScanRegs { v4u a[14]; };
DI void dscan_issue(ScanRegs& R, const unsigned char* ws, size_t item, int lw, int lane) {
    const GAS v4u* wn = (const GAS v4u*)(ws + WS_WN + item * 16384) + lane; const GAS v4u* qg = (const GAS v4u*)(ws + WS_QG + item * 16384) + lane;
    const GAS v4u* qk = (const GAS v4u*)(ws + WS_QK + item * 8192) + lane;  const GAS v4u* ke = (const GAS v4u*)(ws + WS_KE + item * 16384) + lane;
#pragma unroll
    for (int i = 0; i < 4; ++i) { const int f = lw + 4 * i; R.a[i] = wn[f * 64]; R.a[4 + i] = qg[f * 64]; R.a[8 + i] = ke[f * 64]; }
#pragma unroll
    for (int i = 0; i < 2; ++i) R.a[12 + i] = qk[(lw + 4 * i) * 64];
}
DI void dscan_store_a(const ScanRegs& R, LAS unsigned char* buf, int lw, int lane) {
    LAS v4u* b = (LAS v4u*)buf + lane;
#pragma unroll
    for (int i = 0; i < 4; ++i) { const int f = lw + 4 * i; b[(SC_WN / 16) + f * 64] = R.a[i]; b[(SC_QG / 16) + f * 64] = R.a[4 + i]; b[(SC_KE / 16) + f * 64] = R.a[8 + i]; }
#pragma unroll
    for (int i = 0; i < 2; ++i) b[(SC_QK / 16) + (lw + 4 * i) * 64] = R.a[12 + i];
}
#define SC_RD(off) (*(const LAS bf16x8*)(buf + (off)))
#define SC_SB() __builtin_amdgcn_sched_barrier(0)
DI void dscan_chunk(f32x16 (&S)[4], unsigned (&Uw)[16], unsigned (&Unw)[16], float& gen, const LAS unsigned char* buf, const GAS unsigned* U1, const GAS float* GE, GAS unsigned* od, int n) {
    f32x16 U[2];
#pragma unroll
    for (int rt = 0; rt < 2; ++rt)
#pragma unroll
        for (int kp = 0; kp < 8; ++kp) { U[rt][2 * kp] = bflo(Uw[rt * 8 + kp]); U[rt][2 * kp + 1] = bfhi(Uw[rt * 8 + kp]); }
    const float ge = gen;
    f32x16 O[2];
    bf16x8 fa[4], fb[4];
    fa[0] = SC_RD(SC_WN); fa[1] = SC_RD(SC_QG); fa[2] = SC_RD(SC_WN + 8 * 1024); fa[3] = SC_RD(SC_QG + 8 * 1024);
    const bool more = n + 1 < 64;
    f32x16 zero;
#pragma unroll
    for (int k = 0; k < 16; ++k) zero[k] = 0.f;
    bf16x8 qa[2], qb[2];
#pragma unroll
    for (int ks = 0; ks < 8; ++ks) {
        bf16x8 (&cur)[4] = (ks & 1) ? fb : fa; bf16x8 (&nxt)[4] = (ks & 1) ? fa : fb;
        if (ks < 7) { nxt[0] = SC_RD(SC_WN + (ks + 1) * 1024); nxt[1] = SC_RD(SC_QG + (ks + 1) * 1024); nxt[2] = SC_RD(SC_WN + (8 + ks + 1) * 1024); nxt[3] = SC_RD(SC_QG + (8 + ks + 1) * 1024); }
        else { qa[0] = SC_RD(SC_QK); qa[1] = SC_RD(SC_QK + 4 * 1024); }
        SC_SB();
        const bf16x8 sb = pack_step(S[ks >> 1], ks & 1);
        U[0] = MFMA32(cur[0], sb, U[0]); O[0] = MFMA32(cur[1], sb, ks == 0 ? zero : O[0]); U[1] = MFMA32(cur[2], sb, U[1]); O[1] = MFMA32(cur[3], sb, ks == 0 ? zero : O[1]);
        if (more) { if (ks == 0) gen = GE[n + 1];
#pragma unroll
            for (int j = 0; j < 2; ++j) Unw[(ks >> 2) * 8 + 2 * (ks & 3) + j] = U1[((ks >> 2) * 8 + 2 * (ks & 3) + j) * 64]; }
        if (ks & 1) S[ks >> 1] = S[ks >> 1] * ge;
        SC_SB();
    }
    bf16x8 Ub[4];
#pragma unroll
    for (int rt = 0; rt < 2; ++rt) { Ub[2 * rt] = pack_step(U[rt], 0); Ub[2 * rt + 1] = pack_step(U[rt], 1); }
#pragma unroll
    for (int ks = 0; ks < 4; ++ks) {
        bf16x8 (&cur)[2] = (ks & 1) ? qb : qa; bf16x8 (&nxt)[2] = (ks & 1) ? qa : qb;
        if (ks < 3) { nxt[0] = SC_RD(SC_QK + (ks + 1) * 1024); nxt[1] = SC_RD(SC_QK + (4 + ks + 1) * 1024); }
        else {
#pragma unroll
            for (int d = 0; d < 4; ++d) fa[d] = SC_RD(SC_KE + (d * 4) * 1024); }
        SC_SB();
        O[0] = MFMA32(cur[0], Ub[ks], O[0]); O[1] = MFMA32(cur[1], Ub[ks], O[1]);
        SC_SB();
    }
#pragma unroll
    for (int ks = 0; ks < 4; ++ks) {
        bf16x8 (&cur)[4] = (ks & 1) ? fb : fa; bf16x8 (&nxt)[4] = (ks & 1) ? fa : fb;
        if (ks < 3) {
#pragma unroll
            for (int d = 0; d < 4; ++d) nxt[d] = SC_RD(SC_KE + (d * 4 + ks + 1) * 1024); }
        SC_SB();
#pragma unroll
        for (int d = 0; d < 4; ++d) S[d] = MFMA32(cur[d], Ub[ks], S[d]);
#pragma unroll
        for (int j = 0; j < 4; ++j) od[((ks >> 1) * 8 + 4 * (ks & 1) + j) * 64] = cvtpk(O[ks >> 1][8 * (ks & 1) + 2 * j], O[ks >> 1][8 * (ks & 1) + 2 * j + 1]);
        SC_SB();
    }
}
DI void dscan_wg(Frame& F, const Lyr& L, int bh, size_t od_extra = 0, int hs_ = 0) {
    const int b = bh >> 2, h = bh & 3, w = F.wave, lane = opaque_tid() & 63, r = lane & 31, hh = lane >> 5, dv0 = (w & 3) * 32, l = L.l;
    const bool loader = w >= 4; const int lw = w - 4;
    const size_t item0 = (size_t)bh * 64;
    if (loader) {
        ScanRegs R0, R1, R2, R3;
        dscan_issue(R0, L.ws, item0, lw, lane);
        asm volatile("s_waitcnt vmcnt(0)" ::: "memory");
        dscan_store_a(R0, F.lds, lw, lane);
        asm volatile("s_waitcnt lgkmcnt(0)" ::: "memory");
        dscan_issue(R1, L.ws, item0 + 1, lw, lane);
        dscan_issue(R2, L.ws, item0 + 2, lw, lane);
        dscan_issue(R3, L.ws, item0 + 3, lw, lane);
#define SC_TRIP(RS, RN, BUFOFF, NEXT) \
            __builtin_amdgcn_s_barrier(); asm volatile("" ::: "memory"); \
            asm volatile("s_waitcnt vmcnt(28)" ::: "memory"); \
            dscan_store_a(RS, F.lds + (BUFOFF), lw, lane); \
            asm volatile("s_waitcnt lgkmcnt(0)" ::: "memory"); \
            dscan_issue(RN, L.ws, item0 + ((NEXT) < 64 ? (NEXT) : 63), lw, lane);
#pragma unroll 1
        for (int n = 0; n < 64; n += 4) {
            SC_TRIP(R1, R0, SC_BUF, n + 4)
            SC_TRIP(R2, R1, 0, n + 5)
            SC_TRIP(R3, R2, SC_BUF, n + 6)
            SC_TRIP(R0, R3, 0, n + 7)
        }
#undef SC_TRIP
        asm volatile("s_waitcnt vmcnt(0)" ::: "memory");
    } else {
        f32x16 S[4]; unsigned UA[16], UB[16];
#pragma unroll
        for (int d = 0; d < 4; ++d)
#pragma unroll
            for (int k = 0; k < 16; ++k) S[d][k] = 0.f;
        const int uoff = (4 * hh) * 128 + dv0 + r, sl = w & 3;
        GAS unsigned* ODp = (GAS unsigned*)(L.ws + WS_OD) + (item0 * 4 + sl) * 1024 + lane;
        const GAS unsigned* U0 = (const GAS unsigned*)((const unsigned*)(L.ws + WS_U0) + item0 * 4096) + sl * 1024 + lane;
        const GAS float* GE = (const GAS float*)(L.ws + WS_GE) + item0;
        float gen = GE[0];
#pragma unroll
        for (int rt = 0; rt < 2; ++rt)
#pragma unroll
            for (int kp = 0; kp < 8; ++kp) UA[rt * 8 + kp] = U0[(rt * 8 + kp) * 64];
#pragma unroll 1
        for (int n = 0; n < 64; n += 2) {
            __builtin_amdgcn_s_barrier(); asm volatile("" ::: "memory");
            dscan_chunk(S, UA, UB, gen, F.lds + lane * 16, U0 + (size_t)(n + 1) * 4096, GE, ODp + (size_t)n * 4096, n);
            __builtin_amdgcn_s_barrier(); asm volatile("" ::: "memory");
            dscan_chunk(S, UB, UA, gen, F.lds + SC_BUF + lane * 16, U0 + (size_t)(n + 2) * 4096, GE, ODp + (size_t)(n + 1) * 4096, n + 1);
        }
        GAS float* PD = (GAS float*)(L.out + O_PD + ((size_t)(l * NB + b) * 4 + h) * 16384);
#pragma unroll
        for (int d = 0; d < 4; ++d)
#pragma unroll
            for (int k = 0; k < 16; ++k) (PD + (d * 32 + CR(k)) * 128)[uoff] = S[d][k];
    }
    __syncthreads();
}

DI void ssm_pass2_item(Frame& F, const Lyr& L, int item) {
    const int b = item >> 7, blk = item & 127, w = F.wave, lane = opaque_tid() & 63, l = L.l;
    LAS bf16* Sw = (LAS bf16*)(F.lds + w * 8704); LAS bf16* Y = (LAS bf16*)(F.lds + 69632);
    const int m0 = b * SEQ + blk * 32;
#pragma unroll 1
    for (int gi = 0; gi < 4; ++gi) {
        const int g = 4 * w + gi, p = lane, e = (l * 32 + g) * 64 + p;
        const f32x2v a = ((const f32x2v*)(L.ws + WS_ABAR))[e], a32 = ((const f32x2v*)(L.ws + WS_A32))[e];
        float sr = 0.f, si = 0.f; unsigned wv[32];
        const GAS f32x2v* E = (const GAS f32x2v*)(L.ws + WS_E) + (size_t)(b * 32 + g) * 128 * 64 + p;
        {
            float t2r = a32.x * a32.x - a32.y * a32.y, t2i = 2.f * a32.x * a32.y; const float a128r = t2r * t2r - t2i * t2i, a128i = 2.f * t2r * t2i;
            const int sbn = blk >> 2, jn = blk & 3;
            const GAS unsigned* bu = (const GAS unsigned*)(L.ws + WS_BU) + ((size_t)(b * 32 + g) * 128 + blk) * 2048 + p;
            f32x2v evs[31];
#pragma unroll
            for (int i = 0; i < 31; ++i) evs[i] = E[(4 * (i < sbn ? i : 0) + 3) * 64];
            const f32x2v evl = E[(jn > 0 ? blk - 1 : 0) * 64];
#pragma unroll
            for (int t = 0; t < 16; ++t) wv[t] = bu[t * 64];
#pragma unroll
            for (int i = 0; i < 31; ++i) if (i < sbn) { const float nr = a128r * sr - a128i * si + evs[i].x, ni = a128r * si + a128i * sr + evs[i].y; sr = nr; si = ni; }
            if (jn > 0) { const f32x2v ev = evl;
                for (int j = 0; j < jn; ++j) { const float nr = a32.x * sr - a32.y * si, ni = a32.x * si + a32.y * sr; sr = nr; si = ni; }
                sr += ev.x; si += ev.y; }
        }
        const bf16* zrow = L.Z + (size_t)m0 * ZW + ZC_SU + g * 16;
        const int r16 = lane & 15, q4 = lane >> 4;
        const GAS bf16x8* Cf = (const GAS bf16x8*)((const bf16*)(L.ws + WS_CFRAG) + (size_t)(l * 32 + g) * 2048) + lane;
        bf16x8 cbv[4]; unsigned short uz[8];
#pragma unroll
        for (int kb = 0; kb < 4; ++kb) cbv[kb] = Cf[kb * 64];
        const float dsk = L.A->in[I_SSMD][l * 512 + g * 16 + r16];
#pragma unroll
        for (int rt = 0; rt < 2; ++rt)
#pragma unroll
            for (int k = 0; k < 4; ++k) uz[rt * 4 + k] = zrow[(size_t)(rt * 16 + 4 * q4 + k) * ZW + r16];
        {
            const GAS unsigned* bu2 = (const GAS unsigned*)(L.ws + WS_BU) + ((size_t)(b * 32 + g) * 128 + blk) * 2048 + p;
#pragma unroll
            for (int t = 16; t < 32; ++t) wv[t] = bu2[t * 64];
#pragma unroll
            for (int t = 0; t < 32; ++t) { const float nr = a.x * sr - a.y * si + bflo(wv[t]), ni = a.x * si + a.y * sr + bfhi(wv[t]); sr = nr; si = ni;
                *(LAS unsigned*)(Sw + t * 136 + 2 * p) = cvtpk(sr, si); }
        }
        if (blk == 127) { L.out[O_PSR + (size_t)((l * NB + b) * 32 + g) * 64 + p] = sr; L.out[O_PSI + (size_t)((l * NB + b) * 32 + g) * 64 + p] = si; }
        LDS_WAIT(); asm volatile("" ::: "memory");
        f32x4 yy[2] = {{0.f, 0.f, 0.f, 0.f}, {0.f, 0.f, 0.f, 0.f}};
#pragma unroll
        for (int kb = 0; kb < 4; ++kb) { const bf16x8 cb = cbv[kb];
#pragma unroll
            for (int rt = 0; rt < 2; ++rt) yy[rt] = MFMA16(*(const LAS bf16x8*)(Sw + (rt * 16 + r16) * 136 + 32 * kb + 8 * q4), cb, yy[rt]); }
#pragma unroll
        for (int rt = 0; rt < 2; ++rt)
#pragma unroll
            for (int k = 0; k < 4; ++k) { const int t = rt * 16 + 4 * q4 + k; const float u = bf2f(uz[rt * 4 + k]);
                Y[t * 520 + g * 16 + r16] = cvt1(gelu_tanh(yy[rt][k] + dsk * u)); }
        LDS_WAIT(); asm volatile("" ::: "memory");
    }
    {
        const int r = lane & 31, hh = lane >> 5;
        const bf16* Wg = (const bf16*)(L.ws + WS_WG) + (size_t)l * 262144;
        bf16x8 wq[16][2];
#pragma unroll
        for (int j = 0; j < 8; ++j)
#pragma unroll
            for (int ct = 0; ct < 2; ++ct) wq[j][ct] = *(const GAS bf16x8*)(Wg + (size_t)(64 * w + 32 * ct + r) * 512 + 16 * j + 8 * hh);
        __syncthreads();
        f32x16 acc[2];
#pragma unroll
        for (int ct = 0; ct < 2; ++ct)
#pragma unroll
            for (int k = 0; k < 16; ++k) acc[ct][k] = 0.f;
#pragma unroll
        for (int ks = 0; ks < 32; ++ks) {
            if ((ks & 7) == 0 && ks + 8 < 32) {
#pragma unroll
                for (int j = 0; j < 8; ++j)
#pragma unroll
                    for (int ct = 0; ct < 2; ++ct) wq[(ks + 8 + j) & 15][ct] = *(const GAS bf16x8*)(Wg + (size_t)(64 * w + 32 * ct + r) * 512 + 16 * (ks + 8 + j) + 8 * hh); }
            const bf16x8 a = *(const LAS bf16x8*)(Y + r * 520 + 16 * ks + 8 * hh);
#pragma unroll
            for (int ct = 0; ct < 2; ++ct) acc[ct] = MFMA32(a, wq[ks & 15][ct], acc[ct]); }
#pragma unroll
        for (int ct = 0; ct < 2; ++ct) { const int nn = 64 * w + 32 * ct + r; const float bg = L.A->in[I_GLUB][l * 512 + nn];
            const LAS bf16* Yp = Y + (4 * hh) * 520 + nn; GAS bf16* yo = (GAS bf16*)L.YC + (size_t)(m0 + 4 * hh) * DM + 512 + nn;
#pragma unroll
            for (int k = 0; k < 16; ++k) { const float y = bf2f(Yp[CR(k) * 520]); yo[CR(k) * DM] = cvt1(y * sigmoidf_(acc[ct][k] + bg)); } }
    }
    __syncthreads();
}

DI void dpost_rows(Frame& F, const Lyr& L) {
    const int gw = F.vcu * NWAVES + F.wave, NGW = F.G * NWAVES, lane = opaque_tid() & 63, l = L.l;
    const unsigned* OD = (const unsigned*)(L.ws + WS_OD);
    const float g0 = L.A->in[I_DNG][l * 128 + 2 * lane], g1 = L.A->in[I_DNG][l * 128 + 2 * lane + 1];
    for (int rw0 = gw * 8; rw0 < MP * 4; rw0 += NGW * 8) {
        f32x2v o[8]; unsigned zg[8];
#pragma unroll
        for (int j = 0; j < 8; ++j) { const int m = (rw0 + j) >> 2, h = (rw0 + j) & 3;
            { const int tp = m & 4095, t = tp & 63, tt = t & 31, kk = (tt & 3) | ((tt >> 3) << 2);
              const v2u ow = *(const GAS v2u*)(OD + (((((size_t)((m >> 12) * 4 + h) * 64 + (tp >> 6)) * 4 + (lane >> 4)) * 2 + (t >> 5)) * 8 + (kk >> 1)) * 64 + ((tt >> 2) & 1) * 32 + 2 * (lane & 15));
              o[j] = (kk & 1) ? (f32x2v){bfhi(ow.x), bfhi(ow.y)} : (f32x2v){bflo(ow.x), bflo(ow.y)}; }
            zg[j] = *(const GAS unsigned*)(L.Z + (size_t)m * ZW + ZC_DG + h * 128 + 2 * lane); }
#pragma unroll
        for (int j = 0; j < 8; ++j) { const int m = (rw0 + j) >> 2, h = (rw0 + j) & 3;
            const float ss = wave_sum(o[j].x * o[j].x + o[j].y * o[j].y);
            const float rs = __builtin_amdgcn_rsqf(ss * (1.f / 128.f) + pg8::RMS_EPS);
            *(GAS unsigned*)(L.YC + (size_t)m * DM + 1536 + h * 128 + 2 * lane) = cvtpk(o[j].x * rs * g0 * siluf_(bflo(zg[j])), o[j].y * rs * g1 * siluf_(bfhi(zg[j]))); }
    }
}
DI float block_sum(LAS float* red, float v, int tid, int grp_waves) {
    v = wave_sum(v);
    __syncthreads();
    if ((tid & 63) == 0) red[tid >> 6] = v;
    __syncthreads();
    const int w = tid >> 6, g0 = (w / grp_waves) * grp_waves; float s = 0.f;
    for (int i = 0; i < grp_waves; ++i) s += red[g0 + i];
    return s;
}
DI void sample_attn(Frame& F, const Lyr& L, int b) {
    const int tid = opaque_tid(), lane = tid & 63, w = F.wave, l = L.l, row = MP + b;
    const bf16* zrow = L.Z + (size_t)row * ZW; bf16* yrow = L.YC + (size_t)row * DM; const Args& A = *L.A;
    LAS float* fl = (LAS float*)F.lds; LAS float* q_l = fl; LAS float* k_l = fl + 512; LAS float* v_l = fl + 640; LAS float* sc_l = fl + 768;
    const float* cosr = L.cosT + 4096 * 32; const float* sinr = L.sinT + 4096 * 32;
    {
        const int d = lane, i = d & 31;
        { const float x = bf2f(zrow[ZC_Q + tid]); const float ss = wave_sum(x * x); const float xn = x * __builtin_amdgcn_rsqf(ss * (1.f / 64.f) + pg8::RMS_EPS) * A.in[I_QNG][l * 64 + d];
          const float pr = __shfl_xor(xn, 32); const float c = cosr[i], s = sinr[i]; q_l[tid] = (d < 32 ? xn * c - pr * s : xn * c + pr * s) * 0.125f; }
        if (w < 2) { const float x = bf2f(zrow[ZC_K + tid]); const float ss = wave_sum(x * x); const float xn = x * __builtin_amdgcn_rsqf(ss * (1.f / 64.f) + pg8::RMS_EPS) * A.in[I_KNG][l * 64 + d];
          const float pr = __shfl_xor(xn, 32); const float c = cosr[i], s = sinr[i]; k_l[tid] = d < 32 ? xn * c - pr * s : xn * c + pr * s; }
        else if (w < 4) v_l[tid - 128] = bf2f(zrow[ZC_V + tid - 128]);
    }
    __syncthreads();
    const float* ck = A.in[I_CK] + (size_t)(l * NS + b) * 16384; const float* cv = A.in[I_CV] + (size_t)(l * NS + b) * 16384;
    {
        GAS f32x4* ok = (GAS f32x4*)(L.out + O_SK + (size_t)(l * NS + b) * 16384); GAS f32x4* ov = (GAS f32x4*)(L.out + O_SV + (size_t)(l * NS + b) * 16384);
#pragma unroll
        for (int k = 0; k < 8; ++k) { const int idx = tid + 512 * k, i = idx >> 5, c4 = idx & 31;
            ok[idx] = i < 127 ? ((const GAS f32x4*)ck)[idx + 32] : *(const LAS f32x4*)(k_l + 4 * c4);
            ov[idx] = i < 127 ? ((const GAS f32x4*)cv)[idx + 32] : *(const LAS f32x4*)(v_l + 4 * c4); }
    }
    const int head = w, kvh = head >> 2;
    {
        float sc[2];
#pragma unroll
        for (int jj = 0; jj < 2; ++jj) { const int j = lane + 64 * jj; float acc = 0.f;
            if (j < 127) { const GAS f32x4* kp = (const GAS f32x4*)(ck + (size_t)(j + 1) * 128 + kvh * 64);
#pragma unroll
                for (int d4 = 0; d4 < 16; ++d4) { const f32x4 kv = kp[d4]; const f32x4 qv = *(const LAS f32x4*)(q_l + head * 64 + 4 * d4); acc += (kv.x * qv.x + kv.y * qv.y) + (kv.z * qv.z + kv.w * qv.w); } }
            else {
#pragma unroll
                for (int d4 = 0; d4 < 16; ++d4) { const f32x4 kv = *(const LAS f32x4*)(k_l + kvh * 64 + 4 * d4); const f32x4 qv = *(const LAS f32x4*)(q_l + head * 64 + 4 * d4); acc += (kv.x * qv.x + kv.y * qv.y) + (kv.z * qv.z + kv.w * qv.w); } }
            sc[jj] = acc; }
        const float sink = A.in[I_SINK][l * 8 + head];
        const float mx = fmaxf(wave_max(fmaxf(sc[0], sc[1])), sink);
        const float p0 = __expf(sc[0] - mx), p1 = __expf(sc[1] - mx);
        const float inv = 1.f / (wave_sum(p0 + p1) + __expf(sink - mx));
        sc_l[head * 128 + lane] = p0 * inv; sc_l[head * 128 + lane + 64] = p1 * inv;
        LDS_WAIT(); asm volatile("" ::: "memory");
    }
    {
        const int d4 = (lane & 15) * 4, ks = lane >> 4; f32x4 o = {0.f, 0.f, 0.f, 0.f};
        const int jend = ks == 3 ? 31 : 32;
#pragma unroll 8
        for (int jj = 0; jj < jend; ++jj) { const int j = 32 * ks + jj; const float p = sc_l[head * 128 + j]; const f32x4 v = *(const GAS f32x4*)(cv + (size_t)(j + 1) * 128 + kvh * 64 + d4); o += v * p; }
        if (ks == 3) { const float p = sc_l[head * 128 + 127]; o += *(const LAS f32x4*)(v_l + kvh * 64 + d4) * p; }
#pragma unroll
        for (int e = 0; e < 4; ++e) { o[e] += __shfl_xor(o[e], 16); o[e] += __shfl_xor(o[e], 32); }
        if (ks == 0) *(GAS v2u*)(yrow + head * 64 + d4) = (v2u){cvtpk(o[0], o[1]), cvtpk(o[2], o[3])};
    }
    __syncthreads();
}
DI void sample_ssm(Frame& F, const Lyr& L, int b) {
    const int tid = opaque_tid(), l = L.l, row = MP + b;
    const bf16* zrow = L.Z + (size_t)row * ZW; bf16* yrow = L.YC + (size_t)row * DM; const Args& A = *L.A;
    LAS float* fl = (LAS float*)F.lds; LAS float* s_l = fl; LAS float* y_l = fl + 4096; LAS float* part = fl + 4608;
#pragma unroll 1
    for (int k = 0; k < 4; ++k) { const int idx = tid + 512 * k, g = idx >> 6, e = l * 2048 + idx;
        const f32x2v a = ((const f32x2v*)(L.ws + WS_ABAR))[e];
        const float s0r = A.in[I_SSR][(size_t)(l * NS + b) * 2048 + idx], s0i = A.in[I_SSI][(size_t)(l * NS + b) * 2048 + idx];
        float br = 0.f, bi = 0.f; const GAS f32x4* bbp = (const GAS f32x4*)((const f32x2v*)(L.ws + WS_BBAR) + (size_t)e * 16);
        const GAS v4u* up = (const GAS v4u*)(zrow + ZC_SU + g * 16); const v4u u0 = up[0], u1 = up[1]; const unsigned ww[8] = {u0.x, u0.y, u0.z, u0.w, u1.x, u1.y, u1.z, u1.w};
#pragma unroll
        for (int c = 0; c < 8; ++c) { const f32x4 bv = bbp[c]; const float x0 = bflo(ww[c]), x1 = bfhi(ww[c]); br += bv.x * x0 + bv.z * x1; bi += bv.y * x0 + bv.w * x1; }
        const float sr = a.x * s0r - a.y * s0i + br, si = a.x * s0i + a.y * s0r + bi;
        L.out[O_SSR + (size_t)(l * NS + b) * 2048 + idx] = sr; L.out[O_SSI + (size_t)(l * NS + b) * 2048 + idx] = si;
        s_l[2 * idx] = sr; s_l[2 * idx + 1] = si; }
    __syncthreads();
    {
        const int g = tid >> 4, c = tid & 15; const GAS f32x4* cr = (const GAS f32x4*)(A.in[I_CRE] + ((size_t)(l * 32 + g) * 16 + c) * 64); const GAS f32x4* ci = (const GAS f32x4*)(A.in[I_CIM] + ((size_t)(l * 32 + g) * 16 + c) * 64);
        float acc = 0.f;
#pragma unroll
        for (int p4 = 0; p4 < 16; ++p4) { const f32x4 a = cr[p4], bq = ci[p4]; const LAS f32x4* sp = (const LAS f32x4*)(s_l + 2 * (g * 64 + 4 * p4)); const f32x4 s0 = sp[0], s1 = sp[1];
            acc += (a.x * s0.x - bq.x * s0.y) + (a.y * s0.z - bq.y * s0.w) + (a.z * s1.x - bq.z * s1.y) + (a.w * s1.z - bq.w * s1.w); }
        acc += A.in[I_SSMD][l * 512 + tid] * bf2f(zrow[ZC_SU + tid]);
        y_l[tid] = gelu_tanh(acc);
    }
    __syncthreads();
    {
        const int n4 = (tid & 127) * 4, ks = tid >> 7; const GAS f32x4* gw = (const GAS f32x4*)(A.in[I_GLUW] + (size_t)l * 262144 + (size_t)(ks * 128) * 512 + n4); f32x4 acc = {0.f, 0.f, 0.f, 0.f};
#pragma unroll 16
        for (int k = 0; k < 128; ++k) acc += gw[k * 128] * y_l[ks * 128 + k];
        *(LAS f32x4*)(part + ks * 512 + n4) = acc;
    }
    __syncthreads();
    { const float acc = A.in[I_GLUB][l * 512 + tid] + (part[tid] + part[512 + tid]) + (part[1024 + tid] + part[1536 + tid]); yrow[512 + tid] = cvt1(y_l[tid] * sigmoidf_(acc)); }
    __syncthreads();
}
DI void sample_sgate(Frame& F, const Lyr& L, int b) {
    const int tid = opaque_tid(), l = L.l, row = MP + b;
    const bf16* zrow = L.Z + (size_t)row * ZW; bf16* yrow = L.YC + (size_t)row * DM; const Args& A = *L.A;
    LAS float* red = (LAS float*)F.lds;
    const float u = bf2f(zrow[ZC_GU + tid]), v = bf2f(zrow[ZC_GV + tid]);
    const float ss = block_sum(red, v * v, tid, 8);
    const float vn = v * __builtin_amdgcn_rsqf(ss * (1.f / 512.f) + pg8::RMS_EPS) * A.in[I_SGNG][l * 512 + tid];
    L.out[O_SCV + (size_t)(l * NS + b) * 512 + tid] = vn;
    const int g = tid >> 7;
    yrow[1024 + tid] = cvt1(u * (A.in[I_SGW][(size_t)(l * 4 + g) * 16384] * vn + A.in[I_SGB][(l * 4 + g) * 128]));
    __syncthreads();
}
DI void sample_delta(Frame& F, const Lyr& L, int b, int h) {
    const int tid = opaque_tid(), l = L.l, row = MP + b;
    const bf16* zrow = L.Z + (size_t)row * ZW; const float* zab = L.ZAB + (size_t)row * 8; bf16* yrow = L.YC + (size_t)row * DM; const Args& A = *L.A;
    LAS float* fl = (LAS float*)F.lds; LAS float* red = fl; LAS float* q_l = fl + 16; LAS float* k_l = fl + 144; LAS float* v_l = fl + 272; LAS float* U_l = fl + 400; LAS float* part = fl + 528;
    float y = 0.f;
    if (tid < 384) { const int wh = tid >> 7, d = tid & 127, ch = wh * 512 + h * 128 + d; const float x = bf2f(zrow[ZC_DQ + ch]);
        const float* sc0 = A.in[I_SC] + (size_t)(l * NS + b) * 3 * 1536 + ch; const float* cw = A.in[I_CONVW] + (size_t)l * 4 * 1536 + ch;
        const float b0 = sc0[0], b1 = sc0[1536], b2 = sc0[3072];
        y = siluf_(cw[0] * b0 + cw[1536] * b1 + cw[3072] * b2 + cw[4608] * x);
        float* oc = L.out + O_SC + (size_t)(l * NS + b) * 3 * 1536 + ch; oc[0] = b1; oc[1536] = b2; oc[3072] = x; }
    const float ssq = block_sum(red, y * y, tid, 2);
    if (tid < 128) q_l[tid] = y * __builtin_amdgcn_rsqf(ssq + pg8::RMS_EPS) * 0.08838834764831845f;
    else if (tid < 256) k_l[tid - 128] = y * __builtin_amdgcn_rsqf(ssq + pg8::RMS_EPS);
    else if (tid < 384) v_l[tid - 256] = y;
    const float gg = -__expf(A.in[I_ALOG][l * 4 + h]) * softplusf_(zab[h] + A.in[I_DTB][l * 4 + h]);
    const float eg = __expf(gg), beta = sigmoidf_(zab[4 + h]);
    __syncthreads();
    const int dks = tid >> 5, dv4 = (tid & 31) * 4;
    const GAS f32x4* S0 = (const GAS f32x4*)(A.in[I_SD] + ((size_t)(l * NS + b) * 4 + h) * 16384 + (size_t)(dks * 8) * 128 + dv4);
    f32x4 s[8]; f32x4 ks = {0.f, 0.f, 0.f, 0.f};
#pragma unroll
    for (int i = 0; i < 8; ++i) s[i] = S0[i * 32];
#pragma unroll
    for (int i = 0; i < 8; ++i) ks += s[i] * k_l[dks * 8 + i];
    *(LAS f32x4*)(part + dks * 128 + dv4) = ks;
    __syncthreads();
    if (tid < 128) { float t = 0.f;
#pragma unroll
        for (int i = 0; i < 16; ++i) t += part[i * 128 + tid];
        U_l[tid] = beta * (v_l[tid] - eg * t); }
    __syncthreads();
    {
        const f32x4 U = *(const LAS f32x4*)(U_l + dv4); f32x4 o = {0.f, 0.f, 0.f, 0.f};
        GAS f32x4* S1 = (GAS f32x4*)(L.out + O_SD + ((size_t)(l * NS + b) * 4 + h) * 16384 + (size_t)(dks * 8) * 128 + dv4);
#pragma unroll
        for (int i = 0; i < 8; ++i) { const f32x4 sn = s[i] * eg + U * k_l[dks * 8 + i]; S1[i * 32] = sn; o += sn * q_l[dks * 8 + i]; }
        *(LAS f32x4*)(part + dks * 128 + dv4) = o;
    }
    __syncthreads();
    float o = 0.f;
    if (tid < 128) {
#pragma unroll
        for (int i = 0; i < 16; ++i) o += part[i * 128 + tid]; }
    const float so = block_sum(red, o * o, tid, 2);
    if (tid < 128) yrow[1536 + h * 128 + tid] = cvt1(o * __builtin_amdgcn_rsqf(so * (1.f / 128.f) + pg8::RMS_EPS) * A.in[I_DNG][l * 128 + tid] * siluf_(bf2f(zrow[ZC_DG + h * 128 + tid])));
    __syncthreads();
}
DI void sample_sub(Frame& F, const Lyr& L, int it) {
    const int part = it >> 5, b = it & 31;
    if (part < 4) sample_delta(F, L, b, part);
    else if (part == 4) sample_attn(F, L, b);
    else if (part == 5) sample_ssm(F, L, b);
    else sample_sgate(F, L, b);
}
enum { TH_IN = 0, TH_BR = 1, TH_RES = 2, TH_FF1 = 3 };
struct ThinArgs {
    const bf16* X; const bf16* Wt; int N, K;
    int first, stride;
    bf16* Z; float* ZAB; bf16* G; bf16* GS; bf16* H; bf16* XB;
    const float* R; float* Xs;
    const float* ssq_in; float* ssq_out;
};
template <int MODE>
DI void thin_gemm(Frame& F, const ThinArgs& T) {
    constexpr int NC = (MODE == TH_BR || MODE == TH_RES) ? 1 : 2;
    const int tid = opaque_tid(), lane = tid & 63, w = F.wave, r16 = lane & 15, q4 = lane >> 4;
    LAS float* red = (LAS float*)F.lds;
    LAS float* sqs = (LAS float*)(F.lds + 32768);
    LAS float* rsl = (LAS float*)(F.lds + 32768 + 4096);
    const int ncg = T.N / (16 * NC), K = T.K, kw = K / 8, nst = kw / 32;
    if (T.first >= ncg) return;
    if (MODE == TH_IN || MODE == TH_FF1) {
        const int row = tid >> 4, part = tid & 15; const f32x4 v = *(const GAS f32x4*)(T.ssq_in + row * 128 + part * 8), v2 = *(const GAS f32x4*)(T.ssq_in + row * 128 + part * 8 + 4);
        float s = ((v[0] + v[1]) + (v[2] + v[3])) + ((v2[0] + v2[1]) + (v2[2] + v2[3]));
        s += __shfl_xor(s, 1); s += __shfl_xor(s, 2); s += __shfl_xor(s, 4); s += __shfl_xor(s, 8);
        if (part == 0) rsl[row] = __builtin_amdgcn_rsqf(s * (1.0f / 2048.0f) + pg8::RMS_EPS);
        __syncthreads();
    }
    for (int cg = T.first; cg < ncg; cg += T.stride) {
        if (MODE == TH_IN && cg >= 137 && cg < 144) continue;
        const GAS bf16x8* wp0 = (const GAS bf16x8*)(T.Wt + (size_t)(cg * 16 * NC + r16) * K + w * kw + 8 * q4);
        const GAS bf16x8* wp1 = (const GAS bf16x8*)(T.Wt + (size_t)(cg * 16 * NC + (NC == 2 ? 16 : 0) + r16) * K + w * kw + 8 * q4);
        const GAS bf16x8* x0 = (const GAS bf16x8*)(T.X + (size_t)r16 * K + w * kw + 8 * q4);
        const GAS bf16x8* x1 = (const GAS bf16x8*)(T.X + (size_t)(16 + r16) * K + w * kw + 8 * q4);
        f32x4 a00 = {0.f, 0.f, 0.f, 0.f}, a01 = a00, a10 = a00, a11 = a00;
#pragma unroll 8
        for (int s = 0; s < nst; ++s) { const bf16x8 w0 = wp0[4 * s], xa = x0[4 * s], xb = x1[4 * s];
            a00 = MFMA16(w0, xa, a00); a01 = MFMA16(w0, xb, a01);
            if (NC == 2) { const bf16x8 w1 = wp1[4 * s]; a10 = MFMA16(w1, xa, a10); a11 = MFMA16(w1, xb, a11); } }
        LAS f32x4* rw = (LAS f32x4*)red + (w * 4) * 64 + lane;
        rw[0] = a00; rw[64] = a01; if (NC == 2) { rw[128] = a10; rw[192] = a11; }
        __syncthreads();
#pragma unroll
        for (int o = 0; o < NC; ++o) {
            const int e = tid + 512 * o, t = e >> 8, ln = (e >> 2) & 63, reg = e & 3, i = 16 * (t & 1) + (ln & 15), c = cg * 16 * NC + 16 * (t >> 1) + 4 * (ln >> 4) + reg;
            float v = 0.f;
            if (MODE == TH_BR) {
#pragma unroll
                for (int b = 0; b < 4; ++b) { const float g = bf2f(T.G[(size_t)i * 8192 + b * 2048 + c]);
                    v += g * (red[(((2 * b) * 4 + t) * 64 + ln) * 4 + reg] + red[(((2 * b + 1) * 4 + t) * 64 + ln) * 4 + reg]); }
            } else {
#pragma unroll
                for (int ww = 0; ww < 8; ++ww) v += red[((ww * 4 + t) * 64 + ln) * 4 + reg];
            }
            if (MODE == TH_IN) { const float z = v * rsl[i];
                if (c < 4352) T.Z[(size_t)i * ZW + c] = cvt1((c >= 1280 && c < 2304) ? gelu_tanh(z) : z);
                else if (c < 4360) T.ZAB[i * 8 + (c - 4352)] = z;
                else if (c >= 4608) T.G[(size_t)i * 8192 + (c - 4608)] = cvt1(fmaxf(sigmoidf_(z), 1e-18f)); }
            else if (MODE == TH_BR) T.GS[(size_t)i * DM + c] = cvt1(v);
            else if (MODE == TH_FF1) { const float a = fmaxf(v * rsl[i], 0.f); T.H[(size_t)i * DFF + c] = cvt1(a * a); }
            else { const float x = T.R[i * DM + c] + v; T.Xs[i * DM + c] = x; T.XB[(size_t)i * DM + c] = cvt1(x); sqs[e] = x * x; }
        }
        __syncthreads();
        if (MODE == TH_RES) { if (tid < 32) { const int rh = tid >> 4, rr = tid & 15; float s = 0.f;
#pragma unroll
                for (int ch = 0; ch < NC; ++ch)
#pragma unroll
                    for (int q = 0; q < 4; ++q)
#pragma unroll
                        for (int g = 0; g < 4; ++g) s += sqs[(2 * ch + rh) * 256 + (q * 16 + rr) * 4 + g];
                T.ssq_out[tid * 128 + cg] = s; } }
    }
    __syncthreads();
}
template <class Ord> DI void fill_rstd(LAS float* rsl, const Ord& S2, const float* P) {
    LAS int* pmv = (LAS int*)(rsl + 2048);
    const int t = opaque_tid();
    if (t < 8) { pg8::Unit u_; pmv[t] = S2.next(t, u_) ? u_.pm : -1; }
    __syncthreads();
#pragma unroll
    for (int pass = 0; pass < 2; ++pass) {
        f32x4 v[2][8]; int pm[2];
#pragma unroll
        for (int j = 0; j < 2; ++j) { const int idx = t + 512 * (2 * pass + j); pm[j] = pmv[idx >> 8];
            const GAS f32x4* p = (const GAS f32x4*)(P + (size_t)((pm[j] < 0 ? 0 : pm[j]) * 256 + (idx & 255)) * 32);
#pragma unroll
            for (int i = 0; i < 8; ++i) v[j][i] = p[i]; }
#pragma unroll
        for (int j = 0; j < 2; ++j) { const int idx = t + 512 * (2 * pass + j); float s = 0.f;
#pragma unroll
            for (int i = 0; i < 8; ++i) s += (v[j][i][0] + v[j][i][1]) + (v[j][i][2] + v[j][i][3]);
            if (pm[j] >= 0) rsl[idx] = __builtin_amdgcn_rsqf(s * (1.0f / 2048.0f) + pg8::RMS_EPS); }
    }
    __syncthreads();
}
__global__ void __launch_bounds__(NWAVES * 64, 2) hybrid_fwd(Args args) {
    extern __shared__ __attribute__((aligned(16))) unsigned char lds[];
    Frame F;
    F.lds = (LAS unsigned char*)lds;
    F.MISC = (volatile LAS unsigned*)(F.lds + MISC_OFF);
    F.tid = threadIdx.x; F.lane = F.tid & 63; F.wave = __builtin_amdgcn_readfirstlane(F.tid >> 6);
    F.G = gridDim.x; { const int bx = blockIdx.x; F.vcu = (F.G % 8 == 0) ? (bx % 8) * (F.G / 8) + bx / 8 : bx; }
    F.ws = args.ws; F.ctl = (gu32*)(args.ws + WS_CTL);
    for (int u = F.tid; u < (LDS_BYTES - LDSCTL_OFF) / 4; u += NWAVES * 64) ((LAS unsigned*)(F.lds + LDSCTL_OFF))[u] = 0u;
    __syncthreads();
    XcdBarrier bar = xcd_barrier_post((unsigned*)(F.ctl + CW_BAR), F.MISC + 8);
    unsigned char* ws = args.ws;
#define GRID_BARK(k) do { GRID_BAR(); if ((PROBE_BARMASK >> (k)) & 1) GRID_BAR(); } while (0)
#define GRID_BAR() do { for (int brep_ = 0; brep_ < REP_BAR; ++brep_) { XcdBarrier b2_ = bar; asm volatile("" : "+s"(b2_.bar), "+s"(b2_.x)); xcd_barrier(b2_); } } while (0)
    const int bid = blockIdx.x, G = F.G;

#ifndef NO_P0
    for (int rep_ = 0; rep_ < REP_P0; ++rep_) { p0_prologue(F, args); if (rep_ + 1 < REP_P0) GRID_BAR(); }
#endif
    GRID_BARK(0);

#pragma unroll 1
    for (int l = 0; l < DEPTH; ++l) {
        { GAS unsigned char* wsg_ = (GAS unsigned char*)args.ws; asm volatile("" : "+s"(wsg_)); ws = (unsigned char*)wsg_; }
        float* ssq = (float*)(ws + WS_SSQP);
        bf16* XB = (bf16*)(ws + WS_XB); bf16* Zb = (bf16*)(ws + WS_Z); bf16* Gb = (bf16*)(ws + WS_G); bf16* YC = (bf16*)(ws + WS_YCAT); bf16* GS = (bf16*)(ws + WS_GS); bf16* Hb = (bf16*)(ws + WS_H);
        float* ZAB = (float*)(ws + WS_ZAB);
        float* outp; { GAS float* og_ = (GAS float*)args.out; asm volatile("" : "+s"(og_)); outp = (float*)og_; }
        float* Xp = outp + O_YP; float* Xs = outp + O_YS;
        Lyr L; L.l = l; L.Z = Zb; L.ZAB = ZAB; L.YC = YC; L.cosT = (const float*)(ws + WS_ROPE); L.sinT = L.cosT + 4097 * 32; L.A = &args; L.out = outp; L.ws = ws;
        float* ssqs = (float*)(ws + WS_SSQS);
        ThinArgs T{}; T.Z = Zb + (size_t)MP * ZW; T.ZAB = ZAB + (size_t)MP * 8; T.G = Gb + (size_t)MP * GW; T.GS = GS + (size_t)MP * DM; T.H = Hb + (size_t)MP * DFF; T.XB = XB + (size_t)MP * DM; T.Xs = Xs; T.first = F.vcu; T.stride = G;
        {
            pg8::Gemm g{XB, (const bf16*)(ws + WS_WIN) + (size_t)l * NINP * DM, MP, NINP, DM};
            LAS float* rsl = (LAS float*)(F.lds + RING_BYTES);
#pragma unroll 1
            for (int half = 0; half < 2; ++half) {
                pg8::SplitOrder S; S.init(G, bid, half ? 768 : 0, half ? 832 : 768);
                fill_rstd(rsl, S, ssq + (size_t)(2 * l) * MPAD * 32);
                pg8::EpiIn E{Zb, ZAB, Gb, rsl, (float*)(ws + WS_SGQ)};
#ifndef NO_GIN
                for (int rep_ = 0; rep_ < REP_GIN; ++rep_)
                pg8::gemm_phase<pg8::EpiIn, pg8::SplitOrder, true, true>(F.lds + RING_OFF, g, S, E);
#endif
                if (half == 0) GRID_BARK(1);
            }
            T.X = XB + (size_t)MP * DM; T.Wt = g.Bt; T.N = NINP; T.K = DM; T.ssq_in = ssqs + (2 * l) * 4096;
            { const int late = 832 % G;
              if (G > late) { T.first = bid >= late ? bid - late : 1 << 30; T.stride = G - late; } }
            for (int rep_ = 0; rep_ < REP_THIN; ++rep_) thin_gemm<TH_IN>(F, T);
            T.first = F.vcu; T.stride = G;
        }
        {
            const int late = 832 % G, early = G - late;
            for (int rep_ = 0; rep_ < REP_A; ++rep_)
            for (int it = (bid >= late ? bid - late : 768); ; ) {
                if (it < 768) {
#ifndef NO_DPREP
                if (it < 512) dprep_item(F, L, it); else
#endif
#ifndef NO_SSM1
                { ssm_pass1_task(F, L, (it - 512) * 8 + F.wave); __syncthreads(); }
#else
                {}
#endif
                }
                __syncthreads();
                if (opaque_tid() == 0) F.MISC[16] = __hip_atomic_fetch_add(F.ctl + CW_QUEUE + 64 * l, 1u, __ATOMIC_RELAXED, __HIP_MEMORY_SCOPE_AGENT);
                __syncthreads();
                it = early + (int)F.MISC[16];
                if (it >= 768) break;
            }
        }
        GRID_BARK(2);
        for (int rep_ = 0; rep_ < REP_B; ++rep_) {
#ifndef NO_DSCAN
        if (bid < 8) { for (int r2_ = 0; r2_ < REP_SCAN; ++r2_) dscan_wg(F, L, bid);
#if PROBE_DET
            dscan_wg(F, L, bid, (WS_H - WS_OD) / 4);
#endif
#if PROBE_HS >= 0
            dscan_wg(F, L, bid, (WS_H - WS_OD) / 4, 1);
#endif
#if PROBE_ENDDLY
            for (int q_ = 0; q_ < PROBE_ENDDLY; ++q_) __builtin_amdgcn_s_sleep(127);
#endif
        }
        else
#endif
        for (int it = bid - 8; it < 864; ) {
#ifndef NO_SSM2
            if (it < 256) { for (int r2_ = 0; r2_ < REP_BOTH; ++r2_) ssm_pass2_item(F, L, it); } else
#endif
#ifndef NO_ATTN
            if (it < 384) { if (it >= 256) attn_item(F, L, it - 256); } else
#endif
#ifndef NO_SAMPLE
            if (it < 608) { if (it >= 384) for (int r2_ = 0; r2_ < REP_SAMP; ++r2_) sample_sub(F, L, it - 384); } else
#endif
#ifndef NO_SGATE
            { if (it >= 608) sgate_item(F, L, it - 608); }
#else
            {}
#endif
            __syncthreads();
            if (opaque_tid() == 0) F.MISC[16] = __hip_atomic_fetch_add(F.ctl + CW_QUEUE + 64 * l + 16, 1u, __ATOMIC_RELAXED, __HIP_MEMORY_SCOPE_AGENT);
            __syncthreads();
            it = (G - 8) + (int)F.MISC[16];
        }
        }
        GRID_BARK(3);
        if (PROBE_BAR2) GRID_BAR();
#if PROBE_DET
        det_compare(F, L);
#endif
#ifndef NO_DPOST
        dpost_rows(F, L);
#endif
        GRID_BARK(4);
        {
            pg8::Gemm g{YC, (const bf16*)(ws + WS_WB) + (size_t)l * DM * DM, MP, DM, DM}; pg8::StaticOrder S; S.init(MP, DM, G, bid);
            pg8::EpiGate E{Gb, GS};
#ifndef NO_GBR
            for (int rep_ = 0; rep_ < REP_G3; ++rep_)
            pg8::gemm_phase<pg8::EpiGate, pg8::StaticOrder, true, true>(F.lds + RING_OFF, g, S, E);
#endif
            T.X = YC + (size_t)MP * DM; T.Wt = g.Bt; T.N = DM; T.K = DM;
            for (int rep_ = 0; rep_ < REP_THIN; ++rep_) thin_gemm<TH_BR>(F, T);
        }
        GRID_BARK(5);
        {
            pg8::Gemm g{GS, (const bf16*)(ws + WS_WO) + (size_t)l * DM * DM, MP, DM, DM}; pg8::StaticOrder S; S.init(MP, DM, G, bid);
            pg8::EpiRes E{l == 0 ? args.in[I_XP] : Xp, l == 0 ? args.in[I_XS] : Xs, Xp, Xs, XB, ssq + (size_t)(2 * l + 1) * MPAD * 32};
#ifndef NO_GRES
            if (REP_G3 > 1) { pg8::EpiRes E2 = E; E2.Xp = (float*)(ws + 1100 * MiB); E2.XB = (bf16*)(ws + 1170 * MiB); E2.ssq_out = (float*)(ws + 1210 * MiB);
                pg8::gemm_phase<pg8::EpiRes, pg8::StaticOrder, true, true>(F.lds + RING_OFF, g, S, E2); }
            pg8::gemm_phase<pg8::EpiRes, pg8::StaticOrder, true, true>(F.lds + RING_OFF, g, S, E);
#endif
            T.X = GS + (size_t)MP * DM; T.Wt = g.Bt; T.N = DM; T.K = DM; T.R = l == 0 ? args.in[I_XS] : Xs; T.ssq_out = ssqs + (2 * l + 1) * 4096;
            thin_gemm<TH_RES>(F, T);
        }
        GRID_BARK(6);
        {
            pg8::Gemm g{XB, (const bf16*)(ws + WS_W1) + (size_t)l * DFF * DM, MP, DFF, DM}; pg8::StaticOrder S; S.init(MP, DFF, G, bid);
            LAS float* rsl = (LAS float*)(F.lds + RING_BYTES);
            { pg8::StaticOrder S2; S2.init(MP, DFF, G, bid); fill_rstd(rsl, S2, ssq + (size_t)(2 * l + 1) * MPAD * 32); }
            pg8::EpiFf1 E{Hb, rsl};
#ifndef NO_GFF1
            for (int rep_ = 0; rep_ < REP_GFF1; ++rep_)
            pg8::gemm_phase<pg8::EpiFf1, pg8::StaticOrder, true, true>(F.lds + RING_OFF, g, S, E);
#endif
            T.X = XB + (size_t)MP * DM; T.Wt = g.Bt; T.N = DFF; T.K = DM; T.ssq_in = ssqs + (2 * l + 1) * 4096;
            for (int rep_ = 0; rep_ < REP_THIN; ++rep_) thin_gemm<TH_FF1>(F, T);
        }
        GRID_BARK(7);
        {
            pg8::Gemm g{Hb, (const bf16*)(ws + WS_W2) + (size_t)l * DM * DFF, MP, DM, DFF}; pg8::StaticOrder S; S.init(MP, DM, G, bid);
            pg8::EpiRes E{Xp, Xs, Xp, Xs, XB, ssq + (size_t)(2 * l + 2) * MPAD * 32};
#ifndef NO_GRES
            if (REP_G3 > 1) { pg8::EpiRes E2 = E; E2.Xp = (float*)(ws + 1100 * MiB); E2.XB = (bf16*)(ws + 1170 * MiB); E2.ssq_out = (float*)(ws + 1210 * MiB);
                pg8::gemm_phase<pg8::EpiRes, pg8::StaticOrder, true, true>(F.lds + RING_OFF, g, S, E2); }
            pg8::gemm_phase<pg8::EpiRes, pg8::StaticOrder, true, true>(F.lds + RING_OFF, g, S, E);
#endif
            T.X = Hb + (size_t)MP * DFF; T.Wt = g.Bt; T.N = DM; T.K = DFF; T.R = Xs; T.ssq_out = ssqs + (2 * l + 2) * 4096;
            thin_gemm<TH_RES>(F, T);
        }
        GRID_BARK(8);
    }
#if PROBE_DET
    if (bid == 0 && opaque_tid() == 0) {
        unsigned* C = (unsigned*)(args.ws + WS_CTL) + 1024;
        const unsigned cnt = __hip_atomic_load(C, __ATOMIC_RELAXED, __HIP_MEMORY_SCOPE_AGENT), early = __hip_atomic_load(C + 1, __ATOMIC_RELAXED, __HIP_MEMORY_SCOPE_AGENT), mask = __hip_atomic_load(C + 2, __ATOMIC_RELAXED, __HIP_MEMORY_SCOPE_AGENT);
        if (cnt) {
            const size_t offs[16] = {O_YP, O_YS, O_PK, O_PV, O_PSR, O_PSI, O_PD, O_PC, O_PCV, O_SK, O_SV, O_SSR, O_SSI, O_SD, O_SC, O_SCV};
            int idx;
            if (PROBE_DET == 1) { idx = 1; unsigned c = cnt; while (c > 1 && idx < 15) { c >>= 1; ++idx; } }
            else if (PROBE_DET == 2) idx = (int)((64u - early) >> 2);
            else idx = __builtin_popcount(mask) > 15 ? 15 : __builtin_popcount(mask);
            size_t o = O_YP; for (int i = 0; i < 16; ++i) o = (i == idx) ? offs[i] : o;
            ((float*)args.out)[o] = __builtin_nanf("");
        }
    }
#endif
}

extern "C" void kernel_launch(void* const* d_in, const int* in_sizes, int n_in, void* d_out, int out_size, void* d_ws, size_t ws_size, hipStream_t stream) {
    static int grid = 0;
    if (grid == 0) {
        if (n_in != 35 || out_size != (int)O_END || ws_size < WS_END) { fprintf(stderr, "kernel_launch: unexpected problem shape (n_in %d, out %d, ws %zu)\n", n_in, out_size, ws_size); grid = -1; return; }
        int dev = 0, cus = 0, per_cu = 0;
        if (hipGetDevice(&dev) != hipSuccess || hipDeviceGetAttribute(&cus, hipDeviceAttributeMultiprocessorCount, dev) != hipSuccess) { grid = -1; return; }
        if (hipFuncSetAttribute((const void*)hybrid_fwd, hipFuncAttributeMaxDynamicSharedMemorySize, LDS_BYTES) != hipSuccess) { grid = -1; return; }
        if (hipOccupancyMaxActiveBlocksPerMultiprocessor(&per_cu, (const void*)hybrid_fwd, NWAVES * 64, LDS_BYTES) != hipSuccess || per_cu < 1)
            fprintf(stderr, "kernel_launch: occupancy query reports %d workgroups per CU\n", per_cu);
        (void)hipGetLastError();
        grid = cus;
    }
    if (grid < 0) return;
    if (hipMemsetAsync((char*)d_ws + WS_CTL, 0, CTL_ZERO_BYTES, stream) != hipSuccess) return;
    Args a{};
    for (int i = 0; i < 35; ++i) a.in[i] = (const float*)d_in[i];
    a.out = (float*)d_out; a.ws = (unsigned char*)d_ws;
    hipLaunchKernelGGL(hybrid_fwd, dim3(grid), dim3(NWAVES * 64), LDS_BYTES, stream, a);
}
```
